# Optimizing an MI355X kernel written in HIP

```python
import jax, jax.numpy as jnp
from jax import lax
import numpy as np

D_MODEL = 2048
BATCH = 1
SEQ = 8192
DEPTH = 4

HEAD_DIM = 128
GROUPS = 4
BRANCH_W = GROUPS * HEAD_DIM
N_BRANCH = 4
CONV_W = 3
CHUNK = 128
POOL_WINDOWS = (2, 4, 8, 16)
Q_BLOCK = 128
PEER_HEADS = 8
PEER_KEYS = 128
PEER_N = PEER_KEYS * PEER_KEYS
PEER_DKEY = 256
PEER_HALF = PEER_DKEY // 2
PEER_TOPK = 16
TOKEN_BLOCK = 128
EPS = 1e-6

OFF_A = 0
OFF_B = OFF_A + 3 * BRANCH_W
OFF_C = OFF_B + 2 * BRANCH_W
OFF_D = OFF_C + BRANCH_W
OFF_G = OFF_D + 3 * BRANCH_W + GROUPS
IN_COLS = OFF_G + N_BRANCH * D_MODEL

kernel_name = "hybrid_conv_sgu_pool_fox_peer"


def rmsnorm(x, g):
    xf = x.astype(jnp.float32)
    y = xf * lax.rsqrt(jnp.mean(xf * xf, axis=-1, keepdims=True) + EPS)
    return (y * g.astype(jnp.float32)).astype(x.dtype)


def short_conv_mixer(cols, conv_w):
    b, c, h = jnp.split(cols, 3, axis=-1)
    z = c * h
    kern = conv_w[:, None, :].astype(z.dtype)
    y = lax.conv_general_dilated(z, kern, window_strides=(1,), padding=((CONV_W - 1, 0),),
                                 dimension_numbers=('NWC', 'WIO', 'NWC'),
                                 feature_group_count=BRANCH_W)
    return b * y


def sgu_mixer(cols, norm_g, w_s, bias):
    zc = jax.nn.gelu(cols)
    u, v = jnp.split(zc, 2, axis=-1)
    v = rmsnorm(v, norm_g)
    bsz, s, _ = v.shape
    v = v.reshape(bsz, s // CHUNK, CHUNK, GROUPS, HEAD_DIM)
    mask = jnp.tril(jnp.ones((CHUNK, CHUNK), dtype=bool))
    w = jnp.where(mask[None], w_s, 0).astype(v.dtype)
    sv = jnp.einsum('gts,bcsgd->bctgd', w, v) + bias.T[:, :, None].astype(v.dtype)
    return u * sv.reshape(bsz, s, BRANCH_W)


def pool_mixer(p, pool_w, scale):
    bsz, s, _ = p.shape
    pf = p.astype(jnp.float32)
    cs = jnp.concatenate([jnp.zeros((bsz, 1, BRANCH_W), jnp.float32), jnp.cumsum(pf, axis=1)], axis=1)
    t = jnp.arange(1, s + 1, dtype=jnp.float32)
    outs = []
    for g, w in enumerate(POOL_WINDOWS):
        sl = slice(g * HEAD_DIM, (g + 1) * HEAD_DIM)
        csg = cs[..., sl]
        lag = jnp.concatenate([jnp.zeros((bsz, w - 1, HEAD_DIM), jnp.float32), csg[:, :s - w + 1]], axis=1)
        mean = (csg[:, 1:] - lag) / jnp.minimum(t, float(w))[None, :, None]
        outs.append(mean - pf[..., sl])
    pooled = jnp.stack(outs, axis=2).astype(p.dtype)
    y = jnp.einsum('bsgi,gio->bsgo', pooled, pool_w)
    return y.reshape(bsz, s, BRANCH_W) * scale


def forgetting_attention(cols, forget_b):
    bsz, s, _ = cols.shape
    q = cols[..., 0:BRANCH_W].reshape(bsz, s, GROUPS, HEAD_DIM)
    k = cols[..., BRANCH_W:2 * BRANCH_W].reshape(bsz, s, GROUPS, HEAD_DIM)
    v = cols[..., 2 * BRANCH_W:3 * BRANCH_W].reshape(bsz, s, GROUPS, HEAD_DIM)
    f_logit = cols[..., 3 * BRANCH_W:].astype(jnp.float32) + forget_b.astype(jnp.float32)
    F = jnp.cumsum(jax.nn.log_sigmoid(f_logit), axis=1)
    Fk = jnp.transpose(F, (0, 2, 1))
    nblk = s // Q_BLOCK
    qb = q.reshape(bsz, nblk, Q_BLOCK, GROUPS, HEAD_DIM).transpose(1, 0, 2, 3, 4)
    Fb = F.reshape(bsz, nblk, Q_BLOCK, GROUPS).transpose(1, 0, 3, 2)
    key_pos = jnp.arange(s)
    scale = HEAD_DIM ** -0.5

    def block(args):
        q_i, F_i, i = args
        qpos = i * Q_BLOCK + jnp.arange(Q_BLOCK)
        sc = jnp.einsum('bqhd,bkhd->bhqk', q_i, k).astype(jnp.float32) * scale
        sc = sc + F_i[..., None] - Fk[:, :, None, :]
        sc = jnp.where((qpos[:, None] >= key_pos[None, :])[None, None], sc, -jnp.inf)
        pr = jax.nn.softmax(sc, axis=-1).astype(v.dtype)
        return jnp.einsum('bhqk,bkhd->bqhd', pr, v)

    o = lax.map(block, (qb, Fb, jnp.arange(nblk)))
    return o.transpose(1, 0, 2, 3, 4).reshape(bsz, s, BRANCH_W)


def peer_ffn(h, wq, keys, u_tab, v_tab):
    bsz, s, d = h.shape
    q = (h @ wq).reshape(bsz, s, PEER_HEADS, 2, PEER_HALF)
    sc = jnp.einsum('bshpc,hpnc->bshpn', q, keys).astype(jnp.float32)
    vals, idx = lax.top_k(sc, PEER_TOPK)
    cand = vals[..., 0, :, None] + vals[..., 1, None, :]
    cand_idx = idx[..., 0, :, None] * PEER_KEYS + idx[..., 1, None, :]
    kk = PEER_TOPK * PEER_TOPK
    top_vals, top_pos = lax.top_k(cand.reshape(bsz, s, PEER_HEADS, kk), PEER_TOPK)
    expert = jnp.take_along_axis(cand_idx.reshape(bsz, s, PEER_HEADS, kk), top_pos, axis=-1)
    gate = jax.nn.softmax(top_vals, axis=-1).astype(h.dtype)
    nblk = (bsz * s) // TOKEN_BLOCK
    hb = h.reshape(nblk, TOKEN_BLOCK, d)
    eb = expert.reshape(nblk, TOKEN_BLOCK, PEER_HEADS, PEER_TOPK)
    gb = gate.reshape(nblk, TOKEN_BLOCK, PEER_HEADS, PEER_TOPK)

    def block(args):
        h_i, e_i, g_i = args
        u = u_tab[e_i]
        a = g_i * jax.nn.gelu(jnp.einsum('td,thkd->thk', h_i, u))
        return jnp.einsum('thk,thkd->td', a, v_tab[e_i])

    out = lax.map(block, (hb, eb, gb))
    return out.reshape(bsz, s, d)


def setup_inputs(seed: int = 0) -> dict:
    key = jax.random.key(seed)
    ks = jax.random.split(key, 24)
    f32 = jnp.float32
    nrm = lambda k, shape, sc: jax.random.normal(k, shape, f32) * sc
    D = D_MODEL
    x = nrm(ks[0], (BATCH, SEQ, D), 1.0)
    norm1_g = 1.0 + nrm(ks[1], (DEPTH, D), 0.05)
    w_mix = nrm(ks[2], (DEPTH, D, OFF_D + 3 * BRANCH_W), D ** -0.5)
    w_fg = nrm(ks[3], (DEPTH, D, GROUPS), 0.1 * D ** -0.5)
    w_gate = nrm(ks[4], (DEPTH, D, N_BRANCH * D), D ** -0.5)
    w_in = jnp.concatenate([w_mix, w_fg, w_gate], axis=-1)
    conv_w = nrm(ks[5], (DEPTH, CONV_W, BRANCH_W), CONV_W ** -0.5)
    sgu_norm_g = 1.0 + nrm(ks[6], (DEPTH, BRANCH_W), 0.05)
    sgu_w = nrm(ks[7], (DEPTH, GROUPS, CHUNK, CHUNK), CHUNK ** -0.5)
    sgu_b = 1.0 + nrm(ks[8], (DEPTH, GROUPS, CHUNK), 0.1)
    pool_w = nrm(ks[9], (DEPTH, GROUPS, HEAD_DIM, HEAD_DIM), HEAD_DIM ** -0.5)
    pool_scale = 1.0 + nrm(ks[10], (DEPTH, BRANCH_W), 0.1)
    forget_b = 2.0 + nrm(ks[11], (DEPTH, GROUPS), 0.5)
    w_branch = nrm(ks[12], (DEPTH, N_BRANCH, BRANCH_W, D), BRANCH_W ** -0.5)
    w_out = nrm(ks[13], (DEPTH, D, D), D ** -0.5)
    norm2_g = 1.0 + nrm(ks[14], (DEPTH, D), 0.05)
    peer_wq = nrm(ks[15], (DEPTH, D, PEER_HEADS * PEER_DKEY), D ** -0.5)
    peer_keys = nrm(ks[16], (DEPTH, PEER_HEADS, 2, PEER_KEYS, PEER_HALF), PEER_HALF ** -0.5)
    peer_u = nrm(ks[17], (DEPTH, PEER_N, D), D ** -0.5)
    peer_v = nrm(ks[18], (DEPTH, PEER_N, D), (PEER_HEADS * PEER_TOPK) ** -0.5)
    final_g = 1.0 + nrm(ks[19], (D,), 0.05)
    return {"x": x, "norm1_g": norm1_g, "w_in": w_in, "conv_w": conv_w,
            "sgu_norm_g": sgu_norm_g, "sgu_w": sgu_w, "sgu_b": sgu_b,
            "pool_w": pool_w, "pool_scale": pool_scale, "forget_b": forget_b,
            "w_branch": w_branch, "w_out": w_out, "norm2_g": norm2_g,
            "peer_wq": peer_wq, "peer_keys": peer_keys, "peer_u": peer_u,
            "peer_v": peer_v, "final_g": final_g}


def reference(x, norm1_g, w_in, conv_w, sgu_norm_g, sgu_w, sgu_b, pool_w, pool_scale,
              forget_b, w_branch, w_out, norm2_g, peer_wq, peer_keys, peer_u, peer_v, final_g):
    bsz, s, d = x.shape
    h = x
    for l in range(DEPTH):
        xn = rmsnorm(h, norm1_g[l])
        z = xn @ w_in[l]
        oa = short_conv_mixer(z[..., OFF_A:OFF_B], conv_w[l])
        ob = sgu_mixer(z[..., OFF_B:OFF_C], sgu_norm_g[l], sgu_w[l], sgu_b[l])
        oc = pool_mixer(z[..., OFF_C:OFF_D], pool_w[l], pool_scale[l])
        od = forgetting_attention(z[..., OFF_D:OFF_G], forget_b[l])
        branches = jnp.stack([oa, ob, oc, od], axis=2)
        gates = jax.nn.sigmoid(z[..., OFF_G:].reshape(bsz, s, N_BRANCH, d))
        y = jnp.einsum('bsnm,nmd->bsnd', branches, w_branch[l])
        merged = jnp.einsum('bsnd,bsnd->bsd', gates, y)
        h = h + merged @ w_out[l]
        h = h + peer_ffn(rmsnorm(h, norm2_g[l]), peer_wq[l], peer_keys[l], peer_u[l], peer_v[l])
    return rmsnorm(h, final_g)
```

```cpp
#include <hip/hip_runtime.h>
#include <cstdio>
#include <cstdint>

#define LAS __attribute__((address_space(3)))
#define GAS __attribute__((address_space(1)))
typedef unsigned short bf16_t;
typedef short bf16x8 __attribute__((ext_vector_type(8)));
typedef short s16x4 __attribute__((ext_vector_type(4)));
typedef float f32x2 __attribute__((ext_vector_type(2)));
typedef float f32x4 __attribute__((ext_vector_type(4)));
typedef float f32x16 __attribute__((ext_vector_type(16)));
typedef unsigned u32x2 __attribute__((ext_vector_type(2)));
typedef unsigned u32x4 __attribute__((ext_vector_type(4)));
typedef long i64x2 __attribute__((ext_vector_type(2)));

#ifndef N_LAUNCH_MODE
#define N_LAUNCH_MODE 1
#endif

constexpr int SEQ = 8192, DM = 2048, DEPTH = 4, BWID = 512;
constexpr int NMIX = 4608, NGATE = 8192, NIN = 12800, INCOLS = 12804;
constexpr int PEER_N = 16384;
constexpr float A_SCALE = 64.f;
constexpr float V_SCALE = 16.f;
constexpr float U_SCALE = 64.f;
constexpr int C_A = 0, C_B = 1536, C_C = 2560, C_Q = 3072, C_K = 3584, C_V = 4096;
constexpr float EPS = 1e-6f;
constexpr int NTHREADS = 512, NWAVES = 8;

constexpr size_t al256(size_t x) { return (x + 255) & ~(size_t)255; }
constexpr size_t WS_CTL = 0, CTL_BYTES = 1u << 20;
constexpr size_t WS_WIN = WS_CTL + CTL_BYTES;
constexpr size_t WS_WB = WS_WIN + (size_t)DEPTH * NIN * DM * 2;
constexpr size_t WS_WO = WS_WB + (size_t)DEPTH * 4 * DM * BWID * 2;
constexpr size_t WS_WQ = WS_WO + (size_t)DEPTH * DM * DM * 2;
constexpr size_t WS_KEYS = WS_WQ + (size_t)DEPTH * DM * DM * 2;
constexpr size_t WS_U = WS_KEYS + (size_t)DEPTH * 8 * 2 * 128 * 128 * 2;
constexpr size_t WS_V = WS_U + (size_t)DEPTH * PEER_N * DM * 2;
constexpr size_t WS_SGUW = WS_V + (size_t)DEPTH * PEER_N * DM * 2;
constexpr size_t WS_POOLW = WS_SGUW + (size_t)DEPTH * 4 * 128 * 128 * 2;
constexpr size_t WS_WFG = WS_POOLW + (size_t)DEPTH * 4 * 128 * 128 * 2;
constexpr size_t WS_H = WS_WFG + (size_t)DEPTH * 4 * DM * 4;
constexpr size_t WS_MACC = WS_H + (size_t)SEQ * DM * 4;
constexpr size_t WS_XN = WS_MACC + (size_t)SEQ * DM * 4;
constexpr size_t WS_ZMIX = WS_XN + (size_t)SEQ * DM * 2;
constexpr size_t WS_ZGATE = WS_ZMIX + (size_t)SEQ * NMIX * 2;
constexpr size_t WS_BR = WS_ZGATE + (size_t)SEQ * NGATE * 2;
constexpr size_t WS_MERGED = WS_BR + (size_t)SEQ * DM * 2;
constexpr size_t WS_Q = WS_MERGED + (size_t)SEQ * DM * 2;
constexpr size_t WS_FLOG = WS_Q + (size_t)SEQ * DM * 2;
constexpr size_t WS_F = WS_FLOG + (size_t)SEQ * 4 * 4;
constexpr size_t WS_PIDX = WS_F + (size_t)SEQ * 4 * 4;
constexpr size_t WS_PGATE = WS_PIDX + (size_t)SEQ * 128 * 4;
constexpr size_t WS_PQ = WS_PGATE + (size_t)SEQ * 128 * 4;
constexpr size_t WS_AB = WS_PQ + (size_t)8 * SEQ * 128 * 4;
constexpr size_t WS_HN8 = WS_AB + (size_t)SEQ * 128 * 2;
constexpr size_t WS_SSQP = WS_HN8 + (size_t)SEQ * DM;
constexpr size_t WS_RS2 = WS_SSQP + (size_t)SEQ * 32 * 4;
constexpr size_t WS_END = WS_RS2 + (size_t)SEQ * 4;
static_assert(WS_WB % 256 == 0 && WS_U % 256 == 0 && WS_H % 256 == 0 && WS_ZMIX % 256 == 0 && WS_F % 256 == 0, "ws alignment");

constexpr int LDS_BYTES = 155648;
constexpr int LDS_BARW = LDS_BYTES - 64;

struct Params {
    const float *x, *norm1_g, *w_in, *conv_w, *sgu_norm_g, *sgu_w, *sgu_b, *pool_w, *pool_scale, *forget_b, *w_branch, *w_out, *norm2_g, *peer_wq, *peer_keys, *peer_u, *peer_v, *final_g;
    float* out;
    bf16_t *WinT, *WbT, *WoT, *WqT, *keysB, *uS, *vS, *sguW, *poolWT;
    float *wfg, *h, *macc, *flog, *F, *pgate, *pq;
    bf16_t* aB;
    unsigned char *uS8, *vS8, *hn8, *aB8;
    float *ssqp, *rs2;
    bf16_t *xn, *zmix, *br, *merged, *q;
    bf16_t* po;
    unsigned char* zgate;
    int* pidx;
    unsigned* ctl;
};
struct Args { const float* in[18]; float* out; unsigned char* ws; int ph_lo, ph_hi; };
constexpr int TPW = 16;
constexpr int LDS_PTAB = LDS_BYTES - 256;
constexpr int LDS_RSTAB = 135168;
constexpr int LDS_MISC = LDS_BYTES - 512;
constexpr int CW_MIXQ = 8192;
constexpr int CW_KN = 12288;
constexpr int CW_QCNT = 16384;

__device__ __forceinline__ unsigned f2bf(float f) { unsigned u = __float_as_uint(f); return (u + 0x7fffu + ((u >> 16) & 1u)) >> 16; }
__device__ __forceinline__ unsigned pk2(float lo, float hi) { return f2bf(lo) | (f2bf(hi) << 16); }
__device__ __forceinline__ float bflo(unsigned w) { return __uint_as_float(w << 16); }
__device__ __forceinline__ float bfhi(unsigned w) { return __uint_as_float(w & 0xffff0000u); }
__device__ __forceinline__ float bf1(bf16_t v) { return __uint_as_float((unsigned)v << 16); }
__device__ __forceinline__ unsigned cvtpk(float lo, float hi) { unsigned r; asm volatile("v_cvt_pk_bf16_f32 %0, %1, %2" : "=v"(r) : "v"(lo), "v"(hi)); return r; }
__device__ __forceinline__ float clamp8(float x) { return fminf(fmaxf(x, -448.f), 448.f); }
__device__ __forceinline__ float gelu_t(float x) {
    const float u = x + 0.044715f * x * x * x;
    const float e = __builtin_amdgcn_exp2f(-2.3022081985f * u);
    return x * __builtin_amdgcn_rcpf(1.0f + e);
}
__device__ __forceinline__ float sigmoid_f(float x) { return __builtin_amdgcn_rcpf(1.0f + __builtin_amdgcn_exp2f(-1.4426950409f * x)); }
__device__ __forceinline__ float wave_sum(float v) {
#pragma unroll
    for (int o = 1; o < 64; o <<= 1) v += __shfl_xor(v, o);
    return v;
}
__device__ __forceinline__ unsigned xb_xcc_id() { return (unsigned)__builtin_amdgcn_s_getreg((3 << 11) | 20) & 0xFu; }
__device__ __forceinline__ int ltid() { int t = threadIdx.x; asm volatile("" : "+v"(t)); return t; }
__device__ __forceinline__ int lbid() { int b = blockIdx.x; asm volatile("" : "+s"(b)); return b; }
__device__ __forceinline__ f32x4 mfma16(bf16x8 x, bf16x8 y, f32x4 c) { return __builtin_amdgcn_mfma_f32_16x16x32_bf16(x, y, c, 0, 0, 0); }

namespace pg8 {
constexpr int BM = 256, BK = 64, HALF = 128, HTB = HALF * BK * 2, STAGE_BYTES = 8 * HTB, NXCD = 8, WGM = 8;
__host__ __device__ __forceinline__ int lds_byte(int r, int c) { const int st = (r >> 4) * 2 + (c >> 5), rr = r & 15, cc = c & 31, ob = rr * 64 + cc * 2; return st * 1024 + (ob ^ (((ob >> 9) & 1) << 5)); }
__host__ __device__ __forceinline__ void stage_rc(int b, int& R, int& C) { const int st = b / 1024, sb = b % 1024, swz = sb ^ (((sb >> 9) & 1) << 5); R = (st >> 1) * 16 + swz / 64; C = (st & 1) * 32 + (swz % 64) / 2; }
__host__ __device__ __forceinline__ int perm32(int rho) { const int n = rho >> 4, i = rho & 15; return 8 * (i >> 2) + 4 * n + (i & 3); }

struct Unit { int pm, pn, aco, bro; };
struct Gemm { const bf16_t* A; const bf16_t* Bt; int M, N, K, lda, ldb; };

struct StaticOrder {
    int nM, nN, nwg, G, c, i0, imax;
    __host__ __device__ __forceinline__ void init(int M, int N, int G_, int c_) { nM = M / BM; nN = N / BM; nwg = nM * nN; G = G_; c = c_; i0 = 0; imax = 1 << 30; }
    __host__ __device__ __forceinline__ bool next(int i_, Unit& u) const {
        const int i = i_ + i0; if (i >= imax) return false;
        const long L = (long)i * G + c; if (L >= nwg) return false;
        int wgid = (int)L; { const int q = nwg / NXCD, r = nwg % NXCD, xcd = wgid % NXCD, off = wgid / NXCD; wgid = (xcd < r ? xcd * (q + 1) : r * (q + 1) + (xcd - r) * q) + off; }
        const int nig = WGM * nN, gid = wgid / nig, fm = gid * WGM, gsz = (nM - fm) < WGM ? (nM - fm) : WGM;
        u.pm = fm + ((wgid % nig) % gsz); u.pn = (wgid % nig) / gsz; u.aco = 0; u.bro = 0; return true;
    }
};
struct MergeOrder {
    StaticOrder so;
    __host__ __device__ __forceinline__ bool next(int i, Unit& u) const { if (!so.next(i >> 2, u)) return false; const int n = i & 3; u.aco = n * BWID; u.bro = n * DM; return true; }
};

template <class Epi, class Sched>
__device__ __forceinline__ void gemm_phase(LAS unsigned char* lds, const Gemm g, const Sched& S, const Epi& E) {
    const int tid = ltid(), wid = __builtin_amdgcn_readfirstlane(tid >> 6), lane = tid & 63, wr = wid >> 2, wc = wid & 3, fr = lane & 15, fq = lane >> 4;
    const int K = g.K, nt = K / BK;
    unsigned voffA[2], voffB[2];
#pragma unroll
    for (int i = 0; i < 2; ++i) { int R, C; stage_rc(tid * 16 + i * 8192, R, C); const int Rb = Epi::PERM ? ((R & ~31) + perm32(R & 31)) : R;
        voffA[i] = (unsigned)(R * g.lda + C) * 2u; voffB[i] = (unsigned)(Rb * g.ldb + C) * 2u; }
    const size_t kstep = (size_t)(BK * 2);
    const size_t hstepA = (size_t)HALF * g.lda * 2, hstepB = (size_t)HALF * g.ldb * 2;
    const unsigned ldsw = (unsigned)wid * 1024u;
    const int aoff = lds_byte(wr * 64 + fr, fq * 8), boff = lds_byte(wc * 32 + fr, fq * 8);
#define PG8_UA(u) ((const char*)g.A + ((size_t)(u).pm * BM * g.lda + (size_t)(u).aco) * 2)
#define PG8_UB(u) ((const char*)g.Bt + ((size_t)((u).pn * BM + (u).bro) * g.ldb) * 2)
#define PG8_SA(b, h) (((b) * 2 + (h)) * HTB)
#define PG8_SB(b, h) ((4 + (b) * 2 + (h)) * HTB)
#define PG8_STAGE(bufoff, gbase, voff) do { _Pragma("unroll") for (int _i = 0; _i < 2; ++_i) \
        __builtin_amdgcn_global_load_lds((const unsigned*)((const char*)(gbase) + (voff)[_i]), (LAS unsigned*)(lds + (bufoff) + ldsw + _i * 8192), 16, 0, 0); } while (0)
#define PG8_LDA(dst, b, h) do { _Pragma("unroll") for (int m = 0; m < 4; ++m) _Pragma("unroll") for (int k = 0; k < 2; ++k) dst[m][k] = *(const LAS bf16x8*)(lds + PG8_SA(b, h) + aoff + m * 2048 + k * 1024); } while (0)
#define PG8_LDB(dst, b, h) do { _Pragma("unroll") for (int n = 0; n < 2; ++n) _Pragma("unroll") for (int k = 0; k < 2; ++k) dst[n][k] = *(const LAS bf16x8*)(lds + PG8_SB(b, h) + boff + n * 2048 + k * 1024); } while (0)
#define PG8_MMA(ai, bj, At, Bt) do { __builtin_amdgcn_s_setprio(1); _Pragma("unroll") for (int m = 0; m < 4; ++m) _Pragma("unroll") for (int n = 0; n < 2; ++n) _Pragma("unroll") for (int k = 0; k < 2; ++k) \
        acc[ai][bj][m][n] = __builtin_amdgcn_mfma_f32_16x16x32_bf16(Bt[n][k], At[m][k], acc[ai][bj][m][n], 0, 0, 0); __builtin_amdgcn_s_setprio(0); } while (0)
#define PG8_WAIT_V(n) asm volatile("s_waitcnt vmcnt(" #n ")" ::: "memory")
#define PG8_WAIT_L(n) asm volatile("s_waitcnt lgkmcnt(" #n ")" ::: "memory")
#define PG8_BAR __builtin_amdgcn_s_barrier()
#define PG8_SCHED __builtin_amdgcn_sched_barrier(0)
    Unit cur, nxt; int ui = 0;
    if (!S.next(0, cur)) return;
    f32x4 acc[2][2][4][2];
#pragma unroll
    for (int a = 0; a < 2; ++a)
#pragma unroll
        for (int b = 0; b < 2; ++b)
#pragma unroll
            for (int m = 0; m < 4; ++m)
#pragma unroll
                for (int n = 0; n < 2; ++n) acc[a][b][m][n] = (f32x4){0.f, 0.f, 0.f, 0.f};
    bf16x8 At[4][2], B0[2][2], B1[2][2];
    const char* cA = PG8_UA(cur); const char* cB = PG8_UB(cur);
    PG8_STAGE(PG8_SB(0, 0), cB, voffB); PG8_STAGE(PG8_SB(0, 1), cB + hstepB, voffB); PG8_STAGE(PG8_SA(0, 0), cA, voffA); PG8_STAGE(PG8_SA(0, 1), cA + hstepA, voffA);
    if (wr == 1) PG8_BAR;
    PG8_WAIT_V(2); PG8_BAR;
    PG8_STAGE(PG8_SB(1, 0), cB + kstep, voffB); PG8_STAGE(PG8_SA(1, 0), cA + kstep, voffA); PG8_STAGE(PG8_SB(1, 1), cB + hstepB + kstep, voffB);
    PG8_WAIT_V(6); PG8_BAR;
    for (;;) {
        const bool has_next = S.next(ui + 1, nxt);
        const char* nA = has_next ? PG8_UA(nxt) : cA; const char* nB = has_next ? PG8_UB(nxt) : cB;
        for (int t = 0; t < nt; t += 2) {
            const bool last = (t == nt - 2);
            const char* a1 = cA + (size_t)(t + 1) * kstep;
            const char* a2 = last ? nA : cA + (size_t)(t + 2) * kstep; const char* b2 = last ? nB : cB + (size_t)(t + 2) * kstep;
            const char* a3 = a2 + kstep; const char* b3 = b2 + kstep;
            PG8_LDB(B0, 0, 0); PG8_LDB(B1, 0, 1); PG8_SCHED; PG8_LDA(At, 0, 0); PG8_STAGE(PG8_SA(1, 1), a1 + hstepA, voffA);
            PG8_WAIT_V(8); PG8_WAIT_L(0); PG8_BAR; PG8_MMA(0, 0, At, B0); PG8_MMA(0, 1, At, B1); PG8_BAR; PG8_SCHED;
            PG8_LDA(At, 0, 1); PG8_STAGE(PG8_SB(0, 0), b2, voffB); PG8_STAGE(PG8_SB(0, 1), b2 + hstepB, voffB); PG8_STAGE(PG8_SA(0, 0), a2, voffA);
            PG8_WAIT_V(8); PG8_WAIT_L(0); PG8_BAR; PG8_MMA(1, 0, At, B0); PG8_MMA(1, 1, At, B1); PG8_BAR; PG8_SCHED;
            PG8_LDB(B0, 1, 0); PG8_LDB(B1, 1, 1); PG8_SCHED; PG8_LDA(At, 1, 0); PG8_STAGE(PG8_SA(0, 1), a2 + hstepA, voffA);
            PG8_WAIT_V(8); PG8_WAIT_L(0); PG8_BAR; PG8_MMA(0, 0, At, B0); PG8_MMA(0, 1, At, B1); PG8_BAR; PG8_SCHED;
            PG8_LDA(At, 1, 1); PG8_STAGE(PG8_SB(1, 0), b3, voffB); PG8_STAGE(PG8_SB(1, 1), b3 + hstepB, voffB); PG8_STAGE(PG8_SA(1, 0), a3, voffA);
            PG8_WAIT_V(8); PG8_WAIT_L(0); PG8_BAR; PG8_MMA(1, 0, At, B0); PG8_MMA(1, 1, At, B1); PG8_BAR; PG8_SCHED;
        }
        if (wr == 0) PG8_BAR;
        bool keep = false;
        if constexpr (Epi::HORNER) keep = E.scale(acc, cur, wr, wc, fr, fq); else E(acc, cur, wr, wc, fr, fq);
        if (!has_next) break;
        if (!keep) {
#pragma unroll
        for (int a = 0; a < 2; ++a)
#pragma unroll
            for (int b = 0; b < 2; ++b)
#pragma unroll
                for (int m = 0; m < 4; ++m)
#pragma unroll
                    for (int n = 0; n < 2; ++n) acc[a][b][m][n] = (f32x4){0.f, 0.f, 0.f, 0.f};
        }
        cur = nxt; cA = nA; cB = nB; ++ui;
        if (wr == 1) PG8_BAR;
    }
    PG8_WAIT_V(0);
    PG8_BAR;
#undef PG8_UA
#undef PG8_UB
#undef PG8_SA
#undef PG8_SB
#undef PG8_STAGE
#undef PG8_LDA
#undef PG8_LDB
#undef PG8_MMA
#undef PG8_WAIT_V
#undef PG8_WAIT_L
#undef PG8_BAR
#undef PG8_SCHED
}

__device__ __forceinline__ size_t gate_off(int row, int gcol) { return ((size_t)(row >> 4) * (NGATE / 32) + (size_t)(gcol >> 5)) * 512 + (size_t)((row & 15) * 32 + (gcol & 31)); }
struct EpiInproj {
    static constexpr bool PERM = true; static constexpr bool HORNER = false;
    bf16_t* zmix; unsigned char* zgate; unsigned* kn;
    __device__ __forceinline__ void operator()(const f32x4 (&acc)[2][2][4][2], const Unit& u, int wr, int wc, int fr, int fq) const {
        if (u.pn == C_K / BM || u.pn == C_K / BM + 1) {
#pragma unroll
            for (int bj = 0; bj < 2; ++bj) { float mx = 0.f;
#pragma unroll
                for (int ai = 0; ai < 2; ++ai)
#pragma unroll
                    for (int m = 0; m < 4; ++m) { const f32x4 a = acc[ai][bj][m][0], b = acc[ai][bj][m][1];
                        float q2 = (a[0] * a[0] + a[1] * a[1]) + (a[2] * a[2] + a[3] * a[3]) + (b[0] * b[0] + b[1] * b[1]) + (b[2] * b[2] + b[3] * b[3]);
                        q2 += __shfl_xor(q2, 16); q2 += __shfl_xor(q2, 32); mx = fmaxf(mx, q2); }
#pragma unroll
                for (int o = 1; o < 16; o <<= 1) mx = fmaxf(mx, __shfl_xor(mx, o));
                if ((threadIdx.x & 63) == 0) atomicMax(kn + ((u.pn - C_K / BM) * 2 + bj) * 4 + wc, __float_as_uint(mx)); }
        }
        const int row0 = u.pm * BM + wr * 64 + fr; int colt = u.pn * BM; const bool gate = colt >= NMIX;
        if (gate) {
            const int col0 = colt - NMIX + wc * 32 + 8 * fq;
#pragma unroll
            for (int ai = 0; ai < 2; ++ai)
#pragma unroll
                for (int m = 0; m < 4; ++m) { const int grow = row0 + ai * HALF + m * 16;
#pragma unroll
                    for (int bj = 0; bj < 2; ++bj) { const f32x4 v0 = acc[ai][bj][m][0], v1 = acc[ai][bj][m][1]; unsigned w0 = 0u, w1 = 0u;
#pragma unroll
                        for (int e = 0; e < 4; ++e) { w0 = __builtin_amdgcn_cvt_pk_u8_f32(__builtin_truncf(sigmoid_f(v0[e]) * 255.f + 0.5f), e, w0);
                                                      w1 = __builtin_amdgcn_cvt_pk_u8_f32(__builtin_truncf(sigmoid_f(v1[e]) * 255.f + 0.5f), e, w1); }
                        *(u32x2*)(zgate + gate_off(grow, col0 + bj * HALF)) = (u32x2){w0, w1}; } }
            return;
        }
        bf16_t* base = zmix; const int ldc = NMIX;
        const int col0 = colt + wc * 32 + 8 * fq;
#pragma unroll
        for (int ai = 0; ai < 2; ++ai)
#pragma unroll
            for (int m = 0; m < 4; ++m) { bf16_t* rowp = base + (size_t)(row0 + ai * HALF + m * 16) * ldc + col0;
#pragma unroll
                for (int bj = 0; bj < 2; ++bj) { const f32x4 v0 = acc[ai][bj][m][0], v1 = acc[ai][bj][m][1];
                    u32x4 w; w.x = cvtpk(v0[0], v0[1]); w.y = cvtpk(v0[2], v0[3]); w.z = cvtpk(v1[0], v1[1]); w.w = cvtpk(v1[2], v1[3]);
                    *(u32x4*)(rowp + bj * HALF) = w; } }
    }
};
struct EpiBf16 {
    static constexpr bool PERM = true; static constexpr bool HORNER = false;
    bf16_t* O; int ldc;
    __device__ __forceinline__ void operator()(const f32x4 (&acc)[2][2][4][2], const Unit& u, int wr, int wc, int fr, int fq) const {
        const int row0 = u.pm * BM + wr * 64 + fr; const int col0 = u.pn * BM + wc * 32 + 8 * fq;
#pragma unroll
        for (int ai = 0; ai < 2; ++ai)
#pragma unroll
            for (int m = 0; m < 4; ++m) { bf16_t* rowp = O + (size_t)(row0 + ai * HALF + m * 16) * ldc + col0;
#pragma unroll
                for (int bj = 0; bj < 2; ++bj) { const f32x4 v0 = acc[ai][bj][m][0], v1 = acc[ai][bj][m][1];
                    u32x4 w; w.x = cvtpk(v0[0], v0[1]); w.y = cvtpk(v0[2], v0[3]); w.z = cvtpk(v1[0], v1[1]); w.w = cvtpk(v1[2], v1[3]);
                    *(u32x4*)(rowp + bj * HALF) = w; } }
    }
};
struct EpiMerge {
    static constexpr bool PERM = true; static constexpr bool HORNER = true;
    const unsigned char* G; bf16_t* merged;
    __device__ __forceinline__ bool scale(f32x4 (&acc)[2][2][4][2], const Unit& u, int wr, int wc, int fr, int fq) const {
        const int n = u.aco >> 9; const int col0 = u.pn * BM + wc * 32 + 8 * fq; const bool last = (n == 3);
#pragma unroll
        for (int ai = 0; ai < 2; ++ai) {
            u32x2 gw[4][2], gx[4][2];
#pragma unroll
            for (int m = 0; m < 4; ++m) { const int r = u.pm * BM + ai * HALF + wr * 64 + m * 16 + fr;
#pragma unroll
                for (int bj = 0; bj < 2; ++bj) { const int c = col0 + bj * HALF;
                    gw[m][bj] = *(const u32x2*)(G + gate_off(r, n * DM + c));
                    gx[m][bj] = last ? gw[m][bj] : *(const u32x2*)(G + gate_off(r, (n + 1) * DM + c)); } }
#pragma unroll
            for (int m = 0; m < 4; ++m) { const int r = u.pm * BM + ai * HALF + wr * 64 + m * 16 + fr;
#pragma unroll
                for (int bj = 0; bj < 2; ++bj) { const int c = col0 + bj * HALF; const u32x2 g = gw[m][bj], x = gx[m][bj];
                    f32x4 v0 = acc[ai][bj][m][0], v1 = acc[ai][bj][m][1];
#pragma unroll
                    for (int e = 0; e < 4; ++e) {
                        const float k0 = fmaxf((float)((g.x >> (8 * e)) & 0xffu), 1.f), k1 = fmaxf((float)((g.y >> (8 * e)) & 0xffu), 1.f);
                        const float d0 = last ? (1.f / 255.f) : __builtin_amdgcn_rcpf(fmaxf((float)((x.x >> (8 * e)) & 0xffu), 1.f));
                        const float d1 = last ? (1.f / 255.f) : __builtin_amdgcn_rcpf(fmaxf((float)((x.y >> (8 * e)) & 0xffu), 1.f));
                        v0[e] *= k0 * d0; v1[e] *= k1 * d1; }
                    if (last) { u32x4 w; w.x = cvtpk(v0[0], v0[1]); w.y = cvtpk(v0[2], v0[3]); w.z = cvtpk(v1[0], v1[1]); w.w = cvtpk(v1[2], v1[3]);
                        *(u32x4*)(merged + (size_t)r * DM + c) = w; }
                    else { acc[ai][bj][m][0] = v0; acc[ai][bj][m][1] = v1; } } }
        }
        return !last;
    }
};
struct EpiResNorm {
    static constexpr bool PERM = true; static constexpr bool HORNER = false;
    const float* base; const bf16_t* po; float* h; const float* gain; bf16_t* xn; unsigned char* hn8; float* part;
    __device__ __forceinline__ void operator()(const f32x4 (&acc)[2][2][4][2], const Unit& u, int wr, int wc, int fr, int fq) const {
        const int col0 = u.pn * BM + wc * 32 + 8 * fq;
        f32x4 gv[2][2];
#pragma unroll
        for (int bj = 0; bj < 2; ++bj) { gv[bj][0] = *(const f32x4*)(gain + col0 + bj * HALF); gv[bj][1] = *(const f32x4*)(gain + col0 + bj * HALF + 4); }
#pragma unroll
        for (int ai = 0; ai < 2; ++ai)
#pragma unroll
            for (int mp2 = 0; mp2 < 2; ++mp2) {
                f32x4 bv[2][2][2]; u32x4 pv[2][2];
#pragma unroll
                for (int mm = 0; mm < 2; ++mm) { const int r = u.pm * BM + ai * HALF + wr * 64 + (mp2 * 2 + mm) * 16 + fr;
#pragma unroll
                    for (int bj = 0; bj < 2; ++bj) { const f32x4* bp = (const f32x4*)(base + (size_t)r * DM + col0 + bj * HALF); bv[mm][bj][0] = bp[0]; bv[mm][bj][1] = bp[1];
                        pv[mm][bj] = (u32x4){0u, 0u, 0u, 0u}; if (po) pv[mm][bj] = *(const u32x4*)(po + (size_t)r * DM + col0 + bj * HALF); } }
#pragma unroll
                for (int mm = 0; mm < 2; ++mm) { const int m = mp2 * 2 + mm; const int r = u.pm * BM + ai * HALF + wr * 64 + m * 16 + fr; float q2 = 0.f;
#pragma unroll
                    for (int bj = 0; bj < 2; ++bj) { const size_t off = (size_t)r * DM + col0 + bj * HALF; const u32x4 pw_ = pv[mm][bj];
                        const f32x4 v0 = bv[mm][bj][0] + acc[ai][bj][m][0] + (f32x4){bflo(pw_.x), bfhi(pw_.x), bflo(pw_.y), bfhi(pw_.y)}, v1 = bv[mm][bj][1] + acc[ai][bj][m][1] + (f32x4){bflo(pw_.z), bfhi(pw_.z), bflo(pw_.w), bfhi(pw_.w)};
                        f32x4* hp = (f32x4*)(h + off); hp[0] = v0; hp[1] = v1;
                        q2 += (v0[0] * v0[0] + v0[1] * v0[1]) + (v0[2] * v0[2] + v0[3] * v0[3]) + (v1[0] * v1[0] + v1[1] * v1[1]) + (v1[2] * v1[2] + v1[3] * v1[3]);
                        const f32x4 y0 = v0 * gv[bj][0], y1 = v1 * gv[bj][1];
                        u32x4 w; w.x = cvtpk(y0[0], y0[1]); w.y = cvtpk(y0[2], y0[3]); w.z = cvtpk(y1[0], y1[1]); w.w = cvtpk(y1[2], y1[3]);
                        *(u32x4*)(xn + off) = w;
                        int f0 = __builtin_amdgcn_cvt_pk_fp8_f32(clamp8(y0[0]), clamp8(y0[1]), 0, false); f0 = __builtin_amdgcn_cvt_pk_fp8_f32(clamp8(y0[2]), clamp8(y0[3]), f0, true);
                        int f1 = __builtin_amdgcn_cvt_pk_fp8_f32(clamp8(y1[0]), clamp8(y1[1]), 0, false); f1 = __builtin_amdgcn_cvt_pk_fp8_f32(clamp8(y1[2]), clamp8(y1[3]), f1, true);
                        *(u32x2*)(hn8 + off) = (u32x2){(unsigned)f0, (unsigned)f1}; }
                    q2 += __shfl_xor(q2, 16); q2 += __shfl_xor(q2, 32);
                    if (fq == 0) part[(size_t)r * 32 + u.pn * 4 + wc] = q2; }
            }
    }
};
__device__ __forceinline__ float row_rs(const float* part, int r) {
    const f32x4* pp = (const f32x4*)(part + (size_t)r * 32); float s = 0.f;
#pragma unroll
    for (int k = 0; k < 8; ++k) { const f32x4 v = pp[k]; s += v[0]; s += v[1]; s += v[2]; s += v[3]; }
    return __builtin_amdgcn_rsqf(s * (1.f / DM) + EPS);
}
struct EpiScaleBf16 {
    static constexpr bool PERM = true; static constexpr bool HORNER = false;
    bf16_t* O; int ldc; const float* part; const LAS float* rstab; int tab_pm;
    __device__ __forceinline__ void operator()(const f32x4 (&acc)[2][2][4][2], const Unit& u, int wr, int wc, int fr, int fq) const {
        const int row0 = u.pm * BM + wr * 64 + fr; const int col0 = u.pn * BM + wc * 32 + 8 * fq;
#pragma unroll
        for (int ai = 0; ai < 2; ++ai)
#pragma unroll
            for (int m = 0; m < 4; ++m) { const int r = row0 + ai * HALF + m * 16; bf16_t* rowp = O + (size_t)r * ldc + col0;
                const float rs = (u.pm == tab_pm) ? rstab[r - u.pm * BM] : row_rs(part, r);
#pragma unroll
                for (int bj = 0; bj < 2; ++bj) { const f32x4 v0 = acc[ai][bj][m][0] * rs, v1 = acc[ai][bj][m][1] * rs;
                    u32x4 w; w.x = cvtpk(v0[0], v0[1]); w.y = cvtpk(v0[2], v0[3]); w.z = cvtpk(v1[0], v1[1]); w.w = cvtpk(v1[2], v1[3]);
                    *(u32x4*)(rowp + bj * HALF) = w; } }
    }
};
}

namespace fa {
constexpr float SCALE = 0.08838834764831845f, INV_SCALE = 11.313708498984761f, THR = 8.f;
constexpr int QBLK = 32, KVBLK = 64, QB = 256;
constexpr int SHM_V = KVBLK * 128 * 2, SHM_K = KVBLK * 128 * 2;
constexpr int OFF_V = 0, OFF_K = 2 * SHM_V, OFF_FK = OFF_K + 2 * SHM_K, OFF_WS = OFF_FK + 2 * 64 * 4;
#define KSWZ(row, colB) ((row) * 256 + ((colB) ^ (((row) & 7) << 4)))
#define SBAR() __builtin_amdgcn_sched_barrier(0)
__device__ __forceinline__ int v_st(int k, int c) { const int kk = (k & ~0xC) | ((k & 4) << 1) | ((k & 8) >> 1); return ((kk >> 3) * 4 + (c >> 5)) * 512 + ((kk & 7) * 32 + (c & 31)) * 2; }
__device__ __forceinline__ int v_rd_base(int lane) { return ((lane & 3) << 3) | (((lane >> 2) & 3) << 6) | (((lane >> 4) & 1) << 5) | (((lane >> 5) & 1) << 8); }
constexpr int v_rd_off(int d0, int ks, int half) { return d0 * 512 + ks * 4096 + half * 2048; }
__device__ __forceinline__ int crow(int r, int hi) { return (r & 3) + 8 * (r >> 2) + 4 * hi; }
__device__ __forceinline__ void mask_tile(f32x16& p0, f32x16& p1, int dq) {
    const float NEG = -__builtin_inff();
#pragma unroll
    for (int r = 0; r < 16; ++r) {
        const int c = (r & 3) + 8 * (r >> 2);
        if (dq - c < 0) p0[r] = NEG;
        if (dq - c - 32 < 0) p1[r] = NEG;
    }
}
__device__ __forceinline__ void partialSM(f32x16& p0, f32x16& p1, float& m_reg, float& mn, float& alpha) {
    float pmax = p0[0];
#pragma unroll
    for (int r = 1; r < 16; ++r) pmax = fmaxf(pmax, p0[r]);
#pragma unroll
    for (int r = 0; r < 16; ++r) pmax = fmaxf(pmax, p1[r]);
    { auto rr = __builtin_amdgcn_permlane32_swap(__float_as_uint(pmax), __float_as_uint(pmax), false, false);
      pmax = fmaxf(__uint_as_float(rr[0]), __uint_as_float(rr[1])); }
    constexpr float C2 = 1.4426950408889634f * SCALE;
    if (__builtin_expect(__all((pmax - m_reg) * SCALE <= THR), 1)) { mn = m_reg; alpha = 1.f; }
    else { mn = fmaxf(m_reg, pmax); alpha = __builtin_amdgcn_exp2f((m_reg - mn) * C2); m_reg = mn; }
    const float mnL = -mn * C2;
#pragma unroll
    for (int r = 0; r < 16; ++r) p0[r] = fmaf(p0[r], C2, mnL);
#pragma unroll
    for (int r = 0; r < 16; ++r) p1[r] = fmaf(p1[r], C2, mnL);
#pragma unroll
    for (int r = 0; r < 16; ++r) p0[r] = __builtin_amdgcn_exp2f(p0[r]);
}
__device__ __forceinline__ void finishSM(f32x16& p0, f32x16& p1, float alpha, float& l_reg, bf16x8& pa0, bf16x8& pa1, bf16x8& pa2, bf16x8& pa3) {
#pragma unroll
    for (int r = 0; r < 16; ++r) p1[r] = __builtin_amdgcn_exp2f(p1[r]);
    float ps = 0;
#pragma unroll
    for (int r = 0; r < 16; ++r) ps += p0[r];
#pragma unroll
    for (int r = 0; r < 16; ++r) ps += p1[r];
    { auto rr = __builtin_amdgcn_permlane32_swap(__float_as_uint(ps), __float_as_uint(ps), false, false);
      ps = __uint_as_float(rr[0]) + __uint_as_float(rr[1]); }
    l_reg = l_reg * alpha + ps;
#define PK4(P, B_, OUT) do { unsigned a0 = cvtpk(P[B_+0], P[B_+1]), a1 = cvtpk(P[B_+2], P[B_+3]);                          \
        unsigned b0 = cvtpk(P[B_+4], P[B_+5]), b1 = cvtpk(P[B_+6], P[B_+7]);                                             \
        auto r0 = __builtin_amdgcn_permlane32_swap(a0, b0, false, false); auto r1 = __builtin_amdgcn_permlane32_swap(a1, b1, false, false); \
        u32x4 w = {r0[0], r1[0], r0[1], r1[1]}; OUT = *reinterpret_cast<bf16x8*>(&w); } while (0)
    PK4(p0, 0, pa0); PK4(p0, 8, pa1); PK4(p1, 0, pa2); PK4(p1, 8, pa3);
#undef PK4
}
__device__ __forceinline__ void qkt(f32x16& p0, f32x16& p1, const LAS char* kbuf, const LAS float* fk, float Fq, int r32, int hi, const bf16x8* qr) {
#pragma unroll
    for (int a = 0; a < 4; ++a) { const f32x4 f0 = *(const LAS f32x4*)(fk + 8 * a + 4 * hi), f1 = *(const LAS f32x4*)(fk + 32 + 8 * a + 4 * hi);
#pragma unroll
        for (int b = 0; b < 4; ++b) { p0[4 * a + b] = (Fq - f0[b]) * INV_SCALE; p1[4 * a + b] = (Fq - f1[b]) * INV_SCALE; } }
    const LAS char* kb[4];
#pragma unroll
    for (int dd = 0; dd < 4; ++dd) kb[dd] = kbuf + KSWZ(r32, (dd * 16 + hi * 8) * 2);
#pragma unroll
    for (int d0 = 0; d0 < 8; ++d0) { const LAS char* a = kb[d0 & 3] + (d0 >> 2) * 128;
        bf16x8 b0 = *reinterpret_cast<const LAS bf16x8*>(a);
        bf16x8 b1 = *reinterpret_cast<const LAS bf16x8*>(a + 32 * 256);
        p0 = __builtin_amdgcn_mfma_f32_32x32x16_bf16(b0, qr[d0], p0, 0, 0, 0);
        p1 = __builtin_amdgcn_mfma_f32_32x32x16_bf16(b1, qr[d0], p1, 0, 0, 0); }
}
__device__ __forceinline__ void pv_tile(f32x16* o, int vb0, bf16x8 pa0, bf16x8 pa1, bf16x8 pa2, bf16x8 pa3) {
#define TRRD(dst, off) asm volatile("ds_read_b64_tr_b16 %0, %1 offset:%2" : "=&v"(dst) : "v"(vb0), "i"(off) : "memory")
#define PV_D0(d0) do { s16x4 l0, l1, l2, l3, h0, h1, h2, h3; constexpr int b_ = v_rd_off(d0, 0, 0); \
        TRRD(l0, b_); TRRD(h0, b_ + 2048); TRRD(l1, b_ + 4096); TRRD(h1, b_ + 6144); TRRD(l2, b_ + 8192); TRRD(h2, b_ + 10240); TRRD(l3, b_ + 12288); TRRD(h3, b_ + 14336); \
        asm volatile("s_waitcnt lgkmcnt(0)" ::: "memory"); SBAR();   \
        o[d0] = __builtin_amdgcn_mfma_f32_32x32x16_bf16(pa0, (bf16x8){l0[0], l0[1], l0[2], l0[3], h0[0], h0[1], h0[2], h0[3]}, o[d0], 0, 0, 0);   \
        o[d0] = __builtin_amdgcn_mfma_f32_32x32x16_bf16(pa1, (bf16x8){l1[0], l1[1], l1[2], l1[3], h1[0], h1[1], h1[2], h1[3]}, o[d0], 0, 0, 0);   \
        o[d0] = __builtin_amdgcn_mfma_f32_32x32x16_bf16(pa2, (bf16x8){l2[0], l2[1], l2[2], l2[3], h2[0], h2[1], h2[2], h2[3]}, o[d0], 0, 0, 0);   \
        o[d0] = __builtin_amdgcn_mfma_f32_32x32x16_bf16(pa3, (bf16x8){l3[0], l3[1], l3[2], l3[3], h3[0], h3[1], h3[2], h3[3]}, o[d0], 0, 0, 0); } while (0)
    PV_D0(0); PV_D0(1); PV_D0(2); PV_D0(3);
#undef PV_D0
#undef TRRD
}
__device__ __forceinline__ void attn_unit(const bf16_t* __restrict__ zmix, const float* __restrict__ Fh, bf16_t* __restrict__ br, int g, int qb, float kn2, LAS char* lds) {
    const int tid = ltid(), wid = __builtin_amdgcn_readfirstlane(tid >> 6), lane = tid & 63, r32 = lane & 31, hi = lane >> 5;
    const bf16_t* Zq = zmix + C_Q + g * 128; const bf16_t* Zk = zmix + C_K + g * 128; const bf16_t* Zv = zmix + C_V + g * 128;
    const int P0 = qb * QB, j_hi = (P0 + QB) / KVBLK;
    const int qlo = P0 + wid * QBLK, qm = qlo + r32 - 4 * hi;
    LAS char* V_lds = lds + OFF_V; LAS char* K_lds = lds + OFF_K; LAS float* FK_lds = (LAS float*)(lds + OFF_FK);
    LAS float* wsf = (LAS float*)(lds + OFF_WS) + wid * 64; LAS float* li_l = wsf; LAS float* al_l = wsf + 32;
    bf16x8 qr[8];
#pragma unroll
    for (int d0 = 0; d0 < 8; ++d0) qr[d0] = *(const bf16x8*)(Zq + (size_t)(qlo + r32) * NMIX + d0 * 16 + hi * 8);
    const float Fq = Fh[qlo + r32];
    int j_lo; float qrow2;
    {
        float qs = 0.f;
#pragma unroll
        for (int d0 = 0; d0 < 8; ++d0)
#pragma unroll
            for (int e = 0; e < 8; ++e) { const float v = bf1((bf16_t)qr[d0][e]); qs = fmaf(v, v, qs); }
        { auto rr = __builtin_amdgcn_permlane32_swap(__float_as_uint(qs), __float_as_uint(qs), false, false); qs = __uint_as_float(rr[0]) + __uint_as_float(rr[1]); }
        qrow2 = qs;
#pragma unroll
        for (int o_ = 1; o_ < 32; o_ <<= 1) qs = fmaxf(qs, __shfl_xor(qs, o_));
        LAS float* red = (LAS float*)(lds + OFF_WS);
        __syncthreads();
        if (lane == 0) red[wid] = qs;
        __syncthreads();
        float qn2 = red[0];
#pragma unroll
        for (int w = 1; w < 8; ++w) qn2 = fmaxf(qn2, red[w]);
        const float B2 = 2.f * sqrtf(qn2 * kn2) * SCALE * 1.01f + 0.5f;
        const float thr = -18.f - B2 - Fh[P0];
        const int ndiag0 = P0 / KVBLK;
        int cntskip = 0;
        if (tid < 128) { const bool sk = (tid < ndiag0) && (-Fh[tid * KVBLK + KVBLK - 1] < thr); const unsigned long long bal = __ballot(sk); cntskip = __popcll(bal); }
        __syncthreads();
        if (tid == 0 || tid == 64) red[8 + (tid >> 6)] = (float)cntskip;
        __syncthreads();
        j_lo = (int)(red[8] + red[9]);
        __syncthreads();
    }
    float m_reg = -1e30f, l_reg = 0.f; f32x16 o[4];
#pragma unroll
    for (int d = 0; d < 4; ++d)
#pragma unroll
        for (int r = 0; r < 16; ++r) o[d][r] = 0.f;
    const int sr = tid >> 4, sc = (tid & 15) * 8, vst0 = v_st(sr, sc), vst1 = v_st(32 + sr, sc), kws = KSWZ(sr, sc * 2);
    const int vbase = (int)(uintptr_t)V_lds + v_rd_base(lane);
    bf16x8 st_k0, st_k1, st_v0, st_v1; float st_f = 0.f;
#define SLOAD(kb) do { st_k0 = *(const bf16x8*)(Zk + (size_t)((kb) + sr) * NMIX + sc); st_k1 = *(const bf16x8*)(Zk + (size_t)((kb) + 32 + sr) * NMIX + sc); \
                       st_v0 = *(const bf16x8*)(Zv + (size_t)((kb) + sr) * NMIX + sc); st_v1 = *(const bf16x8*)(Zv + (size_t)((kb) + 32 + sr) * NMIX + sc); \
                       if (tid < 64) st_f = Fh[(kb) + tid]; } while (0)
#define SWRITE(bf) do { *(LAS bf16x8*)(K_lds + (bf) * SHM_K + kws) = st_k0; *(LAS bf16x8*)(K_lds + (bf) * SHM_K + kws + 32 * 256) = st_k1; \
                        *(LAS bf16x8*)(V_lds + (bf) * SHM_V + vst0) = st_v0; *(LAS bf16x8*)(V_lds + (bf) * SHM_V + vst1) = st_v1; \
                        if (tid < 64) FK_lds[(bf) * 64 + tid] = st_f; } while (0)
    const float cbase = -(sqrtf(qrow2 * kn2) * SCALE * 1.01f + 0.25f) - Fq;
    LAS float* stopm = (LAS float*)(lds + OFF_WS + 2048);
    __syncthreads();
    int j = j_hi - 1;
    SLOAD(j * KVBLK); SWRITE(0);
    __syncthreads();
    f32x16 p0, p1; float mn, alpha; bf16x8 pa0, pa1, pa2, pa3;
    for (int t = 0;; ++t) {
        const int buf = t & 1, kb = j * KVBLK; const bool has_next = j > j_lo;
        if (has_next) SLOAD(kb - KVBLK);
        if (kb <= qlo + QBLK - 1) {
            qkt(p0, p1, K_lds + buf * SHM_K, FK_lds + buf * 64, Fq, r32, hi, qr);
            if (kb + KVBLK - 1 > qlo) mask_tile(p0, p1, qm - kb);
            partialSM(p0, p1, m_reg, mn, alpha);
            if (__any(alpha < 1.f)) { if (hi == 0) al_l[r32] = alpha; asm volatile("s_waitcnt lgkmcnt(0)" ::: "memory");
#pragma unroll
                for (int d_ = 0; d_ < 4; ++d_)
#pragma unroll
                    for (int r = 0; r < 16; ++r) o[d_][r] *= al_l[crow(r, hi)]; }
            finishSM(p0, p1, alpha, l_reg, pa0, pa1, pa2, pa3);
            pv_tile(o, vbase + buf * SHM_V, pa0, pa1, pa2, pa3);
        }
        float cm = fmaf(m_reg, SCALE, cbase);
#pragma unroll
        for (int o_ = 1; o_ < 32; o_ <<= 1) cm = fminf(cm, __shfl_xor(cm, o_));
        if (lane == 0) stopm[buf * 8 + wid] = cm;
        if (has_next) SWRITE(buf ^ 1);
        __syncthreads();
        if (!has_next) break;
        float cmin = stopm[buf * 8];
#pragma unroll
        for (int w = 1; w < 8; ++w) cmin = fminf(cmin, stopm[buf * 8 + w]);
        if (cmin >= 18.f - FK_lds[(buf ^ 1) * 64 + 63]) break;
        --j;
    }
#undef SLOAD
#undef SWRITE
    if (hi == 0) li_l[r32] = l_reg; asm volatile("s_waitcnt lgkmcnt(0)" ::: "memory");
    float rli[16];
#pragma unroll
    for (int r = 0; r < 16; ++r) rli[r] = __builtin_amdgcn_rcpf(li_l[crow(r, hi)]);
    bf16_t* Ow = br + (size_t)qlo * DM + 3 * BWID + g * 128;
#pragma unroll
    for (int r = 0; r < 16; ++r) { const int orow = crow(r, hi);
#pragma unroll
        for (int d0 = 0; d0 < 4; ++d0) { const float v = o[d0][r] * rli[r]; const float vn = __shfl_xor(v, 1);
            if ((r32 & 1) == 0) *(unsigned*)(Ow + (size_t)orow * DM + d0 * 32 + r32) = cvtpk(v, vn); } }
}
}

namespace mix {
constexpr int VR_STRIDE = 520;
constexpr int PL_STRIDE = 520;
__device__ __forceinline__ void unpk8(const u32x4 w, float (&f)[8]) { f[0] = bflo(w.x); f[1] = bfhi(w.x); f[2] = bflo(w.y); f[3] = bfhi(w.y); f[4] = bflo(w.z); f[5] = bfhi(w.z); f[6] = bflo(w.w); f[7] = bfhi(w.w); }
__device__ __forceinline__ void conv_item(const Params& p, int l, int t0) {
    const int tid = ltid(), cc = tid & 63, tg = tid >> 6, c = cc * 8, tf = t0 + tg * 16;
    const float* cw = p.conv_w + (size_t)l * 3 * BWID + c;
    float w[3][8];
#pragma unroll
    for (int j = 0; j < 3; ++j) { const f32x4 a = *(const f32x4*)(cw + j * BWID), b = *(const f32x4*)(cw + j * BWID + 4);
        w[j][0] = a[0]; w[j][1] = a[1]; w[j][2] = a[2]; w[j][3] = a[3]; w[j][4] = b[0]; w[j][5] = b[1]; w[j][6] = b[2]; w[j][7] = b[3]; }
    const bf16_t* zb = p.zmix + C_A + c; const bf16_t* zc = zb + BWID; const bf16_t* zh = zb + 2 * BWID;
    float z2[8], z1[8];
    { u32x4 c2 = {0u, 0u, 0u, 0u}, h2 = c2, c1 = c2, h1 = c2;
      if (tf >= 2) { c2 = *(const u32x4*)(zc + (size_t)(tf - 2) * NMIX); h2 = *(const u32x4*)(zh + (size_t)(tf - 2) * NMIX); }
      if (tf >= 1) { c1 = *(const u32x4*)(zc + (size_t)(tf - 1) * NMIX); h1 = *(const u32x4*)(zh + (size_t)(tf - 1) * NMIX); }
      float a[8], b[8]; unpk8(c2, a); unpk8(h2, b);
#pragma unroll
      for (int e = 0; e < 8; ++e) z2[e] = a[e] * b[e];
      unpk8(c1, a); unpk8(h1, b);
#pragma unroll
      for (int e = 0; e < 8; ++e) z1[e] = a[e] * b[e]; }
#pragma unroll 1
    for (int hb = 0; hb < 2; ++hb) {
        u32x4 cv[8], hv[8], bv[8];
#pragma unroll
        for (int i = 0; i < 8; ++i) { const size_t ro = (size_t)(tf + hb * 8 + i) * NMIX; cv[i] = *(const u32x4*)(zc + ro); hv[i] = *(const u32x4*)(zh + ro); bv[i] = *(const u32x4*)(zb + ro); }
#pragma unroll
        for (int i = 0; i < 8; ++i) { float a[8], b[8], g[8], y[8]; unpk8(cv[i], a); unpk8(hv[i], b); unpk8(bv[i], g);
#pragma unroll
            for (int e = 0; e < 8; ++e) { const float z0 = a[e] * b[e]; y[e] = g[e] * (w[0][e] * z2[e] + w[1][e] * z1[e] + w[2][e] * z0); z2[e] = z1[e]; z1[e] = z0; }
            u32x4 o; o.x = pk2(y[0], y[1]); o.y = pk2(y[2], y[3]); o.z = pk2(y[4], y[5]); o.w = pk2(y[6], y[7]);
            *(u32x4*)(p.br + (size_t)(tf + hb * 8 + i) * DM + c) = o; }
    }
}
__device__ __forceinline__ void sgu_item(const Params& p, int l, int t0, LAS unsigned char* lds) {
    const int tid = ltid(), wid = __builtin_amdgcn_readfirstlane(tid >> 6), lane = tid & 63, fr = lane & 15, fq = lane >> 4;
    LAS bf16_t* VR = (LAS bf16_t*)lds;
    __syncthreads();
    {
        const float* ngp = p.sgu_norm_g + (size_t)l * BWID + 8 * lane; const f32x4 n0 = *(const f32x4*)ngp, n1 = *(const f32x4*)(ngp + 4);
        const float ng[8] = {n0[0], n0[1], n0[2], n0[3], n1[0], n1[1], n1[2], n1[3]};
        u32x4 zr[16];
#pragma unroll
        for (int i = 0; i < 16; ++i) zr[i] = *(const u32x4*)(p.zmix + (size_t)(t0 + wid * 16 + i) * NMIX + C_B + BWID + 8 * lane);
#pragma unroll
        for (int i = 0; i < 16; ++i) { float v[8]; unpk8(zr[i], v); float ss = 0.f;
#pragma unroll
            for (int e = 0; e < 8; ++e) { v[e] = gelu_t(v[e]); ss += v[e] * v[e]; }
            const float rstd = __builtin_amdgcn_rsqf(wave_sum(ss) * (1.f / BWID) + EPS);
            u32x4 o; o.x = pk2(v[0] * rstd * ng[0], v[1] * rstd * ng[1]); o.y = pk2(v[2] * rstd * ng[2], v[3] * rstd * ng[3]);
            o.z = pk2(v[4] * rstd * ng[4], v[5] * rstd * ng[5]); o.w = pk2(v[6] * rstd * ng[6], v[7] * rstd * ng[7]);
            *(LAS u32x4*)(VR + (wid * 16 + i) * VR_STRIDE + 8 * lane) = o; }
    }
    __syncthreads();
    const int g = wid >> 1, dh = wid & 1;
    const int q4 = (lane & 15) >> 2, pl = lane & 3;
    const int vb0 = (int)(uintptr_t)VR + (fq * 8 + q4) * (VR_STRIDE * 2) + (g * 128 + dh * 64 + pl * 4) * 2, vb1 = vb0 + 64 * VR_STRIDE * 2;
    bf16x8 X[4][4];
#define TRX(dst, base, off) asm volatile("ds_read_b64_tr_b16 %0, %1 offset:%2" : "=&v"(dst) : "v"(base), "i"(off) : "memory")
#pragma unroll
    for (int xb = 0; xb < 4; ++xb)
#pragma unroll
        for (int ks = 0; ks < 4; ++ks) { s16x4 lo, hi; constexpr int RB = VR_STRIDE * 2;
            if (ks < 2) { TRX(lo, vb0, xb * 32 + (ks & 1) * 32 * RB); TRX(hi, vb0, xb * 32 + (ks & 1) * 32 * RB + 4 * RB); }
            else        { TRX(lo, vb1, xb * 32 + (ks & 1) * 32 * RB); TRX(hi, vb1, xb * 32 + (ks & 1) * 32 * RB + 4 * RB); }
            asm volatile("s_waitcnt lgkmcnt(0)" ::: "memory");
            X[xb][ks] = (bf16x8){lo[0], lo[1], lo[2], lo[3], hi[0], hi[1], hi[2], hi[3]}; }
#undef TRX
    const bf16_t* W = p.sguW + ((size_t)l * 4 + g) * 128 * 128;
    const float* bias = p.sgu_b + ((size_t)l * 4 + g) * 128;
#pragma unroll 1
    for (int tp = 0; tp < 4; ++tp) {
        bf16x8 Y[2][4]; u32x2 uw[2][4]; float bs[2];
#pragma unroll
        for (int h2 = 0; h2 < 2; ++h2) { const int t = (tp * 2 + h2) * 16 + fr; bs[h2] = bias[t];
#pragma unroll
            for (int ks = 0; ks < 4; ++ks) Y[h2][ks] = *(const bf16x8*)(W + (size_t)t * 128 + ks * 32 + fq * 8);
#pragma unroll
            for (int xb = 0; xb < 4; ++xb) uw[h2][xb] = *(const u32x2*)(p.zmix + (size_t)(t0 + t) * NMIX + C_B + g * 128 + dh * 64 + xb * 16 + 4 * fq); }
#pragma unroll
        for (int h2 = 0; h2 < 2; ++h2) { const int t = (tp * 2 + h2) * 16 + fr;
            f32x4 acc[4];
#pragma unroll
            for (int xb = 0; xb < 4; ++xb) acc[xb] = (f32x4){0.f, 0.f, 0.f, 0.f};
#pragma unroll
            for (int ks = 0; ks < 4; ++ks)
#pragma unroll
                for (int xb = 0; xb < 4; ++xb) acc[xb] = mfma16(X[xb][ks], Y[h2][ks], acc[xb]);
#pragma unroll
            for (int xb = 0; xb < 4; ++xb) { const int c = g * 128 + dh * 64 + xb * 16 + 4 * fq; const u32x2 u_ = uw[h2][xb];
                const float u0 = gelu_t(bflo(u_.x)), u1 = gelu_t(bfhi(u_.x)), u2 = gelu_t(bflo(u_.y)), u3 = gelu_t(bfhi(u_.y));
                u32x2 o; o.x = pk2(u0 * (acc[xb][0] + bs[h2]), u1 * (acc[xb][1] + bs[h2])); o.y = pk2(u2 * (acc[xb][2] + bs[h2]), u3 * (acc[xb][3] + bs[h2]));
                *(u32x2*)(p.br + (size_t)(t0 + t) * DM + BWID + c) = o; } }
    }
}
template <int W>
__device__ __forceinline__ void pool_fill(const bf16_t* zmix, LAS bf16_t* PL, int t0, int th, int lane) {
    constexpr int G = (W == 2) ? 0 : (W == 4) ? 1 : (W == 8) ? 2 : 3;
    const int ccl = lane & 15, ts = lane >> 4, c = G * 128 + ccl * 8;
#pragma unroll 1
    for (int hp = 0; hp < 2; ++hp) {
        const int tl0 = th * 64 + ts * 16 + hp * 8, ta0 = t0 + tl0;
        u32x4 R[8 + W - 1];
#pragma unroll
        for (int k = 0; k < 8 + W - 1; ++k) { const int ta = ta0 - (W - 1) + k; R[k] = (u32x4){0u, 0u, 0u, 0u}; if (ta >= 0) R[k] = *(const u32x4*)(zmix + (size_t)ta * NMIX + C_C + c); }
        float s[8];
#pragma unroll
        for (int e = 0; e < 8; ++e) s[e] = 0.f;
#pragma unroll
        for (int k = 0; k < W - 1; ++k) { float f[8]; unpk8(R[k], f);
#pragma unroll
            for (int e = 0; e < 8; ++e) s[e] += f[e]; }
#pragma unroll
        for (int i = 0; i < 8; ++i) { float f[8], d[8]; unpk8(R[W - 1 + i], f); unpk8(R[i], d);
            const int ta = ta0 + i; const float inv = 1.f / (float)((ta + 1 < W) ? ta + 1 : W);
            float o[8];
#pragma unroll
            for (int e = 0; e < 8; ++e) { s[e] += f[e]; o[e] = s[e] * inv - f[e]; s[e] -= d[e]; }
            u32x4 w; w.x = pk2(o[0], o[1]); w.y = pk2(o[2], o[3]); w.z = pk2(o[4], o[5]); w.w = pk2(o[6], o[7]);
            *(LAS u32x4*)(PL + (tl0 + i) * PL_STRIDE + c) = w; }
    }
}
__device__ __forceinline__ void pool_item(const Params& p, int l, int t0, LAS unsigned char* lds) {
    const int tid = ltid(), wid = __builtin_amdgcn_readfirstlane(tid >> 6), lane = tid & 63, fr = lane & 15, fq = lane >> 4;
    LAS bf16_t* PL = (LAS bf16_t*)lds;
    const int g = wid >> 1, oh = wid & 1;
    const bf16_t* WT = p.poolWT + ((size_t)l * 4 + g) * 128 * 128;
    __syncthreads();
    {
        const int gg = wid & 3, th = wid >> 2;
        if (gg == 0) pool_fill<2>(p.zmix, PL, t0, th, lane); else if (gg == 1) pool_fill<4>(p.zmix, PL, t0, th, lane);
        else if (gg == 2) pool_fill<8>(p.zmix, PL, t0, th, lane); else pool_fill<16>(p.zmix, PL, t0, th, lane);
    }
    bf16x8 X[4][4];
#pragma unroll
    for (int xb = 0; xb < 4; ++xb)
#pragma unroll
        for (int ks = 0; ks < 4; ++ks) X[xb][ks] = *(const bf16x8*)(WT + (size_t)(oh * 64 + xb * 16 + fr) * 128 + ks * 32 + fq * 8);
    __syncthreads();
    const float* sc = p.pool_scale + (size_t)l * BWID + g * 128;
    f32x4 sv[4];
#pragma unroll
    for (int xb = 0; xb < 4; ++xb) sv[xb] = *(const f32x4*)(sc + oh * 64 + xb * 16 + 4 * fq);
#pragma unroll 2
    for (int tb = 0; tb < 8; ++tb) {
        f32x4 acc[4];
#pragma unroll
        for (int xb = 0; xb < 4; ++xb) acc[xb] = (f32x4){0.f, 0.f, 0.f, 0.f};
#pragma unroll
        for (int ks = 0; ks < 4; ++ks) { const bf16x8 Y = *(const LAS bf16x8*)(PL + (tb * 16 + fr) * PL_STRIDE + g * 128 + ks * 32 + fq * 8);
#pragma unroll
            for (int xb = 0; xb < 4; ++xb) acc[xb] = mfma16(X[xb][ks], Y, acc[xb]); }
        const int t = tb * 16 + fr;
#pragma unroll
        for (int xb = 0; xb < 4; ++xb) { const int o0 = oh * 64 + xb * 16 + 4 * fq;
            u32x2 o; o.x = pk2(acc[xb][0] * sv[xb][0], acc[xb][1] * sv[xb][1]); o.y = pk2(acc[xb][2] * sv[xb][2], acc[xb][3] * sv[xb][3]);
            *(u32x2*)(p.br + (size_t)(t0 + t) * DM + 2 * BWID + g * 128 + o0) = o; }
    }
}
}

template <bool FORGET>
__device__ __forceinline__ void norm_phase(const Params& p, int l, const float* hsrc, const bf16_t* po, const float* gain, int gw, int ngw, int lane) {
    f32x4 gv[8], wf[4][8];
#pragma unroll
    for (int j = 0; j < 8; ++j) { gv[j] = ((const f32x4*)gain)[lane + 64 * j];
        if (FORGET) {
#pragma unroll
            for (int g = 0; g < 4; ++g) wf[g][j] = ((const f32x4*)(p.wfg + ((size_t)l * 4 + g) * DM))[lane + 64 * j]; } }
    for (int t = gw; t < SEQ; t += ngw) {
        const f32x4* hr = (const f32x4*)(hsrc + (size_t)t * DM) + lane;
        f32x4 v[8]; float ss = 0.f;
#pragma unroll
        for (int j = 0; j < 8; ++j) v[j] = hr[64 * j];
        if (po) {
#pragma unroll
            for (int j = 0; j < 8; ++j) { const u32x2 w = ((const u32x2*)(po + (size_t)t * DM))[lane + 64 * j]; v[j][0] += bflo(w.x); v[j][1] += bfhi(w.x); v[j][2] += bflo(w.y); v[j][3] += bfhi(w.y); } }
#pragma unroll
        for (int j = 0; j < 8; ++j) ss += (v[j][0] * v[j][0] + v[j][1] * v[j][1]) + (v[j][2] * v[j][2] + v[j][3] * v[j][3]);
        const float rstd = __builtin_amdgcn_rsqf(wave_sum(ss) * (1.f / DM) + EPS);
        float fd[4] = {0.f, 0.f, 0.f, 0.f};
        u32x2* o8 = (u32x2*)(p.xn + (size_t)t * DM) + lane;
#pragma unroll
        for (int j = 0; j < 8; ++j) { const f32x4 y = v[j] * rstd * gv[j];
            u32x2 w; w.x = pk2(y[0], y[1]); w.y = pk2(y[2], y[3]); o8[64 * j] = w;
            if (!FORGET) { int f8 = __builtin_amdgcn_cvt_pk_fp8_f32(clamp8(y[0]), clamp8(y[1]), 0, false); f8 = __builtin_amdgcn_cvt_pk_fp8_f32(clamp8(y[2]), clamp8(y[3]), f8, true);
                ((unsigned*)(p.hn8 + (size_t)t * DM))[lane + 64 * j] = (unsigned)f8; }
            if (FORGET) {
#pragma unroll
                for (int g = 0; g < 4; ++g) fd[g] += (y[0] * wf[g][j][0] + y[1] * wf[g][j][1]) + (y[2] * wf[g][j][2] + y[3] * wf[g][j][3]); } }
        if (FORGET) {
#pragma unroll
            for (int g = 0; g < 4; ++g) { const float z = wave_sum(fd[g]) + p.forget_b[l * 4 + g];
                const float ls = fminf(z, 0.f) - log1pf(__expf(-fabsf(z)));
                if (lane == 0) p.flog[(size_t)t * 4 + g] = ls; } }
    }
}
__device__ __forceinline__ void final_norm_phase(const Params& p, int gw, int ngw, int lane) {
    for (int t = gw; t < SEQ; t += ngw) {
        const f32x4* hr = (const f32x4*)(p.h + (size_t)t * DM) + lane;
        f32x4 v[8]; float ss = 0.f;
#pragma unroll
        for (int j = 0; j < 8; ++j) { v[j] = hr[64 * j]; const u32x2 w = ((const u32x2*)(p.po + (size_t)t * DM))[lane + 64 * j];
            v[j][0] += bflo(w.x); v[j][1] += bfhi(w.x); v[j][2] += bflo(w.y); v[j][3] += bfhi(w.y);
            ss += (v[j][0] * v[j][0] + v[j][1] * v[j][1]) + (v[j][2] * v[j][2] + v[j][3] * v[j][3]); }
        const float rstd = __builtin_amdgcn_rsqf(wave_sum(ss) * (1.f / DM) + EPS);
        f32x4* o = (f32x4*)(p.out + (size_t)t * DM) + lane;
#pragma unroll
        for (int j = 0; j < 8; ++j) o[64 * j] = v[j] * rstd * ((const f32x4*)p.final_g)[lane + 64 * j];
    }
}
__device__ __forceinline__ void cumsum_head(const Params& p, int g, LAS unsigned char* lds) {
    LAS float* part = (LAS float*)lds;
    const int tid = ltid(), lane = tid & 63, wid = tid >> 6;
    float v[16]; float s = 0.f;
#pragma unroll
    for (int j = 0; j < 16; ++j) { v[j] = p.flog[(size_t)(tid * 16 + j) * 4 + g]; s += v[j]; }
    float x = s;
#pragma unroll
    for (int o = 1; o < 64; o <<= 1) { const float y = __shfl_up(x, o); if (lane >= o) x += y; }
    __syncthreads();
    if (lane == 63) part[wid] = x;
    __syncthreads();
    float pre = x - s;
    for (int w = 0; w < wid; ++w) pre += part[w];
#pragma unroll
    for (int j = 0; j < 16; ++j) { pre += v[j]; p.F[(size_t)g * SEQ + tid * 16 + j] = pre; }
    __syncthreads();
}
__device__ __forceinline__ void knorm_phase(const Params& p, int l, int gw, int ngw, int lane) {
    float mx = 0.f;
#pragma unroll 4
    for (int t = gw; t < SEQ; t += ngw) {
        const u32x4 w = *(const u32x4*)(p.zmix + (size_t)t * NMIX + C_K + lane * 8);
        float s = bflo(w.x) * bflo(w.x) + bfhi(w.x) * bfhi(w.x) + bflo(w.y) * bflo(w.y) + bfhi(w.y) * bfhi(w.y)
                + bflo(w.z) * bflo(w.z) + bfhi(w.z) * bfhi(w.z) + bflo(w.w) * bflo(w.w) + bfhi(w.w) * bfhi(w.w);
#pragma unroll
        for (int o = 1; o < 16; o <<= 1) s += __shfl_xor(s, o);
        mx = fmaxf(mx, s);
    }
    if ((lane & 15) == 0) atomicMax(p.ctl + CW_KN + l * 4 + (lane >> 4), __float_as_uint(mx));
}

namespace pro { __device__ __forceinline__ void conv_share(const Params& p, int L, int half, LAS unsigned char* lds); }
namespace peer {
constexpr int S_STRIDE = 129, TL_STRIDE = 17;
constexpr int OFF_TL = 256 * S_STRIDE * 4;
__device__ __forceinline__ float pack_f(float v, unsigned idx, unsigned mask) { return __uint_as_float((__float_as_uint(v) & ~mask) | idx); }
#define CEX_DESC(x, y) do { const float hi_ = fmaxf((x), (y)), lo_ = fminf((x), (y)); (x) = hi_; (y) = lo_; } while (0)
__device__ __forceinline__ void sort16_desc(float (&a)[16]) {
#pragma unroll
    for (int k = 2; k <= 16; k <<= 1)
#pragma unroll
        for (int j = k >> 1; j > 0; j >>= 1)
#pragma unroll
            for (int i = 0; i < 16; ++i) { const int l = i ^ j; if (l > i) { if ((i & k) == 0 || k == 16) { if (k == 16 || (i & k) == 0) CEX_DESC(a[i], a[l]); } else CEX_DESC(a[l], a[i]); } }
}
__device__ __forceinline__ void merge16_desc(float (&r)[16], const float (&c)[16]) {
#pragma unroll
    for (int i = 0; i < 16; ++i) r[i] = fmaxf(r[i], c[15 - i]);
#pragma unroll
    for (int j = 8; j > 0; j >>= 1)
#pragma unroll
        for (int i = 0; i < 16; ++i) { const int l = i ^ j; if (l > i) CEX_DESC(r[i], r[l]); }
}
__device__ __forceinline__ void topk_item(const Params& p, int l, int t0, int hd, LAS unsigned char* lds) {
    const int tid = ltid(), wid = __builtin_amdgcn_readfirstlane(tid >> 6), lane = tid & 63, fr = lane & 15, fq = lane >> 4;
    LAS float* Sc = (LAS float*)lds; LAS float* TL = (LAS float*)(lds + OFF_TL);
    __syncthreads();
    {
        const int pp = wid >> 2, nq = wid & 3;
        const bf16_t* kb = p.keysB + (((size_t)l * 8 + hd) * 2 + pp) * 128 * 128;
        const bf16_t* qb = p.q + (size_t)t0 * DM + hd * 256 + pp * 128;
        bf16x8 X[2][4];
#pragma unroll
        for (int xb = 0; xb < 2; ++xb)
#pragma unroll
            for (int ks = 0; ks < 4; ++ks) X[xb][ks] = *(const bf16x8*)(kb + (size_t)(nq * 32 + xb * 16 + fr) * 128 + ks * 32 + fq * 8);
        bf16x8 Yq[8][4];
#pragma unroll
        for (int tb = 0; tb < 8; ++tb)
#pragma unroll
            for (int ks = 0; ks < 4; ++ks) Yq[tb][ks] = *(const bf16x8*)(qb + (size_t)(tb * 16 + fr) * DM + ks * 32 + fq * 8);
#pragma unroll
        for (int tb = 0; tb < 8; ++tb) {
            f32x4 acc[2] = {(f32x4){0.f, 0.f, 0.f, 0.f}, (f32x4){0.f, 0.f, 0.f, 0.f}};
#pragma unroll
            for (int ks = 0; ks < 4; ++ks) { const bf16x8 Y = Yq[tb][ks];
                acc[0] = mfma16(X[0][ks], Y, acc[0]); acc[1] = mfma16(X[1][ks], Y, acc[1]); }
            LAS float* row = Sc + (pp * 128 + tb * 16 + fr) * S_STRIDE + nq * 32 + 4 * fq;
#pragma unroll
            for (int xb = 0; xb < 2; ++xb)
#pragma unroll
                for (int r = 0; r < 4; ++r) row[xb * 16 + r] = acc[xb][r];
        }
    }
    __syncthreads();
    if (tid < 256) {
        const LAS float* row = Sc + tid * S_STRIDE;
        float L[16];
#pragma unroll
        for (int i = 0; i < 16; ++i) L[i] = pack_f(row[i], (unsigned)i, 127u);
        sort16_desc(L);
#pragma unroll 1
        for (int ch = 1; ch < 8; ++ch) { float C[16];
#pragma unroll
            for (int i = 0; i < 16; ++i) C[i] = pack_f(row[ch * 16 + i], (unsigned)(ch * 16 + i), 127u);
            sort16_desc(C); merge16_desc(L, C); }
#pragma unroll
        for (int i = 0; i < 16; ++i) TL[tid * TL_STRIDE + i] = L[i];
    }
    __syncthreads();
    if (tid < 128) {
        const LAS float* A = TL + tid * TL_STRIDE; const LAS float* B = TL + (128 + tid) * TL_STRIDE;
        float av[16], bv[16];
#pragma unroll
        for (int i = 0; i < 16; ++i) { av[i] = __uint_as_float(__float_as_uint(A[i]) & ~127u); bv[i] = __uint_as_float(__float_as_uint(B[i]) & ~127u); }
        float L[16];
        {   float cand[64]; int nc = 0;
#pragma unroll
            for (int a = 0; a < 16; ++a)
#pragma unroll
                for (int b = 0; b < 16; ++b) if ((a + 1) * (b + 1) <= 16) { cand[nc] = pack_f(av[a] + bv[b], (unsigned)(a * 16 + b), 255u); ++nc; }
#pragma unroll
            for (int i = 50; i < 64; ++i) cand[i] = -__builtin_inff();
#pragma unroll
            for (int i = 0; i < 16; ++i) L[i] = cand[i];
            sort16_desc(L);
#pragma unroll
            for (int ch = 1; ch < 4; ++ch) { float C[16];
#pragma unroll
                for (int i = 0; i < 16; ++i) C[i] = cand[ch * 16 + i];
                sort16_desc(C); merge16_desc(L, C); }
        }
        float val[16]; int ex[16]; float mx = -__builtin_inff();
#pragma unroll
        for (int i = 0; i < 16; ++i) { const unsigned ab = __float_as_uint(L[i]) & 255u; const unsigned ua = __float_as_uint(A[ab >> 4]), ub = __float_as_uint(B[ab & 15]);
            val[i] = __uint_as_float(ua & ~127u) + __uint_as_float(ub & ~127u); ex[i] = (int)((ua & 127u) * 128u + (ub & 127u)); mx = fmaxf(mx, val[i]); }
        float sum = 0.f;
#pragma unroll
        for (int i = 0; i < 16; ++i) { val[i] = __expf(val[i] - mx); sum += val[i]; }
        const float inv = 1.f / sum;
        int* pi = p.pidx + (size_t)(t0 + tid) * 128 + hd * 16; float* pg = p.pgate + (size_t)(t0 + tid) * 128 + hd * 16;
#pragma unroll
        for (int i = 0; i < 16; ++i) { pi[i] = ex[i]; pg[i] = val[i] * inv; }
    }
}
__device__ __forceinline__ void vm_wait_le(int n) {
    if (n >= 19) asm volatile("s_waitcnt vmcnt(19)" ::: "memory");
    else if (n >= 16) asm volatile("s_waitcnt vmcnt(16)" ::: "memory");
    else if (n >= 15) asm volatile("s_waitcnt vmcnt(15)" ::: "memory");
    else if (n >= 12) asm volatile("s_waitcnt vmcnt(12)" ::: "memory");
    else if (n >= 8) asm volatile("s_waitcnt vmcnt(8)" ::: "memory");
    else if (n >= 4) asm volatile("s_waitcnt vmcnt(4)" ::: "memory");
    else asm volatile("s_waitcnt vmcnt(0)" ::: "memory");
}
__device__ __forceinline__ bool claim_item(unsigned* cnt, unsigned nchunk, volatile LAS unsigned* misc, int tid, int& q, int& chunk) {
    __syncthreads();
    if (tid < 64) {
        const unsigned x2 = (xb_xcc_id() & 7u) * 2u; unsigned res = 0xffffffffu;
        unsigned k = misc[1];
        for (int tries = 0; tries < 32; ++tries) {
            const unsigned qx = (x2 + k) & 15u;
            unsigned c = 0u;
            if (tid == 0) c = __hip_atomic_fetch_add(cnt + 64 * qx, 1u, __ATOMIC_RELAXED, __HIP_MEMORY_SCOPE_AGENT);
            c = __builtin_amdgcn_readfirstlane(c);
            if (c < nchunk) { res = (qx << 16) | c; break; }
            unsigned hv = 0xffffffffu;
            if (tid < 16) hv = __hip_atomic_load(cnt + 64 * ((x2 + (unsigned)tid) & 15u), __ATOMIC_RELAXED, __HIP_MEMORY_SCOPE_AGENT);
            const unsigned long long open = __ballot(hv < nchunk) & 0xffffull;
            if (open == 0ull) break;
            k = (unsigned)__builtin_ctzll(open);
        }
        if (tid == 0) { misc[0] = res; misc[1] = k; }
    }
    __syncthreads();
    const unsigned r = misc[0];
    if (r == 0xffffffffu) return false;
    q = (int)(r >> 16); chunk = (int)(r & 0xffffu); return true;
}
__device__ __forceinline__ void gather1_phase(const Params& p, int l, LAS unsigned char* lds, int rep = 0) {
    const int tid = ltid(), wid = __builtin_amdgcn_readfirstlane(tid >> 6), lane = tid & 63, r = lane & 15, c = lane >> 4;
    volatile LAS unsigned* misc = (volatile LAS unsigned*)(lds + LDS_MISC);
    unsigned* cnt = p.ctl + CW_QCNT + ((l * 2 + 0) * 2 + rep) * 16 * 64;
    if (tid == 0) misc[1] = 0u;
    LAS unsigned char* buf = lds + wid * 16384;
    LAS unsigned char* sm = lds + 131072 + wid * 2304;
    const int rowi = lane >> 3, j = lane & 7, fw = rowi >> 1, frd = (r >> 1) & 7;
    const int bk0 = (int)(uintptr_t)buf + r * 128 + ((c ^ frd) * 16), bk1 = (int)(uintptr_t)buf + r * 128 + (((4 + c) ^ frd) * 16);
    float mk[8];
#pragma unroll
    for (int g = 0; g < 8; ++g) mk[g] = ((r >> 1) == g) ? 1.f : 0.f;
    const bool odd = (r & 1) != 0;
    int q, chunk;
    const int cpos = (lbid() >> 3) % 5; bool cpend = (l + 1 < DEPTH) && rep == 0;
    bool dry = false;
    for (int ndone = 0;; ++ndone) {
        if (cpend && (dry || ndone == cpos)) { pro::conv_share(p, l + 1, 0, lds); cpend = false; }
        if (dry) break;
        if (!claim_item(cnt, (unsigned)(SEQ / (8 * TPW)), misc, tid, q, chunk)) { dry = true; if (!cpend) break; continue; }

        const int tw = chunk * (8 * TPW) + wid * TPW;
        float acc[TPW][2];
#pragma unroll
        for (int i = 0; i < TPW; ++i) { acc[i][0] = 0.f; acc[i][1] = 0.f; }
#define G1_DMAQ(Q, EN) do { _Pragma("unroll") for (int nn = 0; nn < 4; ++nn) { const int n = ((Q) & 1) * 4 + nn; const int e = (EN)[(Q) * 4 + nn]; \
                        const unsigned char* src = ub + (unsigned)((unsigned)e * 128u + (unsigned)((j ^ ((n & 1) * 4 + fw)) * 16)); \
                        __builtin_amdgcn_global_load_lds((const unsigned*)src, (LAS unsigned*)(buf + ((Q) >> 1) * 8192 + n * 1024), 16, 0, 0); } } while (0)
#define G1_CQ(Q, H0, H1, I, NEXT, EN) do { const int gga = ((Q) & 1) * 2, ga = ((Q) >> 1) * 4 + gga;     \
                        i64x2 A0a = *(const LAS i64x2*)(uintptr_t)(bk0 + ((Q) >> 1) * 8192 + gga * 2048), A1a = *(const LAS i64x2*)(uintptr_t)(bk1 + ((Q) >> 1) * 8192 + gga * 2048); \
                        i64x2 A0b = *(const LAS i64x2*)(uintptr_t)(bk0 + ((Q) >> 1) * 8192 + gga * 2048 + 2048), A1b = *(const LAS i64x2*)(uintptr_t)(bk1 + ((Q) >> 1) * 8192 + gga * 2048 + 2048); \
                        asm volatile("s_waitcnt lgkmcnt(0)" : "+v"(A0a), "+v"(A1a), "+v"(A0b), "+v"(A1b) :: "memory");     \
                        if (NEXT) G1_DMAQ(Q, EN); \
                        f32x4 Ca = __builtin_amdgcn_mfma_f32_16x16x32_fp8_fp8(A0a[0], (H0)[0], (f32x4){0.f, 0.f, 0.f, 0.f}, 0, 0, 0); \
                        f32x4 Cb = __builtin_amdgcn_mfma_f32_16x16x32_fp8_fp8(A0b[0], (H0)[0], (f32x4){0.f, 0.f, 0.f, 0.f}, 0, 0, 0); \
                        Ca = __builtin_amdgcn_mfma_f32_16x16x32_fp8_fp8(A0a[1], (H0)[1], Ca, 0, 0, 0); Cb = __builtin_amdgcn_mfma_f32_16x16x32_fp8_fp8(A0b[1], (H0)[1], Cb, 0, 0, 0); \
                        Ca = __builtin_amdgcn_mfma_f32_16x16x32_fp8_fp8(A1a[0], (H1)[0], Ca, 0, 0, 0); Cb = __builtin_amdgcn_mfma_f32_16x16x32_fp8_fp8(A1b[0], (H1)[0], Cb, 0, 0, 0); \
                        Ca = __builtin_amdgcn_mfma_f32_16x16x32_fp8_fp8(A1a[1], (H1)[1], Ca, 0, 0, 0); Cb = __builtin_amdgcn_mfma_f32_16x16x32_fp8_fp8(A1b[1], (H1)[1], Cb, 0, 0, 0); \
                        acc[I][0] = fmaf(mk[ga], odd ? Ca[2] : Ca[0], acc[I][0]); acc[I][1] = fmaf(mk[ga], odd ? Ca[3] : Ca[1], acc[I][1]); \
                        acc[I][0] = fmaf(mk[ga + 1], odd ? Cb[2] : Cb[0], acc[I][0]); acc[I][1] = fmaf(mk[ga + 1], odd ? Cb[3] : Cb[1], acc[I][1]); } while (0)
#define G1_SMALLD(SLOT, TI) do { const int* ip_ = p.pidx + (size_t)(tw + (TI)) * 128 + lane; \
                        __builtin_amdgcn_global_load_lds((const unsigned*)ip_, (LAS unsigned*)(sm + (SLOT) * 768), 4, 0, 0); \
                        __builtin_amdgcn_global_load_lds((const unsigned*)(ip_ + 64), (LAS unsigned*)(sm + (SLOT) * 768 + 256), 4, 0, 0); \
                        __builtin_amdgcn_global_load_lds((const unsigned*)(hs0 + (size_t)(TI) * DM), (LAS unsigned*)(sm + (SLOT) * 768 + 512), 4, 0, 0); } while (0)
#define G1_RDIX(SLOT, EN) do { _Pragma("unroll") for (int m = 0; m < 16; ++m) (EN)[m] = *(const LAS int*)(sm + (SLOT) * 768 + (m * 8 + rowi) * 4); } while (0)
#define G1_RDHY(SLOT, H0, H1) do { H0 = *(const LAS i64x2*)(sm + (SLOT) * 768 + 512 + c * 16); H1 = *(const LAS i64x2*)(sm + (SLOT) * 768 + 512 + 64 + c * 16); } while (0)
        {
            const int s = q;
            const unsigned char* ub = p.uS8 + ((size_t)(l * 16 + s) * PEER_N) * 128;
            const unsigned char* hs0 = p.hn8 + (size_t)tw * DM + s * 128 + (lane & 31) * 4;
            int en[16]; i64x2 hyc0, hyc1;
            G1_SMALLD(0, 0); G1_SMALLD(1, 1);
            asm volatile("s_waitcnt vmcnt(0)" ::: "memory"); __builtin_amdgcn_sched_barrier(0);
            G1_RDIX(0, en);
            G1_DMAQ(0, en); G1_DMAQ(1, en); G1_DMAQ(2, en); G1_DMAQ(3, en);
            __builtin_amdgcn_sched_barrier(0);
#pragma unroll
            for (int i = 0; i < TPW; ++i) {
#pragma unroll
                for (int qq = 0; qq < 4; ++qq) {
                    const int nyoung = 4 * ((3 - qq) + ((i + 1 < TPW) ? qq : 0)) + ((qq > 0 && i + 2 < TPW) ? 3 : 0);
                    vm_wait_le(nyoung); __builtin_amdgcn_sched_barrier(0);
                    if (qq == 0) {
                        G1_RDHY(i % 3, hyc0, hyc1);
                        if (i + 1 < TPW) G1_RDIX((i + 1) % 3, en);
                        if (i + 2 < TPW) G1_SMALLD((i + 2) % 3, i + 2);
                        __builtin_amdgcn_sched_barrier(0); }
                    G1_CQ(qq, hyc0, hyc1, i, (i + 1 < TPW), en);
                    __builtin_amdgcn_sched_barrier(0);
                }
            }
        }
#undef G1_SMALLD
#undef G1_RDIX
#undef G1_RDHY
#undef G1_DMAQ
#undef G1_CQ
        const int j0 = 16 * (r >> 1) + 4 * c + 2 * (r & 1);
#pragma unroll
        for (int i = 0; i < TPW; ++i) *(unsigned*)((bf16_t*)p.pq + ((size_t)q * SEQ + tw + i) * 128 + j0) = cvtpk(acc[i][0], acc[i][1]);
    }
}
__device__ __forceinline__ void gather_reduce_phase(const Params& p, const float* rs2, size_t gtid, size_t ngt) {
    for (size_t i = gtid; i < (size_t)SEQ * 128 / 4; i += ngt) {
        f32x4 sum = (f32x4){0.f, 0.f, 0.f, 0.f};
#pragma unroll
        for (int q = 0; q < 16; ++q) { const u32x2 w = ((const u32x2*)((const bf16_t*)p.pq + (size_t)q * SEQ * 128))[i]; sum[0] += bflo(w.x); sum[1] += bfhi(w.x); sum[2] += bflo(w.y); sum[3] += bfhi(w.y); }
        sum *= (1.0f / U_SCALE) * rs2[i >> 5];
        const f32x4 g = ((const f32x4*)p.pgate)[i];
        int w = __builtin_amdgcn_cvt_pk_fp8_f32(clamp8(A_SCALE * g[0] * gelu_t(sum[0])), clamp8(A_SCALE * g[1] * gelu_t(sum[1])), 0, false);
        w = __builtin_amdgcn_cvt_pk_fp8_f32(clamp8(A_SCALE * g[2] * gelu_t(sum[2])), clamp8(A_SCALE * g[3] * gelu_t(sum[3])), w, true);
        ((unsigned*)p.aB8)[i] = (unsigned)w;
    }
}
__device__ __forceinline__ void gather2_phase(const Params& p, int l, LAS unsigned char* lds, int rep = 0) {
    bf16_t* podst = p.po + (rep ? (size_t)SEQ * DM : (size_t)0);
    const int tid = ltid(), wid = __builtin_amdgcn_readfirstlane(tid >> 6), lane = tid & 63, r = lane & 15, c = lane >> 4;
    volatile LAS unsigned* misc = (volatile LAS unsigned*)(lds + LDS_MISC);
    unsigned* cnt = p.ctl + CW_QCNT + ((l * 2 + 1) * 2 + rep) * 16 * 64;
    if (tid == 0) misc[1] = 0u;
    LAS unsigned char* buf = lds + wid * 16384;
    LAS unsigned char* sm = lds + 131072 + wid * 2304;
    const int rowi = lane >> 3, j = lane & 7;
    const int gsw_w = ((rowi >> 1) & 1);
    const int q4 = (lane & 15) >> 2, pl = lane & 3, gl = (q4 >> 1) | ((c & 1) << 1);
    int bnb[4];
#pragma unroll
    for (int nb = 0; nb < 4; ++nb) bnb[nb] = (int)(uintptr_t)buf + (c * 8 + q4) * 128 + pl * 8 + 32 * (nb ^ gl);
    int q, chunk;
    const int cpos = (lbid() >> 3) % 5; bool cpend = (l + 1 < DEPTH) && rep == 0;
    bool dry = false;
    for (int ndone = 0;; ++ndone) {
        if (cpend && (dry || ndone == cpos)) { pro::conv_share(p, l + 1, 1, lds); cpend = false; }
        if (dry) break;
        if (!claim_item(cnt, (unsigned)(SEQ / (8 * TPW)), misc, tid, q, chunk)) { dry = true; if (!cpend) break; continue; }

        const int tw = chunk * (8 * TPW) + wid * TPW;
#define TRR(dst, base, off) asm volatile("ds_read_b64_tr_b16 %0, %1 offset:%2" : "=&v"(dst) : "v"(base), "i"(off) : "memory")
#define EV4(w0, w1) __builtin_amdgcn_perm((w1), (w0), 0x06040200u)
#define OD4(w0, w1) __builtin_amdgcn_perm((w1), (w0), 0x07050301u)
#define G2_CQ(Q, AFQ, NEXT, EN) do { u32x2 lo[4], hi[4]; \
                        TRR(lo[0], bnb[0], ((Q) >> 1) * 8192 + ((Q) & 1) * 4096); TRR(hi[0], bnb[0], ((Q) >> 1) * 8192 + ((Q) & 1) * 4096 + 512); \
                        TRR(lo[1], bnb[1], ((Q) >> 1) * 8192 + ((Q) & 1) * 4096); TRR(hi[1], bnb[1], ((Q) >> 1) * 8192 + ((Q) & 1) * 4096 + 512); \
                        TRR(lo[2], bnb[2], ((Q) >> 1) * 8192 + ((Q) & 1) * 4096); TRR(hi[2], bnb[2], ((Q) >> 1) * 8192 + ((Q) & 1) * 4096 + 512); \
                        TRR(lo[3], bnb[3], ((Q) >> 1) * 8192 + ((Q) & 1) * 4096); TRR(hi[3], bnb[3], ((Q) >> 1) * 8192 + ((Q) & 1) * 4096 + 512); \
                        asm volatile("s_waitcnt lgkmcnt(0)" ::: "memory"); __builtin_amdgcn_sched_barrier(0); \
                        if (NEXT) G2_DMAQ(Q, EN);                        \
                        _Pragma("unroll") for (int nb = 0; nb < 4; ++nb) { \
                            const long E = (long)(((unsigned long long)EV4(hi[nb].x, hi[nb].y) << 32) | EV4(lo[nb].x, lo[nb].y)), O = (long)(((unsigned long long)OD4(hi[nb].x, hi[nb].y) << 32) | OD4(lo[nb].x, lo[nb].y)); \
                            De[nb] = __builtin_amdgcn_mfma_f32_16x16x32_fp8_fp8((AFQ), E, De[nb], 0, 0, 0); Do[nb] = __builtin_amdgcn_mfma_f32_16x16x32_fp8_fp8((AFQ), O, Do[nb], 0, 0, 0); } } while (0)
#define G2_DMAQ(Q, EN) do { _Pragma("unroll") for (int nn = 0; nn < 4; ++nn) { const int n = ((Q) & 1) * 4 + nn; const int e = (EN)[(Q) * 4 + nn]; const int gsw = gsw_w | ((n & 1) << 1); \
                        const unsigned char* src = vb + (unsigned)((unsigned)e * 128u + (unsigned)(((j >> 1) ^ gsw) * 32 + (j & 1) * 16)); \
                        __builtin_amdgcn_global_load_lds((const unsigned*)src, (LAS unsigned*)(buf + ((Q) >> 1) * 8192 + n * 1024), 16, 0, 0); } } while (0)
#define G2_SMALLD(SLOT, TI) do { const int* ip_ = p.pidx + (size_t)(tw + (TI)) * 128 + lane; \
                        __builtin_amdgcn_global_load_lds((const unsigned*)ip_, (LAS unsigned*)(sm + (SLOT) * 768), 4, 0, 0); \
                        __builtin_amdgcn_global_load_lds((const unsigned*)(ip_ + 64), (LAS unsigned*)(sm + (SLOT) * 768 + 256), 4, 0, 0); \
                        __builtin_amdgcn_global_load_lds((const unsigned*)(as0 + (size_t)(TI) * 128), (LAS unsigned*)(sm + (SLOT) * 768 + 512), 4, 0, 0); } while (0)
#define G2_RDIX(SLOT, EN) do { _Pragma("unroll") for (int m = 0; m < 16; ++m) (EN)[m] = *(const LAS int*)(sm + (SLOT) * 768 + (m * 8 + rowi) * 4); } while (0)
#define G2_RDAF(SLOT, AF) do { _Pragma("unroll") for (int ks = 0; ks < 4; ++ks) (AF)[ks] = *(const LAS long*)(sm + (SLOT) * 768 + 512 + ks * 32 + c * 8); } while (0)
        {
            const int s = q;
            const unsigned char* vb = p.vS8 + ((size_t)(l * 16 + s) * PEER_N) * 128;
            const unsigned char* as0 = p.aB8 + (size_t)tw * 128 + (lane & 31) * 4;
            int en[16]; long af[4]; unsigned pend[4];
#pragma unroll
            for (int k = 0; k < 4; ++k) pend[k] = 0u;
            G2_SMALLD(0, 0); G2_SMALLD(1, 1);
            asm volatile("s_waitcnt vmcnt(0)" ::: "memory"); __builtin_amdgcn_sched_barrier(0);
            G2_RDIX(0, en);
            G2_DMAQ(0, en); G2_DMAQ(1, en); G2_DMAQ(2, en); G2_DMAQ(3, en);
            __builtin_amdgcn_sched_barrier(0);
            int sc = 0, sn = 1, s2 = 2;
#pragma unroll 1
            for (int i = 0; i < TPW; ++i) {
                const int t = tw + i;
                f32x4 De[4], Do[4];
#pragma unroll
                for (int nb = 0; nb < 4; ++nb) { De[nb] = (f32x4){0.f, 0.f, 0.f, 0.f}; Do[nb] = (f32x4){0.f, 0.f, 0.f, 0.f}; }
#pragma unroll
                for (int qq = 0; qq < 4; ++qq) {
                    if (qq == 0) vm_wait_le(12);
                    else if (i == TPW - 1) vm_wait_le(4 * (3 - qq) + 4);
                    else if (i >= 1 && i <= TPW - 3) vm_wait_le(19);
                    else vm_wait_le(15);
                    __builtin_amdgcn_sched_barrier(0);
                    if (qq == 0) {
                        G2_RDAF(sc, af);
                        if (i + 1 < TPW) G2_RDIX(sn, en);
                        if (i + 2 < TPW) G2_SMALLD(s2, i + 2);
                        if (i > 0 && c == 0) {
#pragma unroll
                            for (int nb = 0; nb < 4; ++nb) *(unsigned*)(podst + (size_t)(t - 1) * DM + s * 128 + nb * 32 + 2 * r) = pend[nb]; }
                        asm volatile("" ::: "memory"); __builtin_amdgcn_sched_barrier(0); }
                    G2_CQ(qq, af[qq], (i + 1 < TPW), en);
                    __builtin_amdgcn_sched_barrier(0);
                }
#pragma unroll
                for (int nb = 0; nb < 4; ++nb) pend[nb] = cvtpk(De[nb][0] * (1.0f / (V_SCALE * A_SCALE)), Do[nb][0] * (1.0f / (V_SCALE * A_SCALE)));
                { const int tmp = sc; sc = sn; sn = s2; s2 = tmp; }
            }
            if (c == 0) {
#pragma unroll
                for (int nb = 0; nb < 4; ++nb) *(unsigned*)(podst + (size_t)(tw + TPW - 1) * DM + s * 128 + nb * 32 + 2 * r) = pend[nb]; }
        }
#undef G2_CQ
#undef G2_DMAQ
#undef G2_SMALLD
#undef G2_RDIX
#undef G2_RDAF
#undef EV4
#undef OD4
#undef TRR
    }
}
}

namespace pro {
__device__ __forceinline__ void tr_item(const float* W, int ldw, int K, bf16_t* WT, int nblk, int item, LAS float* scr, int lane) {
    const int kb = item / nblk, nb = item % nblk, k0 = 64 * kb, n0 = 32 * nb;
    const int kr = lane >> 3, nq = (lane & 7) * 4;
    f32x4 v[8];
#pragma unroll
    for (int i = 0; i < 8; ++i) v[i] = *(const f32x4*)(W + (size_t)(k0 + 8 * i + kr) * ldw + n0 + nq);
#pragma unroll
    for (int i = 0; i < 8; ++i) { LAS float* d = scr + (8 * i + kr) * 33 + nq; d[0] = v[i][0]; d[1] = v[i][1]; d[2] = v[i][2]; d[3] = v[i][3]; }
    asm volatile("s_waitcnt lgkmcnt(0)" ::: "memory");
    const int c = lane & 7;
#pragma unroll
    for (int j = 0; j < 4; ++j) { const int n = (lane >> 3) + 8 * j; const LAS float* s = scr + (8 * c) * 33 + n;
        u32x4 o; o.x = pk2(s[0 * 33], s[1 * 33]); o.y = pk2(s[2 * 33], s[3 * 33]); o.z = pk2(s[4 * 33], s[5 * 33]); o.w = pk2(s[6 * 33], s[7 * 33]);
        *(u32x4*)(WT + (size_t)(n0 + n) * K + k0 + 8 * c) = o; }
    asm volatile("s_waitcnt lgkmcnt(0)" ::: "memory");
}
__device__ __forceinline__ void tr_item2(const float* W, int ldw, int K, bf16_t* WT, int nblk2, int item, LAS float* scr, int lane) {
    const int kb = item / nblk2, nb = item % nblk2, k0 = 64 * kb, n0 = 64 * nb;
    const int kr = lane >> 3, nq = (lane & 7) * 4, c = lane & 7;
    f32x4 v[2][8];
#pragma unroll
    for (int h = 0; h < 2; ++h)
#pragma unroll
        for (int i = 0; i < 8; ++i) v[h][i] = *(const f32x4*)(W + (size_t)(k0 + 8 * i + kr) * ldw + n0 + 32 * h + nq);
#pragma unroll
    for (int h = 0; h < 2; ++h) {
#pragma unroll
        for (int i = 0; i < 8; ++i) { LAS float* d = scr + (8 * i + kr) * 33 + nq; d[0] = v[h][i][0]; d[1] = v[h][i][1]; d[2] = v[h][i][2]; d[3] = v[h][i][3]; }
        asm volatile("s_waitcnt lgkmcnt(0)" ::: "memory");
#pragma unroll
        for (int j = 0; j < 4; ++j) { const int n = (lane >> 3) + 8 * j; const LAS float* sp = scr + (8 * c) * 33 + n;
            u32x4 o; o.x = pk2(sp[0 * 33], sp[1 * 33]); o.y = pk2(sp[2 * 33], sp[3 * 33]); o.z = pk2(sp[4 * 33], sp[5 * 33]); o.w = pk2(sp[6 * 33], sp[7 * 33]);
            *(u32x4*)(WT + (size_t)(n0 + 32 * h + n) * K + k0 + 8 * c) = o; }
        asm volatile("s_waitcnt lgkmcnt(0)" ::: "memory");
    }
}
__device__ __forceinline__ void cvt_stream(const float* src, bf16_t* dst, size_t n8, size_t gtid, size_t ngt) {
    for (size_t i = gtid; i < n8; i += ngt) { const f32x4 a = ((const f32x4*)src)[2 * i], b = ((const f32x4*)src)[2 * i + 1];
        u32x4 o; o.x = pk2(a[0], a[1]); o.y = pk2(a[2], a[3]); o.z = pk2(b[0], b[1]); o.w = pk2(b[2], b[3]); ((u32x4*)dst)[i] = o; }
}
__device__ __forceinline__ void cvt_sliced(const float* src, bf16_t* dst, size_t gtid, size_t ngt) {
    for (size_t i = gtid; i < (size_t)DEPTH * PEER_N * DM / 8; i += ngt) { const f32x4 a = ((const f32x4*)src)[2 * i], b = ((const f32x4*)src)[2 * i + 1];
        const size_t k8 = i & 255, le = i >> 8, e = le & (PEER_N - 1), l = le >> 14;
        u32x4 o; o.x = pk2(a[0], a[1]); o.y = pk2(a[2], a[3]); o.z = pk2(b[0], b[1]); o.w = pk2(b[2], b[3]);
        *(u32x4*)(dst + (((l * 32 + (k8 >> 3)) * PEER_N + e) * 64 + (k8 & 7) * 8)) = o; }
}
__device__ __forceinline__ void cvt_sliced_fp8(const float* src, unsigned char* dst, float scale, size_t gtid, size_t ngt) {
    const size_t n4 = (size_t)DEPTH * PEER_N * DM / 4;
    for (size_t i0 = gtid; i0 < n4; i0 += 4 * ngt) {
        f32x4 v[4];
#pragma unroll
        for (int u = 0; u < 4; ++u) { const size_t i = i0 + u * ngt; if (i < n4) v[u] = ((const f32x4*)src)[i]; }
#pragma unroll
        for (int u = 0; u < 4; ++u) { const size_t i = i0 + u * ngt; if (i < n4) {
            const size_t k4 = i & 511, le = i >> 9, e = le & (PEER_N - 1), l = le >> 14;
            int w = __builtin_amdgcn_cvt_pk_fp8_f32(clamp8(v[u][0] * scale), clamp8(v[u][1] * scale), 0, false); w = __builtin_amdgcn_cvt_pk_fp8_f32(clamp8(v[u][2] * scale), clamp8(v[u][3] * scale), w, true);
            *(unsigned*)(dst + (((l * 16 + (k4 >> 5)) * PEER_N + e) * 128 + (k4 & 31) * 4)) = (unsigned)w; } }
    }
}
constexpr int I_MIX = 32 * 72, I_GATE = 32 * 128, I_BR = 8 * 32, I_SQ = 32 * 32, I_PW = 2 * 2;
constexpr int I_LAYER = I_MIX + I_GATE + 4 * I_BR + 2 * I_SQ + 4 * I_PW;
constexpr int CVT_CHUNKS = 4096;
constexpr int NTW = I_LAYER + 2 * CVT_CHUNKS;
constexpr int NWG_ITEMS = (NTW + 15) / 16;
__device__ __forceinline__ void cvt_chunk_fp8(const float* src, unsigned char* dst, float scale, size_t g0, int lane) {
    f32x4 v[2][8];
#pragma unroll
    for (int u = 0; u < 8; ++u) v[0][u] = ((const f32x4*)src)[g0 + u * 64 + lane];
#pragma unroll
    for (int b = 0; b < 4; ++b) {
        if (b + 1 < 4) {
#pragma unroll
            for (int u = 0; u < 8; ++u) v[(b + 1) & 1][u] = ((const f32x4*)src)[g0 + (b + 1) * 512 + u * 64 + lane]; }
#pragma unroll
        for (int u = 0; u < 8; ++u) { const size_t i = g0 + b * 512 + u * 64 + lane; const f32x4 x = v[b & 1][u];
            const size_t k4 = i & 511, le = i >> 9, e = le & (PEER_N - 1), l = le >> 14;
            int w = __builtin_amdgcn_cvt_pk_fp8_f32(clamp8(x[0] * scale), clamp8(x[1] * scale), 0, false); w = __builtin_amdgcn_cvt_pk_fp8_f32(clamp8(x[2] * scale), clamp8(x[3] * scale), w, true);
            *(unsigned*)(dst + (((l * 16 + (k4 >> 5)) * PEER_N + e) * 128 + (k4 & 31) * 4)) = (unsigned)w; }
    }
}
__device__ __forceinline__ void conv_wave_item(const Params& p, int l, int w, LAS float* scr, int lane) {
    if (w >= NTW) return;
    if (w >= I_LAYER) { const int c = w - I_LAYER, tbl = c / CVT_CHUNKS, chunk = c % CVT_CHUNKS;
        const size_t g0 = (size_t)l * PEER_N * DM / 4 + (size_t)chunk * 2048;
        if (tbl == 0) cvt_chunk_fp8(p.peer_u, p.uS8, U_SCALE, g0, lane); else cvt_chunk_fp8(p.peer_v, p.vS8, V_SCALE, g0, lane);
        return; }
    int r = w;
    const float* win = p.w_in + (size_t)l * DM * INCOLS; bf16_t* wint = p.WinT + (size_t)l * NIN * DM;
    if (r < I_MIX) { tr_item2(win, INCOLS, DM, wint, 72, r, scr, lane); return; } r -= I_MIX;
    if (r < I_GATE) { tr_item2(win + NMIX + 4, INCOLS, DM, wint + (size_t)NMIX * DM, 128, r, scr, lane); return; } r -= I_GATE;
    if (r < 4 * I_BR) { const int n = r / I_BR; tr_item2(p.w_branch + ((size_t)l * 4 + n) * BWID * DM, DM, BWID, p.WbT + ((size_t)l * 4 + n) * DM * BWID, 32, r % I_BR, scr, lane); return; } r -= 4 * I_BR;
    if (r < I_SQ) { tr_item2(p.w_out + (size_t)l * DM * DM, DM, DM, p.WoT + (size_t)l * DM * DM, 32, r, scr, lane); return; } r -= I_SQ;
    if (r < I_SQ) { tr_item2(p.peer_wq + (size_t)l * DM * DM, DM, DM, p.WqT + (size_t)l * DM * DM, 32, r, scr, lane); return; } r -= I_SQ;
    { const int g = r / I_PW; tr_item2(p.pool_w + ((size_t)l * 4 + g) * 128 * 128, 128, 128, p.poolWT + ((size_t)l * 4 + g) * 128 * 128, 2, r % I_PW, scr, lane); }
}
__device__ __forceinline__ void conv_share(const Params& p, int L, int half, LAS unsigned char* lds) {
    const int tid = ltid(), wid = __builtin_amdgcn_readfirstlane(tid >> 6), lane = tid & 63;
    const int ngw = (int)gridDim.x * NWAVES, gw = lbid() * NWAVES + wid;
    LAS float* scr = (LAS float*)(lds + wid * 16384);
#pragma unroll 1
    for (int w = gw + half * ngw; w < NTW; w += 2 * ngw) conv_wave_item(p, L, w, scr, lane);
}
__device__ __forceinline__ void prologue(const Params& p, int vb, int nvb, LAS unsigned char* lds) {
    const int tid = ltid(), wid = __builtin_amdgcn_readfirstlane(tid >> 6), lane = tid & 63;
    const int gw = vb * NWAVES + wid, ngw = nvb * NWAVES;
    LAS float* scr = (LAS float*)(lds + wid * 16384);
    for (int w = gw; w < NTW; w += ngw) conv_wave_item(p, 0, w, scr, lane);
    const size_t gtid = (size_t)vb * NTHREADS + tid, ngt = (size_t)nvb * NTHREADS;
    cvt_stream(p.peer_keys, p.keysB, (size_t)DEPTH * 8 * 2 * 128 * 128 / 8, gtid, ngt);
    for (size_t i = gtid; i < (size_t)DEPTH * 4 * 128 * 128; i += ngt) { const int s = (int)(i & 127), t = (int)((i >> 7) & 127); p.sguW[i] = (bf16_t)(s <= t ? f2bf(p.sgu_w[i]) : 0u); }
    for (size_t i = gtid; i < (size_t)DEPTH * 4 * DM; i += ngt) { const int k = (int)(i % DM), g = (int)((i / DM) & 3), l = (int)(i / (4 * DM)); p.wfg[i] = p.w_in[((size_t)l * DM + k) * INCOLS + NMIX + g]; }
}
}

#define XB_CW_BAR   4096
#define XB_TMO      128
#define XB_XCNT(j)  (256  + 64 * (j))
#define XB_XSUB(j)  (1280 + 64 * (j))
#define XB_XGEN(j)  (2304 + 64 * (j))
#define XB_TOP      3328
#define XB_TOPGEN   3392
#define XCD_BAR_WORDS 3456
#define XB_SPIN_CAP (1u << 18)
__device__ __forceinline__ unsigned xb_ld(unsigned* p)              { return __hip_atomic_load(p, __ATOMIC_RELAXED, __HIP_MEMORY_SCOPE_AGENT); }
__device__ __forceinline__ unsigned xb_add(unsigned* p, unsigned v) { return __hip_atomic_fetch_add(p, v, __ATOMIC_RELAXED, __HIP_MEMORY_SCOPE_AGENT); }
#define XB_SPIN(cond, bar) do { unsigned _sp = 0; while (cond) { __builtin_amdgcn_s_sleep(1); \
    if ((++_sp & 255u) == 0u) { if (xb_ld(&(bar)[XB_TMO])) break; if (_sp > XB_SPIN_CAP) { atomicAdd(&(bar)[XB_TMO], 1u); break; } } } } while (0)
struct XcdBarrier { unsigned* bar; unsigned x; volatile LAS unsigned* st; };
__device__ __forceinline__ XcdBarrier xcd_barrier_post(unsigned* bar, volatile LAS unsigned* st) {
    XcdBarrier b; b.bar = bar; b.x = xb_xcc_id(); b.st = st;
    if (threadIdx.x == 0) (void)xb_add(&bar[XB_XCNT(b.x)], 1u);
    return b;
}
__device__ __forceinline__ void xcd_barrier_complete(unsigned* bar, unsigned x, unsigned& nloc, unsigned& nx) {
    const unsigned G = gridDim.x * gridDim.y * gridDim.z;
    unsigned sum, cnt, mine, sp = 0u;
    for (;;) {
        sum = 0u; cnt = 0u; mine = 0u;
#pragma unroll
        for (unsigned j = 0; j < 16; ++j) { const unsigned c = xb_ld(&bar[XB_XCNT(j)]); sum += c; cnt += (c > 0u) ? 1u : 0u; mine = (j == x) ? c : mine; }
        if (sum == G) break;
        __builtin_amdgcn_s_sleep(1);
        if ((++sp & 255u) == 0u) { if (xb_ld(&bar[XB_TMO])) break; if (sp > XB_SPIN_CAP) { atomicAdd(&bar[XB_TMO], 1u); break; } }
    }
    nloc = mine > 0u ? mine : 1u; nx = cnt > 0u ? cnt : 1u;
}
__device__ __forceinline__ void xcd_barrier(const XcdBarrier& b) {
    asm volatile("s_waitcnt vmcnt(0)" ::: "memory");
    __syncthreads();
    if (threadIdx.x == 0) {
        const unsigned long long wsv = ((const LAS unsigned long long*)((LAS unsigned char*)b.st - LDS_BARW + LDS_PTAB))[19];
        const unsigned wlo = __builtin_amdgcn_readfirstlane((unsigned)wsv), whi = __builtin_amdgcn_readfirstlane((unsigned)(wsv >> 32));
        unsigned* bar = (unsigned*)(GAS unsigned*)((((unsigned long long)whi << 32) | wlo) + WS_CTL + (size_t)XB_CW_BAR * 4);
        __builtin_amdgcn_s_waitcnt(0);
        unsigned nloc = b.st[0], nx = b.st[1];
        if (nloc == 0u) { xcd_barrier_complete(bar, b.x, nloc, nx); b.st[0] = nloc; b.st[1] = nx; }
        const unsigned old = xb_add(&bar[XB_XSUB(b.x)], 1u);
        const unsigned gen = old / nloc;
        if (old + 1u == (gen + 1u) * nloc) {
            __builtin_amdgcn_fence(__ATOMIC_RELEASE, "agent");
            asm volatile("s_waitcnt vmcnt(0)" ::: "memory");
            const unsigned og = xb_add(&bar[XB_TOP], 1u);
            const unsigned tg = og / nx;
            if (og + 1u == (tg + 1u) * nx) xb_add(&bar[XB_TOPGEN], 1u);
            else XB_SPIN(xb_ld(&bar[XB_TOPGEN]) == tg, bar);
            __builtin_amdgcn_fence(__ATOMIC_ACQUIRE, "agent");
            xb_add(&bar[XB_XGEN(b.x)], 1u);
            asm volatile("s_waitcnt vmcnt(0)" ::: "memory");
        } else {
            XB_SPIN(xb_ld(&bar[XB_XGEN(b.x)]) == gen, bar);
            __builtin_amdgcn_fence(__ATOMIC_ACQUIRE, "agent");
            asm volatile("s_waitcnt vmcnt(0)" ::: "memory");
        }
    }
    __syncthreads();
}

constexpr int NPH_LAYER = 9, NPHASES = 2 + DEPTH * NPH_LAYER;
constexpr int CW_BAR = XB_CW_BAR;


template <class T> __device__ __forceinline__ T* ldptr(const LAS unsigned long long* ptab, int i) {
    const unsigned long long v = ptab[i];
    const unsigned lo = __builtin_amdgcn_readfirstlane((unsigned)v), hi = __builtin_amdgcn_readfirstlane((unsigned)(v >> 32));
    return (T*)(GAS T*)(((unsigned long long)hi << 32) | lo);
}
__device__ __forceinline__ Params mkparams(const LAS unsigned long long* ptab) {
    Params p;
    p.x = ldptr<const float>(ptab, 0); p.norm1_g = ldptr<const float>(ptab, 1); p.w_in = ldptr<const float>(ptab, 2); p.conv_w = ldptr<const float>(ptab, 3);
    p.sgu_norm_g = ldptr<const float>(ptab, 4); p.sgu_w = ldptr<const float>(ptab, 5); p.sgu_b = ldptr<const float>(ptab, 6); p.pool_w = ldptr<const float>(ptab, 7);
    p.pool_scale = ldptr<const float>(ptab, 8); p.forget_b = ldptr<const float>(ptab, 9); p.w_branch = ldptr<const float>(ptab, 10); p.w_out = ldptr<const float>(ptab, 11);
    p.norm2_g = ldptr<const float>(ptab, 12); p.peer_wq = ldptr<const float>(ptab, 13); p.peer_keys = ldptr<const float>(ptab, 14); p.peer_u = ldptr<const float>(ptab, 15);
    p.peer_v = ldptr<const float>(ptab, 16); p.final_g = ldptr<const float>(ptab, 17); p.out = ldptr<float>(ptab, 18);
    unsigned char* ws = ldptr<unsigned char>(ptab, 19);
    p.WinT = (bf16_t*)(ws + WS_WIN); p.WbT = (bf16_t*)(ws + WS_WB); p.WoT = (bf16_t*)(ws + WS_WO); p.WqT = (bf16_t*)(ws + WS_WQ); p.keysB = (bf16_t*)(ws + WS_KEYS);
    p.uS = (bf16_t*)(ws + WS_U); p.vS = (bf16_t*)(ws + WS_V); p.sguW = (bf16_t*)(ws + WS_SGUW); p.poolWT = (bf16_t*)(ws + WS_POOLW);
    p.wfg = (float*)(ws + WS_WFG); p.h = (float*)(ws + WS_H); p.macc = (float*)(ws + WS_MACC); p.flog = (float*)(ws + WS_FLOG); p.F = (float*)(ws + WS_F); p.pgate = (float*)(ws + WS_PGATE);
    p.xn = (bf16_t*)(ws + WS_XN); p.zmix = (bf16_t*)(ws + WS_ZMIX); p.zgate = (unsigned char*)(ws + WS_ZGATE); p.po = (bf16_t*)(ws + WS_MACC); p.br = (bf16_t*)(ws + WS_BR); p.merged = (bf16_t*)(ws + WS_MERGED); p.q = (bf16_t*)(ws + WS_Q);
    p.pidx = (int*)(ws + WS_PIDX); p.ctl = (unsigned*)(ws + WS_CTL); p.pq = (float*)(ws + WS_PQ); p.aB = (bf16_t*)(ws + WS_AB); p.uS8 = (unsigned char*)(ws + WS_U); p.vS8 = (unsigned char*)(ws + WS_V); p.hn8 = (unsigned char*)(ws + WS_HN8); p.aB8 = (unsigned char*)(ws + WS_AB); p.ssqp = (float*)(ws + WS_SSQP); p.rs2 = (float*)(ws + WS_RS2);
    return p;
}

__global__ void __launch_bounds__(NTHREADS, 2) mega(Args a) {
    extern __shared__ __attribute__((aligned(16))) unsigned char lds_raw[];
    LAS unsigned char* lds = (LAS unsigned char*)lds_raw;
    const int tid = threadIdx.x;
    LAS unsigned long long* ptab = (LAS unsigned long long*)(lds + LDS_PTAB);
    if (tid == 0) {
#pragma unroll
        for (int i = 0; i < 18; ++i) ptab[i] = (unsigned long long)a.in[i];
        ptab[18] = (unsigned long long)a.out; ptab[19] = (unsigned long long)a.ws;
    }
    const int G = gridDim.x;
    const int lo = a.ph_lo, hi = a.ph_hi;
    volatile LAS unsigned* barw = (volatile LAS unsigned*)(lds + LDS_BARW);
    if (tid == 0) { barw[0] = 0u; barw[1] = 0u; barw[2] = 0u; barw[3] = 0u; }
    __syncthreads();
    XcdBarrier bar; bar.bar = (unsigned*)(a.ws + WS_CTL) + CW_BAR; bar.x = 0; bar.st = barw;
    if (hi - lo > 1) bar = xcd_barrier_post((unsigned*)(a.ws + WS_CTL) + CW_BAR, barw);
#define PP const Params p = mkparams(ptab); const int tid_ = ltid(), vb = lbid(), wid = __builtin_amdgcn_readfirstlane(tid_ >> 6), lane = tid_ & 63, gw = vb * NWAVES + wid, ngw = G * NWAVES; (void)lane; (void)gw; (void)ngw
#ifndef KMASK
#define KMASK 0xFFFF
#endif
#define KON(b) (((KMASK) >> (b)) & 1)
#ifndef REPEAT_KIND
#define REPEAT_KIND -1
#endif
#define REPS(k) (((REPEAT_KIND) == (k) || ((k) == 3 && ((REPEAT_KIND) >= 13 && (REPEAT_KIND) <= 17))) ? 2 : 1)
#define REPLOOP(k) for (int rep = 0; rep < REPS(k); ++rep, (rep < REPS(k) ? xcd_barrier(bar) : (void)0))
#define IN(k) (lo <= (k) && (k) < hi)
#define SEAM(k) do { if (IN(k) && IN((k) + 1)) xcd_barrier(bar); } while (0)

    if (KON(0) && IN(0)) REPLOOP(0) { PP; pro::prologue(p, vb, G, lds); }
    SEAM(0);
#pragma unroll 1
    for (int l = 0; l < DEPTH; ++l) {
        const int base = 1 + NPH_LAYER * l;
        if (KON(1) && IN(base + 0)) REPLOOP(1) { PP; norm_phase<true>(p, l, l == 0 ? p.x : p.h, l == 0 ? (const bf16_t*)nullptr : p.po, p.norm1_g + (size_t)l * DM, gw, ngw, lane); }
        SEAM(base + 0);
        if (KON(2) && IN(base + 1)) REPLOOP(2) { PP;
            if (vb >= G - 4) cumsum_head(p, vb - (G - 4), lds);
            pg8::Gemm g{p.xn, p.WinT + (size_t)l * NIN * DM, SEQ, NIN, DM, DM, DM}; pg8::StaticOrder S; S.init(SEQ, NIN, G, vb);
            if (G == 256) S.imax = 6;
            pg8::EpiInproj E{p.zmix, p.zgate, p.ctl + CW_KN + l * 16};
            pg8::gemm_phase<pg8::EpiInproj, pg8::StaticOrder>(lds, g, S, E);
        }
        SEAM(base + 1);
        if (IN(base + 2)) REPLOOP(3) { PP;
            volatile LAS unsigned* misc = (volatile LAS unsigned*)(lds + LDS_MISC);
            unsigned* head = p.ctl + CW_MIXQ + (l * 2 + rep) * 64;
            for (;;) {
                __syncthreads();
                if (tid_ == 0) misc[0] = __hip_atomic_fetch_add(head, 1u, __ATOMIC_RELAXED, __HIP_MEMORY_SCOPE_AGENT);
                __syncthreads();
                int it = (int)misc[0];
                const int nleft = (G == 256) ? 64 : 0;
                if (it >= nleft + 128 + 192) break;
                if (it < nleft) { if (KON(2) && rep == 0) {
                    pg8::Gemm g{p.xn, p.WinT + (size_t)l * NIN * DM, SEQ, NIN, DM, DM, DM}; pg8::StaticOrder S; S.init(SEQ, NIN, G, it); S.i0 = 6; S.imax = 7;
                    pg8::EpiInproj E{p.zmix, p.zgate, p.ctl + CW_KN + l * 16};
                    pg8::gemm_phase<pg8::EpiInproj, pg8::StaticOrder>(lds, g, S, E); }
                    continue; }
                it -= nleft;
                if (it < 128) { if (KON(3) && (rep == 0 || (REPEAT_KIND) != 14)) { const int qb = 31 - (it >> 2), g = it & 3;
                    fa::attn_unit(p.zmix, p.F + (size_t)g * SEQ, p.br, g, qb, (__uint_as_float(__hip_atomic_load(p.ctl + CW_KN + l * 16 + g * 4 + 0, __ATOMIC_RELAXED, __HIP_MEMORY_SCOPE_AGENT)) + __uint_as_float(__hip_atomic_load(p.ctl + CW_KN + l * 16 + g * 4 + 1, __ATOMIC_RELAXED, __HIP_MEMORY_SCOPE_AGENT)) + __uint_as_float(__hip_atomic_load(p.ctl + CW_KN + l * 16 + g * 4 + 2, __ATOMIC_RELAXED, __HIP_MEMORY_SCOPE_AGENT)) + __uint_as_float(__hip_atomic_load(p.ctl + CW_KN + l * 16 + g * 4 + 3, __ATOMIC_RELAXED, __HIP_MEMORY_SCOPE_AGENT))), (LAS char*)lds); } }
                else if (KON(4) && (rep == 0 || (REPEAT_KIND) != 13)) { const int k = it - 128, t0 = (k & 63) * 128;
                    if (k < 64) { if (rep == 0 || (REPEAT_KIND) == 14 || (REPEAT_KIND) == 15) mix::sgu_item(p, l, t0, lds); }
                    else if (k < 128) { if (rep == 0 || (REPEAT_KIND) == 14 || (REPEAT_KIND) == 16) mix::pool_item(p, l, t0, lds); }
                    else { if (rep == 0 || (REPEAT_KIND) == 14 || (REPEAT_KIND) == 17) mix::conv_item(p, l, t0); } }
            }
            __syncthreads();
        }
        SEAM(base + 2);
        if (KON(5) && IN(base + 3)) REPLOOP(5) { PP;
            pg8::Gemm g{p.br, p.WbT + (size_t)l * 4 * DM * BWID, SEQ, DM, BWID, DM, BWID}; pg8::MergeOrder S; S.so.init(SEQ, DM, G, vb);
            pg8::EpiMerge E{p.zgate, p.merged};
            pg8::gemm_phase<pg8::EpiMerge, pg8::MergeOrder>(lds, g, S, E);
        }
        SEAM(base + 3);
        if (KON(6) && IN(base + 4)) { PP;
            pg8::Gemm g{p.merged, p.WoT + (size_t)l * DM * DM, SEQ, DM, DM, DM, DM}; pg8::StaticOrder S; S.init(SEQ, DM, G, vb);
            pg8::EpiResNorm E{l == 0 ? p.x : p.h, l == 0 ? (const bf16_t*)nullptr : p.po, p.h, p.norm2_g + (size_t)l * DM, p.xn, p.hn8, p.ssqp};
            pg8::gemm_phase<pg8::EpiResNorm, pg8::StaticOrder>(lds, g, S, E);
        }
        SEAM(base + 4);
        if (KON(8) && IN(base + 5)) REPLOOP(8) { PP;
            pg8::Gemm g{p.xn, p.WqT + (size_t)l * DM * DM, SEQ, DM, DM, DM, DM}; pg8::StaticOrder S; S.init(SEQ, DM, G, vb);
            pg8::Unit u0; int tab_pm = -1;
            LAS float* rstab = (LAS float*)(lds + LDS_RSTAB);
            if (S.next(0, u0)) { tab_pm = u0.pm; const int rr = tid_ >> 1, hf = tid_ & 1, r = u0.pm * 256 + rr;
                const f32x4* pp = (const f32x4*)(p.ssqp + (size_t)r * 32 + hf * 16); float sm = 0.f;
#pragma unroll
                for (int k = 0; k < 4; ++k) { const f32x4 v = pp[k]; sm += v[0]; sm += v[1]; sm += v[2]; sm += v[3]; }
                const float so = __shfl_xor(sm, 1); const float tot = hf ? (so + sm) : (sm + so);
                const float rs = __builtin_amdgcn_rsqf(tot * (1.f / DM) + EPS);
                if (hf == 0) { rstab[rr] = rs; if (u0.pn == 0) p.rs2[r] = rs; } }
            __syncthreads();
            pg8::EpiScaleBf16 E{p.q, DM, p.ssqp, rstab, tab_pm};
            pg8::gemm_phase<pg8::EpiScaleBf16, pg8::StaticOrder>(lds, g, S, E);
            pg8::Unit u;
            for (int ui = 0; S.next(ui, u); ++ui) { __syncthreads(); peer::topk_item(p, l, u.pm * 256, u.pn, lds); peer::topk_item(p, l, u.pm * 256 + 128, u.pn, lds); }
            __syncthreads();
        }
        SEAM(base + 5);
        if (KON(10) && IN(base + 6)) REPLOOP(10) { PP; peer::gather1_phase(p, l, lds, rep); }
        SEAM(base + 6);
        if (KON(10) && IN(base + 7)) REPLOOP(12) { PP; peer::gather_reduce_phase(p, p.rs2, (size_t)vb * NTHREADS + tid_, (size_t)G * NTHREADS); }
        SEAM(base + 7);
        if (KON(10) && IN(base + 8)) REPLOOP(11) { PP; peer::gather2_phase(p, l, lds, rep); }
        SEAM(base + 8);
    }
    if (KON(11) && IN(NPHASES - 1)) { PP; final_norm_phase(p, gw, ngw, lane); }
#undef IN
#undef SEAM
}

extern "C" void kernel_launch(void* const* d_in, const int* in_sizes, int n_in, void* d_out, int out_size, void* d_ws, size_t ws_size, hipStream_t stream) {
    static int grid = 0;
    if (grid == 0) {
        if (n_in != 18 || out_size != SEQ * DM || ws_size < WS_END) { fprintf(stderr, "kernel_launch: unexpected shapes (n_in %d, out %d, ws %zu < %zu)\n", n_in, out_size, ws_size, (size_t)WS_END); grid = -1; return; }
        int dev = 0, cus = 0;
        if (hipGetDevice(&dev) != hipSuccess || hipDeviceGetAttribute(&cus, hipDeviceAttributeMultiprocessorCount, dev) != hipSuccess) { grid = -1; return; }
        if (hipFuncSetAttribute((const void*)mega, hipFuncAttributeMaxDynamicSharedMemorySize, LDS_BYTES) != hipSuccess) { fprintf(stderr, "kernel_launch: hipFuncSetAttribute failed\n"); grid = -1; return; }
        int per_cu = 0;
        if (hipOccupancyMaxActiveBlocksPerMultiprocessor(&per_cu, (const void*)mega, NTHREADS, LDS_BYTES) != hipSuccess || per_cu < 1) fprintf(stderr, "kernel_launch: occupancy query reports %d\n", per_cu);
        (void)hipGetLastError();
        grid = cus;
    }
    if (grid < 0) return;
    unsigned char* ws = (unsigned char*)d_ws;
    (void)hipMemsetAsync(ws + WS_CTL, 0, CTL_BYTES, stream);
    Args a{};
    for (int i = 0; i < 18; ++i) a.in[i] = (const float*)d_in[i];
    a.out = (float*)d_out; a.ws = ws;
#if N_LAUNCH_MODE == 1
    a.ph_lo = 0; a.ph_hi = NPHASES;
    hipLaunchKernelGGL(mega, dim3(grid), dim3(NTHREADS), LDS_BYTES, stream, a);
#else
    for (int ph = 0; ph < NPHASES; ++ph) { a.ph_lo = ph; a.ph_hi = ph + 1; hipLaunchKernelGGL(mega, dim3(grid), dim3(NTHREADS), LDS_BYTES, stream, a); }
#endif
}
```

```cpp
#include <hip/hip_runtime.h>
#include <cstdio>
#include <cstdint>

#define LAS __attribute__((address_space(3)))
#define GAS __attribute__((address_space(1)))
typedef unsigned short bf16_t;
typedef short bf16x8 __attribute__((ext_vector_type(8)));
typedef short s16x4 __attribute__((ext_vector_type(4)));
typedef float f32x2 __attribute__((ext_vector_type(2)));
typedef float f32x4 __attribute__((ext_vector_type(4)));
typedef float f32x16 __attribute__((ext_vector_type(16)));
typedef unsigned u32x2 __attribute__((ext_vector_type(2)));
typedef unsigned u32x4 __attribute__((ext_vector_type(4)));
typedef long i64x2 __attribute__((ext_vector_type(2)));

#ifndef N_LAUNCH_MODE
#define N_LAUNCH_MODE 1
#endif

constexpr int SEQ = 8192, DM = 2048, DEPTH = 4, BWID = 512;
constexpr int NMIX = 4608, NGATE = 8192, NIN = 12800, INCOLS = 12804;
constexpr int PEER_N = 16384;
constexpr float A_SCALE = 64.f;
constexpr float V_SCALE = 16.f;
constexpr float U_SCALE = 64.f;
constexpr int C_A = 0, C_B = 1536, C_C = 2560, C_Q = 3072, C_K = 3584, C_V = 4096;
constexpr float EPS = 1e-6f;
constexpr int NTHREADS = 512, NWAVES = 8;

constexpr size_t al256(size_t x) { return (x + 255) & ~(size_t)255; }
constexpr size_t WS_CTL = 0, CTL_BYTES = 1u << 20;
constexpr size_t WS_WIN = WS_CTL + CTL_BYTES;
constexpr size_t WS_WB = WS_WIN + (size_t)DEPTH * NIN * DM * 2;
constexpr size_t WS_WO = WS_WB + (size_t)DEPTH * 4 * DM * BWID * 2;
constexpr size_t WS_WQ = WS_WO + (size_t)DEPTH * DM * DM * 2;
constexpr size_t WS_KEYS = WS_WQ + (size_t)DEPTH * DM * DM * 2;
constexpr size_t WS_U = WS_KEYS + (size_t)DEPTH * 8 * 2 * 128 * 128 * 2;
constexpr size_t WS_V = WS_U + (size_t)DEPTH * PEER_N * DM * 2;
constexpr size_t WS_SGUW = WS_V + (size_t)DEPTH * PEER_N * DM * 2;
constexpr size_t WS_POOLW = WS_SGUW + (size_t)DEPTH * 4 * 128 * 128 * 2;
constexpr size_t WS_WFG = WS_POOLW + (size_t)DEPTH * 4 * 128 * 128 * 2;
constexpr size_t WS_H = WS_WFG + (size_t)DEPTH * 4 * DM * 4;
constexpr size_t WS_MACC = WS_H + (size_t)SEQ * DM * 4;
constexpr size_t WS_XN = WS_MACC + (size_t)SEQ * DM * 4;
constexpr size_t WS_ZMIX = WS_XN + (size_t)SEQ * DM * 2;
constexpr size_t WS_ZGATE = WS_ZMIX + (size_t)SEQ * NMIX * 2;
constexpr size_t WS_BR = WS_ZGATE + (size_t)SEQ * NGATE * 2;
constexpr size_t WS_MERGED = WS_BR + (size_t)SEQ * DM * 2;
constexpr size_t WS_Q = WS_MERGED + (size_t)SEQ * DM * 2;
constexpr size_t WS_FLOG = WS_Q + (size_t)SEQ * DM * 2;
constexpr size_t WS_F = WS_FLOG + (size_t)SEQ * 4 * 4;
constexpr size_t WS_PIDX = WS_F + (size_t)SEQ * 4 * 4;
constexpr size_t WS_PGATE = WS_PIDX + (size_t)SEQ * 128 * 4;
constexpr size_t WS_PQ = WS_PGATE + (size_t)SEQ * 128 * 4;
constexpr size_t WS_AB = WS_PQ + (size_t)8 * SEQ * 128 * 4;
constexpr size_t WS_HN8 = WS_AB + (size_t)SEQ * 128 * 2;
constexpr size_t WS_SSQP = WS_HN8 + (size_t)SEQ * DM;
constexpr size_t WS_RS2 = WS_SSQP + (size_t)SEQ * 32 * 4;
constexpr size_t WS_END = WS_RS2 + (size_t)SEQ * 4;
static_assert(WS_WB % 256 == 0 && WS_U % 256 == 0 && WS_H % 256 == 0 && WS_ZMIX % 256 == 0 && WS_F % 256 == 0, "ws alignment");

constexpr int LDS_BYTES = 155648;
constexpr int LDS_BARW = LDS_BYTES - 64;

struct Params {
    const float *x, *norm1_g, *w_in, *conv_w, *sgu_norm_g, *sgu_w, *sgu_b, *pool_w, *pool_scale, *forget_b, *w_branch, *w_out, *norm2_g, *peer_wq, *peer_keys, *peer_u, *peer_v, *final_g;
    float* out;
    bf16_t *WinT, *WbT, *WoT, *WqT, *keysB, *uS, *vS, *sguW, *poolWT;
    float *wfg, *h, *macc, *flog, *F, *pgate, *pq;
    bf16_t* aB;
    unsigned char *uS8, *vS8, *hn8, *aB8;
    float *ssqp, *rs2;
    bf16_t *xn, *zmix, *br, *merged, *q;
    bf16_t* po;
    unsigned char* zgate;
    int* pidx;
    unsigned* ctl;
};
struct Args { const float* in[18]; float* out; unsigned char* ws; int ph_lo, ph_hi; };
constexpr int TPW = 16;
constexpr int LDS_PTAB = LDS_BYTES - 256;
constexpr int LDS_RSTAB = 135168;
constexpr int LDS_MISC = LDS_BYTES - 512;
constexpr int CW_MIXQ = 8192;
constexpr int CW_KN = 12288;
constexpr int CW_QCNT = 16384;

__device__ __forceinline__ unsigned f2bf(float f) { unsigned u = __float_as_uint(f); return (u + 0x7fffu + ((u >> 16) & 1u)) >> 16; }
__device__ __forceinline__ unsigned pk2(float lo, float hi) { return f2bf(lo) | (f2bf(hi) << 16); }
__device__ __forceinline__ float bflo(unsigned w) { return __uint_as_float(w << 16); }
__device__ __forceinline__ float bfhi(unsigned w) { return __uint_as_float(w & 0xffff0000u); }
__device__ __forceinline__ float bf1(bf16_t v) { return __uint_as_float((unsigned)v << 16); }
__device__ __forceinline__ unsigned cvtpk(float lo, float hi) { unsigned r; asm volatile("v_cvt_pk_bf16_f32 %0, %1, %2" : "=v"(r) : "v"(lo), "v"(hi)); return r; }
__device__ __forceinline__ float clamp8(float x) { return fminf(fmaxf(x, -448.f), 448.f); }
__device__ __forceinline__ float gelu_t(float x) {
    const float u = x + 0.044715f * x * x * x;
    const float e = __builtin_amdgcn_exp2f(-2.3022081985f * u);
    return x * __builtin_amdgcn_rcpf(1.0f + e);
}
__device__ __forceinline__ float sigmoid_f(float x) { return __builtin_amdgcn_rcpf(1.0f + __builtin_amdgcn_exp2f(-1.4426950409f * x)); }
__device__ __forceinline__ float wave_sum(float v) {
#pragma unroll
    for (int o = 1; o < 64; o <<= 1) v += __shfl_xor(v, o);
    return v;
}
__device__ __forceinline__ unsigned xb_xcc_id() { return (unsigned)__builtin_amdgcn_s_getreg((3 << 11) | 20) & 0xFu; }
__device__ __forceinline__ int ltid() { int t = threadIdx.x; asm volatile("" : "+v"(t)); return t; }
__device__ __forceinline__ int lbid() { int b = blockIdx.x; asm volatile("" : "+s"(b)); return b; }
__device__ __forceinline__ f32x4 mfma16(bf16x8 x, bf16x8 y, f32x4 c) { return __builtin_amdgcn_mfma_f32_16x16x32_bf16(x, y, c, 0, 0, 0); }

namespace pg8 {
constexpr int BM = 256, BK = 64, HALF = 128, HTB = HALF * BK * 2, STAGE_BYTES = 8 * HTB, NXCD = 8, WGM = 8;
__host__ __device__ __forceinline__ int lds_byte(int r, int c) { const int st = (r >> 4) * 2 + (c >> 5), rr = r & 15, cc = c & 31, ob = rr * 64 + cc * 2; return st * 1024 + (ob ^ (((ob >> 9) & 1) << 5)); }
__host__ __device__ __forceinline__ void stage_rc(int b, int& R, int& C) { const int st = b / 1024, sb = b % 1024, swz = sb ^ (((sb >> 9) & 1) << 5); R = (st >> 1) * 16 + swz / 64; C = (st & 1) * 32 + (swz % 64) / 2; }
__host__ __device__ __forceinline__ int perm32(int rho) { const int n = rho >> 4, i = rho & 15; return 8 * (i >> 2) + 4 * n + (i & 3); }

struct Unit { int pm, pn, aco, bro; };
struct Gemm { const bf16_t* A; const bf16_t* Bt; int M, N, K, lda, ldb; };

struct StaticOrder {
    int nM, nN, nwg, G, c, i0, imax;
    __host__ __device__ __forceinline__ void init(int M, int N, int G_, int c_) { nM = M / BM; nN = N / BM; nwg = nM * nN; G = G_; c = c_; i0 = 0; imax = 1 << 30; }
    __host__ __device__ __forceinline__ bool next(int i_, Unit& u) const {
        const int i = i_ + i0; if (i >= imax) return false;
        const long L = (long)i * G + c; if (L >= nwg) return false;
        int wgid = (int)L; { const int q = nwg / NXCD, r = nwg % NXCD, xcd = wgid % NXCD, off = wgid / NXCD; wgid = (xcd < r ? xcd * (q + 1) : r * (q + 1) + (xcd - r) * q) + off; }
        const int nig = WGM * nN, gid = wgid / nig, fm = gid * WGM, gsz = (nM - fm) < WGM ? (nM - fm) : WGM;
        u.pm = fm + ((wgid % nig) % gsz); u.pn = (wgid % nig) / gsz; u.aco = 0; u.bro = 0; return true;
    }
};
struct MergeOrder {
    StaticOrder so;
    __host__ __device__ __forceinline__ bool next(int i, Unit& u) const { if (!so.next(i >> 2, u)) return false; const int n = i & 3; u.aco = n * BWID; u.bro = n * DM; return true; }
};

template <class Epi, class Sched>
__device__ __forceinline__ void gemm_phase(LAS unsigned char* lds, const Gemm g, const Sched& S, const Epi& E) {
    const int tid = ltid(), wid = __builtin_amdgcn_readfirstlane(tid >> 6), lane = tid & 63, wr = wid >> 2, wc = wid & 3, fr = lane & 15, fq = lane >> 4;
    const int K = g.K, nt = K / BK;
    unsigned voffA[2], voffB[2];
#pragma unroll
    for (int i = 0; i < 2; ++i) { int R, C; stage_rc(tid * 16 + i * 8192, R, C); const int Rb = Epi::PERM ? ((R & ~31) + perm32(R & 31)) : R;
        voffA[i] = (unsigned)(R * g.lda + C) * 2u; voffB[i] = (unsigned)(Rb * g.ldb + C) * 2u; }
    const size_t kstep = (size_t)(BK * 2);
    const size_t hstepA = (size_t)HALF * g.lda * 2, hstepB = (size_t)HALF * g.ldb * 2;
    const unsigned ldsw = (unsigned)wid * 1024u;
    const int aoff = lds_byte(wr * 64 + fr, fq * 8), boff = lds_byte(wc * 32 + fr, fq * 8);
#define PG8_UA(u) ((const char*)g.A + ((size_t)(u).pm * BM * g.lda + (size_t)(u).aco) * 2)
#define PG8_UB(u) ((const char*)g.Bt + ((size_t)((u).pn * BM + (u).bro) * g.ldb) * 2)
#define PG8_SA(b, h) (((b) * 2 + (h)) * HTB)
#define PG8_SB(b, h) ((4 + (b) * 2 + (h)) * HTB)
#define PG8_STAGE(bufoff, gbase, voff) do { _Pragma("unroll") for (int _i = 0; _i < 2; ++_i) \
        __builtin_amdgcn_global_load_lds((const unsigned*)((const char*)(gbase) + (voff)[_i]), (LAS unsigned*)(lds + (bufoff) + ldsw + _i * 8192), 16, 0, 0); } while (0)
#define PG8_LDA(dst, b, h) do { _Pragma("unroll") for (int m = 0; m < 4; ++m) _Pragma("unroll") for (int k = 0; k < 2; ++k) dst[m][k] = *(const LAS bf16x8*)(lds + PG8_SA(b, h) + aoff + m * 2048 + k * 1024); } while (0)
#define PG8_LDB(dst, b, h) do { _Pragma("unroll") for (int n = 0; n < 2; ++n) _Pragma("unroll") for (int k = 0; k < 2; ++k) dst[n][k] = *(const LAS bf16x8*)(lds + PG8_SB(b, h) + boff + n * 2048 + k * 1024); } while (0)
#define PG8_MMA(ai, bj, At, Bt) do { __builtin_amdgcn_s_setprio(1); _Pragma("unroll") for (int m = 0; m < 4; ++m) _Pragma("unroll") for (int n = 0; n < 2; ++n) _Pragma("unroll") for (int k = 0; k < 2; ++k) \
        acc[ai][bj][m][n] = __builtin_amdgcn_mfma_f32_16x16x32_bf16(Bt[n][k], At[m][k], acc[ai][bj][m][n], 0, 0, 0); __builtin_amdgcn_s_setprio(0); } while (0)
#define PG8_WAIT_V(n) asm volatile("s_waitcnt vmcnt(" #n ")" ::: "memory")
#define PG8_WAIT_L(n) asm volatile("s_waitcnt lgkmcnt(" #n ")" ::: "memory")
#define PG8_BAR __builtin_amdgcn_s_barrier()
#define PG8_SCHED __builtin_amdgcn_sched_barrier(0)
    Unit cur, nxt; int ui = 0;
    if (!S.next(0, cur)) return;
    f32x4 acc[2][2][4][2];
#pragma unroll
    for (int a = 0; a < 2; ++a)
#pragma unroll
        for (int b = 0; b < 2; ++b)
#pragma unroll
            for (int m = 0; m < 4; ++m)
#pragma unroll
                for (int n = 0; n < 2; ++n) acc[a][b][m][n] = (f32x4){0.f, 0.f, 0.f, 0.f};
    bf16x8 At[4][2], B0[2][2], B1[2][2];
    const char* cA = PG8_UA(cur); const char* cB = PG8_UB(cur);
    PG8_STAGE(PG8_SB(0, 0), cB, voffB); PG8_STAGE(PG8_SB(0, 1), cB + hstepB, voffB); PG8_STAGE(PG8_SA(0, 0), cA, voffA); PG8_STAGE(PG8_SA(0, 1), cA + hstepA, voffA);
    if (wr == 1) PG8_BAR;
    PG8_WAIT_V(2); PG8_BAR;
    PG8_STAGE(PG8_SB(1, 0), cB + kstep, voffB); PG8_STAGE(PG8_SA(1, 0), cA + kstep, voffA); PG8_STAGE(PG8_SB(1, 1), cB + hstepB + kstep, voffB);
    PG8_WAIT_V(6); PG8_BAR;
    for (;;) {
        const bool has_next = S.next(ui + 1, nxt);
        const char* nA = has_next ? PG8_UA(nxt) : cA; const char* nB = has_next ? PG8_UB(nxt) : cB;
        for (int t = 0; t < nt; t += 2) {
            const bool last = (t == nt - 2);
            const char* a1 = cA + (size_t)(t + 1) * kstep;
            const char* a2 = last ? nA : cA + (size_t)(t + 2) * kstep; const char* b2 = last ? nB : cB + (size_t)(t + 2) * kstep;
            const char* a3 = a2 + kstep; const char* b3 = b2 + kstep;
            PG8_LDB(B0, 0, 0); PG8_LDB(B1, 0, 1); PG8_SCHED; PG8_LDA(At, 0, 0); PG8_STAGE(PG8_SA(1, 1), a1 + hstepA, voffA);
            PG8_WAIT_V(8); PG8_WAIT_L(0); PG8_BAR; PG8_MMA(0, 0, At, B0); PG8_MMA(0, 1, At, B1); PG8_BAR; PG8_SCHED;
            PG8_LDA(At, 0, 1); PG8_STAGE(PG8_SB(0, 0), b2, voffB); PG8_STAGE(PG8_SB(0, 1), b2 + hstepB, voffB); PG8_STAGE(PG8_SA(0, 0), a2, voffA);
            PG8_WAIT_V(8); PG8_WAIT_L(0); PG8_BAR; PG8_MMA(1, 0, At, B0); PG8_MMA(1, 1, At, B1); PG8_BAR; PG8_SCHED;
            PG8_LDB(B0, 1, 0); PG8_LDB(B1, 1, 1); PG8_SCHED; PG8_LDA(At, 1, 0); PG8_STAGE(PG8_SA(0, 1), a2 + hstepA, voffA);
            PG8_WAIT_V(8); PG8_WAIT_L(0); PG8_BAR; PG8_MMA(0, 0, At, B0); PG8_MMA(0, 1, At, B1); PG8_BAR; PG8_SCHED;
            PG8_LDA(At, 1, 1); PG8_STAGE(PG8_SB(1, 0), b3, voffB); PG8_STAGE(PG8_SB(1, 1), b3 + hstepB, voffB); PG8_STAGE(PG8_SA(1, 0), a3, voffA);
            PG8_WAIT_V(8); PG8_WAIT_L(0); PG8_BAR; PG8_MMA(1, 0, At, B0); PG8_MMA(1, 1, At, B1); PG8_BAR; PG8_SCHED;
        }
        if (wr == 0) PG8_BAR;
        bool keep = false;
        if constexpr (Epi::HORNER) keep = E.scale(acc, cur, wr, wc, fr, fq); else E(acc, cur, wr, wc, fr, fq);
        if (!has_next) break;
        if (!keep) {
#pragma unroll
        for (int a = 0; a < 2; ++a)
#pragma unroll
            for (int b = 0; b < 2; ++b)
#pragma unroll
                for (int m = 0; m < 4; ++m)
#pragma unroll
                    for (int n = 0; n < 2; ++n) acc[a][b][m][n] = (f32x4){0.f, 0.f, 0.f, 0.f};
        }
        cur = nxt; cA = nA; cB = nB; ++ui;
        if (wr == 1) PG8_BAR;
    }
    PG8_WAIT_V(0);
    PG8_BAR;
#undef PG8_UA
#undef PG8_UB
#undef PG8_SA
#undef PG8_SB
#undef PG8_STAGE
#undef PG8_LDA
#undef PG8_LDB
#undef PG8_MMA
#undef PG8_WAIT_V
#undef PG8_WAIT_L
#undef PG8_BAR
#undef PG8_SCHED
}

__device__ __forceinline__ size_t gate_off(int row, int gcol) { return ((size_t)(row >> 4) * (NGATE / 32) + (size_t)(gcol >> 5)) * 512 + (size_t)((row & 15) * 32 + (gcol & 31)); }
struct EpiInproj {
    static constexpr bool PERM = true; static constexpr bool HORNER = false;
    bf16_t* zmix; unsigned char* zgate; unsigned* kn;
    __device__ __forceinline__ void operator()(const f32x4 (&acc)[2][2][4][2], const Unit& u, int wr, int wc, int fr, int fq) const {
        if (u.pn == C_K / BM || u.pn == C_K / BM + 1) {
#pragma unroll
            for (int bj = 0; bj < 2; ++bj) { float mx = 0.f;
#pragma unroll
                for (int ai = 0; ai < 2; ++ai)
#pragma unroll
                    for (int m = 0; m < 4; ++m) { const f32x4 a = acc[ai][bj][m][0], b = acc[ai][bj][m][1];
                        float q2 = (a[0] * a[0] + a[1] * a[1]) + (a[2] * a[2] + a[3] * a[3]) + (b[0] * b[0] + b[1] * b[1]) + (b[2] * b[2] + b[3] * b[3]);
                        q2 += __shfl_xor(q2, 16); q2 += __shfl_xor(q2, 32); mx = fmaxf(mx, q2); }
#pragma unroll
                for (int o = 1; o < 16; o <<= 1) mx = fmaxf(mx, __shfl_xor(mx, o));
                if ((threadIdx.x & 63) == 0) atomicMax(kn + ((u.pn - C_K / BM) * 2 + bj) * 4 + wc, __float_as_uint(mx)); }
        }
        const int row0 = u.pm * BM + wr * 64 + fr; int colt = u.pn * BM; const bool gate = colt >= NMIX;
        if (gate) {
            const int col0 = colt - NMIX + wc * 32 + 8 * fq;
#pragma unroll
            for (int ai = 0; ai < 2; ++ai)
#pragma unroll
                for (int m = 0; m < 4; ++m) { const int grow = row0 + ai * HALF + m * 16;
#pragma unroll
                    for (int bj = 0; bj < 2; ++bj) { const f32x4 v0 = acc[ai][bj][m][0], v1 = acc[ai][bj][m][1]; unsigned w0 = 0u, w1 = 0u;
#pragma unroll
                        for (int e = 0; e < 4; ++e) { w0 = __builtin_amdgcn_cvt_pk_u8_f32(__builtin_truncf(sigmoid_f(v0[e]) * 255.f + 0.5f), e, w0);
                                                      w1 = __builtin_amdgcn_cvt_pk_u8_f32(__builtin_truncf(sigmoid_f(v1[e]) * 255.f + 0.5f), e, w1); }
                        *(u32x2*)(zgate + gate_off(grow, col0 + bj * HALF)) = (u32x2){w0, w1}; } }
            return;
        }
        bf16_t* base = zmix; const int ldc = NMIX;
        const int col0 = colt + wc * 32 + 8 * fq;
#pragma unroll
        for (int ai = 0; ai < 2; ++ai)
#pragma unroll
            for (int m = 0; m < 4; ++m) { bf16_t* rowp = base + (size_t)(row0 + ai * HALF + m * 16) * ldc + col0;
#pragma unroll
                for (int bj = 0; bj < 2; ++bj) { const f32x4 v0 = acc[ai][bj][m][0], v1 = acc[ai][bj][m][1];
                    u32x4 w; w.x = cvtpk(v0[0], v0[1]); w.y = cvtpk(v0[2], v0[3]); w.z = cvtpk(v1[0], v1[1]); w.w = cvtpk(v1[2], v1[3]);
                    *(u32x4*)(rowp + bj * HALF) = w; } }
    }
};
struct EpiBf16 {
    static constexpr bool PERM = true; static constexpr bool HORNER = false;
    bf16_t* O; int ldc;
    __device__ __forceinline__ void operator()(const f32x4 (&acc)[2][2][4][2], const Unit& u, int wr, int wc, int fr, int fq) const {
        const int row0 = u.pm * BM + wr * 64 + fr; const int col0 = u.pn * BM + wc * 32 + 8 * fq;
#pragma unroll
        for (int ai = 0; ai < 2; ++ai)
#pragma unroll
            for (int m = 0; m < 4; ++m) { bf16_t* rowp = O + (size_t)(row0 + ai * HALF + m * 16) * ldc + col0;
#pragma unroll
                for (int bj = 0; bj < 2; ++bj) { const f32x4 v0 = acc[ai][bj][m][0], v1 = acc[ai][bj][m][1];
                    u32x4 w; w.x = cvtpk(v0[0], v0[1]); w.y = cvtpk(v0[2], v0[3]); w.z = cvtpk(v1[0], v1[1]); w.w = cvtpk(v1[2], v1[3]);
                    *(u32x4*)(rowp + bj * HALF) = w; } }
    }
};
struct EpiMerge {
    static constexpr bool PERM = true; static constexpr bool HORNER = true;
    const unsigned char* G; bf16_t* merged;
    __device__ __forceinline__ bool scale(f32x4 (&acc)[2][2][4][2], const Unit& u, int wr, int wc, int fr, int fq) const {
        const int n = u.aco >> 9; const int col0 = u.pn * BM + wc * 32 + 8 * fq; const bool last = (n == 3);
#pragma unroll
        for (int ai = 0; ai < 2; ++ai) {
            u32x2 gw[4][2], gx[4][2];
#pragma unroll
            for (int m = 0; m < 4; ++m) { const int r = u.pm * BM + ai * HALF + wr * 64 + m * 16 + fr;
#pragma unroll
                for (int bj = 0; bj < 2; ++bj) { const int c = col0 + bj * HALF;
                    gw[m][bj] = *(const u32x2*)(G + gate_off(r, n * DM + c));
                    gx[m][bj] = last ? gw[m][bj] : *(const u32x2*)(G + gate_off(r, (n + 1) * DM + c)); } }
#pragma unroll
            for (int m = 0; m < 4; ++m) { const int r = u.pm * BM + ai * HALF + wr * 64 + m * 16 + fr;
#pragma unroll
                for (int bj = 0; bj < 2; ++bj) { const int c = col0 + bj * HALF; const u32x2 g = gw[m][bj], x = gx[m][bj];
                    f32x4 v0 = acc[ai][bj][m][0], v1 = acc[ai][bj][m][1];
#pragma unroll
                    for (int e = 0; e < 4; ++e) {
                        const float k0 = fmaxf((float)((g.x >> (8 * e)) & 0xffu), 1.f), k1 = fmaxf((float)((g.y >> (8 * e)) & 0xffu), 1.f);
                        const float d0 = last ? (1.f / 255.f) : __builtin_amdgcn_rcpf(fmaxf((float)((x.x >> (8 * e)) & 0xffu), 1.f));
                        const float d1 = last ? (1.f / 255.f) : __builtin_amdgcn_rcpf(fmaxf((float)((x.y >> (8 * e)) & 0xffu), 1.f));
                        v0[e] *= k0 * d0; v1[e] *= k1 * d1; }
                    if (last) { u32x4 w; w.x = cvtpk(v0[0], v0[1]); w.y = cvtpk(v0[2], v0[3]); w.z = cvtpk(v1[0], v1[1]); w.w = cvtpk(v1[2], v1[3]);
                        *(u32x4*)(merged + (size_t)r * DM + c) = w; }
                    else { acc[ai][bj][m][0] = v0; acc[ai][bj][m][1] = v1; } } }
        }
        return !last;
    }
};
struct EpiResNorm {
    static constexpr bool PERM = true; static constexpr bool HORNER = false;
    const float* base; const bf16_t* po; float* h; const float* gain; bf16_t* xn; unsigned char* hn8; float* part;
    __device__ __forceinline__ void operator()(const f32x4 (&acc)[2][2][4][2], const Unit& u, int wr, int wc, int fr, int fq) const {
        const int col0 = u.pn * BM + wc * 32 + 8 * fq;
        f32x4 gv[2][2];
#pragma unroll
        for (int bj = 0; bj < 2; ++bj) { gv[bj][0] = *(const f32x4*)(gain + col0 + bj * HALF); gv[bj][1] = *(const f32x4*)(gain + col0 + bj * HALF + 4); }
#pragma unroll
        for (int ai = 0; ai < 2; ++ai)
#pragma unroll
            for (int mp2 = 0; mp2 < 2; ++mp2) {
                f32x4 bv[2][2][2]; u32x4 pv[2][2];
#pragma unroll
                for (int mm = 0; mm < 2; ++mm) { const int r = u.pm * BM + ai * HALF + wr * 64 + (mp2 * 2 + mm) * 16 + fr;
#pragma unroll
                    for (int bj = 0; bj < 2; ++bj) { const f32x4* bp = (const f32x4*)(base + (size_t)r * DM + col0 + bj * HALF); bv[mm][bj][0] = bp[0]; bv[mm][bj][1] = bp[1];
                        pv[mm][bj] = (u32x4){0u, 0u, 0u, 0u}; if (po) pv[mm][bj] = *(const u32x4*)(po + (size_t)r * DM + col0 + bj * HALF); } }
#pragma unroll
                for (int mm = 0; mm < 2; ++mm) { const int m = mp2 * 2 + mm; const int r = u.pm * BM + ai * HALF + wr * 64 + m * 16 + fr; float q2 = 0.f;
#pragma unroll
                    for (int bj = 0; bj < 2; ++bj) { const size_t off = (size_t)r * DM + col0 + bj * HALF; const u32x4 pw_ = pv[mm][bj];
                        const f32x4 v0 = bv[mm][bj][0] + acc[ai][bj][m][0] + (f32x4){bflo(pw_.x), bfhi(pw_.x), bflo(pw_.y), bfhi(pw_.y)}, v1 = bv[mm][bj][1] + acc[ai][bj][m][1] + (f32x4){bflo(pw_.z), bfhi(pw_.z), bflo(pw_.w), bfhi(pw_.w)};
                        f32x4* hp = (f32x4*)(h + off); hp[0] = v0; hp[1] = v1;
                        q2 += (v0[0] * v0[0] + v0[1] * v0[1]) + (v0[2] * v0[2] + v0[3] * v0[3]) + (v1[0] * v1[0] + v1[1] * v1[1]) + (v1[2] * v1[2] + v1[3] * v1[3]);
                        const f32x4 y0 = v0 * gv[bj][0], y1 = v1 * gv[bj][1];
                        u32x4 w; w.x = cvtpk(y0[0], y0[1]); w.y = cvtpk(y0[2], y0[3]); w.z = cvtpk(y1[0], y1[1]); w.w = cvtpk(y1[2], y1[3]);
                        *(u32x4*)(xn + off) = w;
                        int f0 = __builtin_amdgcn_cvt_pk_fp8_f32(clamp8(y0[0]), clamp8(y0[1]), 0, false); f0 = __builtin_amdgcn_cvt_pk_fp8_f32(clamp8(y0[2]), clamp8(y0[3]), f0, true);
                        int f1 = __builtin_amdgcn_cvt_pk_fp8_f32(clamp8(y1[0]), clamp8(y1[1]), 0, false); f1 = __builtin_amdgcn_cvt_pk_fp8_f32(clamp8(y1[2]), clamp8(y1[3]), f1, true);
                        *(u32x2*)(hn8 + off) = (u32x2){(unsigned)f0, (unsigned)f1}; }
                    q2 += __shfl_xor(q2, 16); q2 += __shfl_xor(q2, 32);
                    if (fq == 0) part[(size_t)r * 32 + u.pn * 4 + wc] = q2; }
            }
    }
};
__device__ __forceinline__ float row_rs(const float* part, int r) {
    const f32x4* pp = (const f32x4*)(part + (size_t)r * 32); float s = 0.f;
#pragma unroll
    for (int k = 0; k < 8; ++k) { const f32x4 v = pp[k]; s += v[0]; s += v[1]; s += v[2]; s += v[3]; }
    return __builtin_amdgcn_rsqf(s * (1.f / DM) + EPS);
}
struct EpiScaleBf16 {
    static constexpr bool PERM = true; static constexpr bool HORNER = false;
    bf16_t* O; int ldc; const float* part; const LAS float* rstab; int tab_pm;
    __device__ __forceinline__ void operator()(const f32x4 (&acc)[2][2][4][2], const Unit& u, int wr, int wc, int fr, int fq) const {
        const int row0 = u.pm * BM + wr * 64 + fr; const int col0 = u.pn * BM + wc * 32 + 8 * fq;
#pragma unroll
        for (int ai = 0; ai < 2; ++ai)
#pragma unroll
            for (int m = 0; m < 4; ++m) { const int r = row0 + ai * HALF + m * 16; bf16_t* rowp = O + (size_t)r * ldc + col0;
                const float rs = (u.pm == tab_pm) ? rstab[r - u.pm * BM] : row_rs(part, r);
#pragma unroll
                for (int bj = 0; bj < 2; ++bj) { const f32x4 v0 = acc[ai][bj][m][0] * rs, v1 = acc[ai][bj][m][1] * rs;
                    u32x4 w; w.x = cvtpk(v0[0], v0[1]); w.y = cvtpk(v0[2], v0[3]); w.z = cvtpk(v1[0], v1[1]); w.w = cvtpk(v1[2], v1[3]);
                    *(u32x4*)(rowp + bj * HALF) = w; } }
    }
};
}

namespace fa {
constexpr float SCALE = 0.08838834764831845f, INV_SCALE = 11.313708498984761f, THR = 8.f;
constexpr int QBLK = 32, KVBLK = 64, QB = 256;
constexpr int SHM_V = KVBLK * 128 * 2, SHM_K = KVBLK * 128 * 2;
constexpr int OFF_V = 0, OFF_K = 2 * SHM_V, OFF_FK = OFF_K + 2 * SHM_K, OFF_WS = OFF_FK + 2 * 64 * 4;
#define KSWZ(row, colB) ((row) * 256 + ((colB) ^ (((row) & 7) << 4)))
#define SBAR() __builtin_amdgcn_sched_barrier(0)
__device__ __forceinline__ int v_st(int k, int c) { const int kk = (k & ~0xC) | ((k & 4) << 1) | ((k & 8) >> 1); return ((kk >> 3) * 4 + (c >> 5)) * 512 + ((kk & 7) * 32 + (c & 31)) * 2; }
__device__ __forceinline__ int v_rd_base(int lane) { return ((lane & 3) << 3) | (((lane >> 2) & 3) << 6) | (((lane >> 4) & 1) << 5) | (((lane >> 5) & 1) << 8); }
constexpr int v_rd_off(int d0, int ks, int half) { return d0 * 512 + ks * 4096 + half * 2048; }
__device__ __forceinline__ int crow(int r, int hi) { return (r & 3) + 8 * (r >> 2) + 4 * hi; }
__device__ __forceinline__ void mask_tile(f32x16& p0, f32x16& p1, int dq) {
    const float NEG = -__builtin_inff();
#pragma unroll
    for (int r = 0; r < 16; ++r) {
        const int c = (r & 3) + 8 * (r >> 2);
        if (dq - c < 0) p0[r] = NEG;
        if (dq - c - 32 < 0) p1[r] = NEG;
    }
}
__device__ __forceinline__ void partialSM(f32x16& p0, f32x16& p1, float& m_reg, float& mn, float& alpha) {
    float pmax = p0[0];
#pragma unroll
    for (int r = 1; r < 16; ++r) pmax = fmaxf(pmax, p0[r]);
#pragma unroll
    for (int r = 0; r < 16; ++r) pmax = fmaxf(pmax, p1[r]);
    { auto rr = __builtin_amdgcn_permlane32_swap(__float_as_uint(pmax), __float_as_uint(pmax), false, false);
      pmax = fmaxf(__uint_as_float(rr[0]), __uint_as_float(rr[1])); }
    constexpr float C2 = 1.4426950408889634f * SCALE;
    if (__builtin_expect(__all((pmax - m_reg) * SCALE <= THR), 1)) { mn = m_reg; alpha = 1.f; }
    else { mn = fmaxf(m_reg, pmax); alpha = __builtin_amdgcn_exp2f((m_reg - mn) * C2); m_reg = mn; }
    const float mnL = -mn * C2;
#pragma unroll
    for (int r = 0; r < 16; ++r) p0[r] = fmaf(p0[r], C2, mnL);
#pragma unroll
    for (int r = 0; r < 16; ++r) p1[r] = fmaf(p1[r], C2, mnL);
#pragma unroll
    for (int r = 0; r < 16; ++r) p0[r] = __builtin_amdgcn_exp2f(p0[r]);
}
__device__ __forceinline__ void finishSM(f32x16& p0, f32x16& p1, float alpha, float& l_reg, bf16x8& pa0, bf16x8& pa1, bf16x8& pa2, bf16x8& pa3) {
#pragma unroll
    for (int r = 0; r < 16; ++r) p1[r] = __builtin_amdgcn_exp2f(p1[r]);
    float ps = 0;
#pragma unroll
    for (int r = 0; r < 16; ++r) ps += p0[r];
#pragma unroll
    for (int r = 0; r < 16; ++r) ps += p1[r];
    { auto rr = __builtin_amdgcn_permlane32_swap(__float_as_uint(ps), __float_as_uint(ps), false, false);
      ps = __uint_as_float(rr[0]) + __uint_as_float(rr[1]); }
    l_reg = l_reg * alpha + ps;
#define PK4(P, B_, OUT) do { unsigned a0 = cvtpk(P[B_+0], P[B_+1]), a1 = cvtpk(P[B_+2], P[B_+3]);                          \
        unsigned b0 = cvtpk(P[B_+4], P[B_+5]), b1 = cvtpk(P[B_+6], P[B_+7]);                                             \
        auto r0 = __builtin_amdgcn_permlane32_swap(a0, b0, false, false); auto r1 = __builtin_amdgcn_permlane32_swap(a1, b1, false, false); \
        u32x4 w = {r0[0], r1[0], r0[1], r1[1]}; OUT = *reinterpret_cast<bf16x8*>(&w); } while (0)
    PK4(p0, 0, pa0); PK4(p0, 8, pa1); PK4(p1, 0, pa2); PK4(p1, 8, pa3);
#undef PK4
}
__device__ __forceinline__ void qkt(f32x16& p0, f32x16& p1, const LAS char* kbuf, const LAS float* fk, float Fq, int r32, int hi, const bf16x8* qr) {
#pragma unroll
    for (int a = 0; a < 4; ++a) { const f32x4 f0 = *(const LAS f32x4*)(fk + 8 * a + 4 * hi), f1 = *(const LAS f32x4*)(fk + 32 + 8 * a + 4 * hi);
#pragma unroll
        for (int b = 0; b < 4; ++b) { p0[4 * a + b] = (Fq - f0[b]) * INV_SCALE; p1[4 * a + b] = (Fq - f1[b]) * INV_SCALE; } }
    const LAS char* kb[4];
#pragma unroll
    for (int dd = 0; dd < 4; ++dd) kb[dd] = kbuf + KSWZ(r32, (dd * 16 + hi * 8) * 2);
#pragma unroll
    for (int d0 = 0; d0 < 8; ++d0) { const LAS char* a = kb[d0 & 3] + (d0 >> 2) * 128;
        bf16x8 b0 = *reinterpret_cast<const LAS bf16x8*>(a);
        bf16x8 b1 = *reinterpret_cast<const LAS bf16x8*>(a + 32 * 256);
        p0 = __builtin_amdgcn_mfma_f32_32x32x16_bf16(b0, qr[d0], p0, 0, 0, 0);
        p1 = __builtin_amdgcn_mfma_f32_32x32x16_bf16(b1, qr[d0], p1, 0, 0, 0); }
}
__device__ __forceinline__ void pv_tile(f32x16* o, int vb0, bf16x8 pa0, bf16x8 pa1, bf16x8 pa2, bf16x8 pa3) {
#define TRRD(dst, off) asm volatile("ds_read_b64_tr_b16 %0, %1 offset:%2" : "=&v"(dst) : "v"(vb0), "i"(off) : "memory")
#define PV_D0(d0) do { s16x4 l0, l1, l2, l3, h0, h1, h2, h3; constexpr int b_ = v_rd_off(d0, 0, 0); \
        TRRD(l0, b_); TRRD(h0, b_ + 2048); TRRD(l1, b_ + 4096); TRRD(h1, b_ + 6144); TRRD(l2, b_ + 8192); TRRD(h2, b_ + 10240); TRRD(l3, b_ + 12288); TRRD(h3, b_ + 14336); \
        asm volatile("s_waitcnt lgkmcnt(0)" ::: "memory"); SBAR();   \
        o[d0] = __builtin_amdgcn_mfma_f32_32x32x16_bf16(pa0, (bf16x8){l0[0], l0[1], l0[2], l0[3], h0[0], h0[1], h0[2], h0[3]}, o[d0], 0, 0, 0);   \
        o[d0] = __builtin_amdgcn_mfma_f32_32x32x16_bf16(pa1, (bf16x8){l1[0], l1[1], l1[2], l1[3], h1[0], h1[1], h1[2], h1[3]}, o[d0], 0, 0, 0);   \
        o[d0] = __builtin_amdgcn_mfma_f32_32x32x16_bf16(pa2, (bf16x8){l2[0], l2[1], l2[2], l2[3], h2[0], h2[1], h2[2], h2[3]}, o[d0], 0, 0, 0);   \
        o[d0] = __builtin_amdgcn_mfma_f32_32x32x16_bf16(pa3, (bf16x8){l3[0], l3[1], l3[2], l3[3], h3[0], h3[1], h3[2], h3[3]}, o[d0], 0, 0, 0); } while (0)
    PV_D0(0); PV_D0(1); PV_D0(2); PV_D0(3);
#undef PV_D0
#undef TRRD
}
__device__ __forceinline__ void attn_unit(const bf16_t* __restrict__ zmix, const float* __restrict__ Fh, bf16_t* __restrict__ br, int g, int qb, float kn2, LAS char* lds) {
    const int tid = ltid(), wid = __builtin_amdgcn_readfirstlane(tid >> 6), lane = tid & 63, r32 = lane & 31, hi = lane >> 5;
    const bf16_t* Zq = zmix + C_Q + g * 128; const bf16_t* Zk = zmix + C_K + g * 128; const bf16_t* Zv = zmix + C_V + g * 128;
    const int P0 = qb * QB, j_hi = (P0 + QB) / KVBLK;
    const int qlo = P0 + wid * QBLK, qm = qlo + r32 - 4 * hi;
    LAS char* V_lds = lds + OFF_V; LAS char* K_lds = lds + OFF_K; LAS float* FK_lds = (LAS float*)(lds + OFF_FK);
    LAS float* wsf = (LAS float*)(lds + OFF_WS) + wid * 64; LAS float* li_l = wsf; LAS float* al_l = wsf + 32;
    bf16x8 qr[8];
#pragma unroll
    for (int d0 = 0; d0 < 8; ++d0) qr[d0] = *(const bf16x8*)(Zq + (size_t)(qlo + r32) * NMIX + d0 * 16 + hi * 8);
    const float Fq = Fh[qlo + r32];
    int j_lo; float qrow2;
    {
        float qs = 0.f;
#pragma unroll
        for (int d0 = 0; d0 < 8; ++d0)
#pragma unroll
            for (int e = 0; e < 8; ++e) { const float v = bf1((bf16_t)qr[d0][e]); qs = fmaf(v, v, qs); }
        { auto rr = __builtin_amdgcn_permlane32_swap(__float_as_uint(qs), __float_as_uint(qs), false, false); qs = __uint_as_float(rr[0]) + __uint_as_float(rr[1]); }
        qrow2 = qs;
#pragma unroll
        for (int o_ = 1; o_ < 32; o_ <<= 1) qs = fmaxf(qs, __shfl_xor(qs, o_));
        LAS float* red = (LAS float*)(lds + OFF_WS);
        __syncthreads();
        if (lane == 0) red[wid] = qs;
        __syncthreads();
        float qn2 = red[0];
#pragma unroll
        for (int w = 1; w < 8; ++w) qn2 = fmaxf(qn2, red[w]);
        const float B2 = 2.f * sqrtf(qn2 * kn2) * SCALE * 1.01f + 0.5f;
        const float thr = -18.f - B2 - Fh[P0];
        const int ndiag0 = P0 / KVBLK;
        int cntskip = 0;
        if (tid < 128) { const bool sk = (tid < ndiag0) && (-Fh[tid * KVBLK + KVBLK - 1] < thr); const unsigned long long bal = __ballot(sk); cntskip = __popcll(bal); }
        __syncthreads();
        if (tid == 0 || tid == 64) red[8 + (tid >> 6)] = (float)cntskip;
        __syncthreads();
        j_lo = (int)(red[8] + red[9]);
        __syncthreads();
    }
    float m_reg = -1e30f, l_reg = 0.f; f32x16 o[4];
#pragma unroll
    for (int d = 0; d < 4; ++d)
#pragma unroll
        for (int r = 0; r < 16; ++r) o[d][r] = 0.f;
    const int sr = tid >> 4, sc = (tid & 15) * 8, vst0 = v_st(sr, sc), vst1 = v_st(32 + sr, sc), kws = KSWZ(sr, sc * 2);
    const int vbase = (int)(uintptr_t)V_lds + v_rd_base(lane);
    bf16x8 st_k0, st_k1, st_v0, st_v1; float st_f = 0.f;
#define SLOAD(kb) do { st_k0 = *(const bf16x8*)(Zk + (size_t)((kb) + sr) * NMIX + sc); st_k1 = *(const bf16x8*)(Zk + (size_t)((kb) + 32 + sr) * NMIX + sc); \
                       st_v0 = *(const bf16x8*)(Zv + (size_t)((kb) + sr) * NMIX + sc); st_v1 = *(const bf16x8*)(Zv + (size_t)((kb) + 32 + sr) * NMIX + sc); \
                       if (tid < 64) st_f = Fh[(kb) + tid]; } while (0)
#define SWRITE(bf) do { *(LAS bf16x8*)(K_lds + (bf) * SHM_K + kws) = st_k0; *(LAS bf16x8*)(K_lds + (bf) * SHM_K + kws + 32 * 256) = st_k1; \
                        *(LAS bf16x8*)(V_lds + (bf) * SHM_V + vst0) = st_v0; *(LAS bf16x8*)(V_lds + (bf) * SHM_V + vst1) = st_v1; \
                        if (tid < 64) FK_lds[(bf) * 64 + tid] = st_f; } while (0)
    const float cbase = -(sqrtf(qrow2 * kn2) * SCALE * 1.01f + 0.25f) - Fq;
    LAS float* stopm = (LAS float*)(lds + OFF_WS + 2048);
    __syncthreads();
    int j = j_hi - 1;
    SLOAD(j * KVBLK); SWRITE(0);
    __syncthreads();
    f32x16 p0, p1; float mn, alpha; bf16x8 pa0, pa1, pa2, pa3;
    for (int t = 0;; ++t) {
        const int buf = t & 1, kb = j * KVBLK; const bool has_next = j > j_lo;
        if (has_next) SLOAD(kb - KVBLK);
        if (kb <= qlo + QBLK - 1) {
            qkt(p0, p1, K_lds + buf * SHM_K, FK_lds + buf * 64, Fq, r32, hi, qr);
            if (kb + KVBLK - 1 > qlo) mask_tile(p0, p1, qm - kb);
            partialSM(p0, p1, m_reg, mn, alpha);
            if (__any(alpha < 1.f)) { if (hi == 0) al_l[r32] = alpha; asm volatile("s_waitcnt lgkmcnt(0)" ::: "memory");
#pragma unroll
                for (int d_ = 0; d_ < 4; ++d_)
#pragma unroll
                    for (int r = 0; r < 16; ++r) o[d_][r] *= al_l[crow(r, hi)]; }
            finishSM(p0, p1, alpha, l_reg, pa0, pa1, pa2, pa3);
            pv_tile(o, vbase + buf * SHM_V, pa0, pa1, pa2, pa3);
        }
        float cm = fmaf(m_reg, SCALE, cbase);
#pragma unroll
        for (int o_ = 1; o_ < 32; o_ <<= 1) cm = fminf(cm, __shfl_xor(cm, o_));
        if (lane == 0) stopm[buf * 8 + wid] = cm;
        if (has_next) SWRITE(buf ^ 1);
        __syncthreads();
        if (!has_next) break;
        float cmin = stopm[buf * 8];
#pragma unroll
        for (int w = 1; w < 8; ++w) cmin = fminf(cmin, stopm[buf * 8 + w]);
        if (cmin >= 18.f - FK_lds[(buf ^ 1) * 64 + 63]) break;
        --j;
    }
#undef SLOAD
#undef SWRITE
    if (hi == 0) li_l[r32] = l_reg; asm volatile("s_waitcnt lgkmcnt(0)" ::: "memory");
    float rli[16];
#pragma unroll
    for (int r = 0; r < 16; ++r) rli[r] = __builtin_amdgcn_rcpf(li_l[crow(r, hi)]);
    bf16_t* Ow = br + (size_t)qlo * DM + 3 * BWID + g * 128;
#pragma unroll
    for (int r = 0; r < 16; ++r) { const int orow = crow(r, hi);
#pragma unroll
        for (int d0 = 0; d0 < 4; ++d0) { const float v = o[d0][r] * rli[r]; const float vn = __shfl_xor(v, 1);
            if ((r32 & 1) == 0) *(unsigned*)(Ow + (size_t)orow * DM + d0 * 32 + r32) = cvtpk(v, vn); } }
}
}

namespace mix {
constexpr int VR_STRIDE = 520;
constexpr int PL_STRIDE = 520;
__device__ __forceinline__ void unpk8(const u32x4 w, float (&f)[8]) { f[0] = bflo(w.x); f[1] = bfhi(w.x); f[2] = bflo(w.y); f[3] = bfhi(w.y); f[4] = bflo(w.z); f[5] = bfhi(w.z); f[6] = bflo(w.w); f[7] = bfhi(w.w); }
__device__ __forceinline__ void conv_item(const Params& p, int l, int t0) {
    const int tid = ltid(), cc = tid & 63, tg = tid >> 6, c = cc * 8, tf = t0 + tg * 16;
    const float* cw = p.conv_w + (size_t)l * 3 * BWID + c;
    float w[3][8];
#pragma unroll
    for (int j = 0; j < 3; ++j) { const f32x4 a = *(const f32x4*)(cw + j * BWID), b = *(const f32x4*)(cw + j * BWID + 4);
        w[j][0] = a[0]; w[j][1] = a[1]; w[j][2] = a[2]; w[j][3] = a[3]; w[j][4] = b[0]; w[j][5] = b[1]; w[j][6] = b[2]; w[j][7] = b[3]; }
    const bf16_t* zb = p.zmix + C_A + c; const bf16_t* zc = zb + BWID; const bf16_t* zh = zb + 2 * BWID;
    float z2[8], z1[8];
    { u32x4 c2 = {0u, 0u, 0u, 0u}, h2 = c2, c1 = c2, h1 = c2;
      if (tf >= 2) { c2 = *(const u32x4*)(zc + (size_t)(tf - 2) * NMIX); h2 = *(const u32x4*)(zh + (size_t)(tf - 2) * NMIX); }
      if (tf >= 1) { c1 = *(const u32x4*)(zc + (size_t)(tf - 1) * NMIX); h1 = *(const u32x4*)(zh + (size_t)(tf - 1) * NMIX); }
      float a[8], b[8]; unpk8(c2, a); unpk8(h2, b);
#pragma unroll
      for (int e = 0; e < 8; ++e) z2[e] = a[e] * b[e];
      unpk8(c1, a); unpk8(h1, b);
#pragma unroll
      for (int e = 0; e < 8; ++e) z1[e] = a[e] * b[e]; }
#pragma unroll 1
    for (int hb = 0; hb < 2; ++hb) {
        u32x4 cv[8], hv[8], bv[8];
#pragma unroll
        for (int i = 0; i < 8; ++i) { const size_t ro = (size_t)(tf + hb * 8 + i) * NMIX; cv[i] = *(const u32x4*)(zc + ro); hv[i] = *(const u32x4*)(zh + ro); bv[i] = *(const u32x4*)(zb + ro); }
#pragma unroll
        for (int i = 0; i < 8; ++i) { float a[8], b[8], g[8], y[8]; unpk8(cv[i], a); unpk8(hv[i], b); unpk8(bv[i], g);
#pragma unroll
            for (int e = 0; e < 8; ++e) { const float z0 = a[e] * b[e]; y[e] = g[e] * (w[0][e] * z2[e] + w[1][e] * z1[e] + w[2][e] * z0); z2[e] = z1[e]; z1[e] = z0; }
            u32x4 o; o.x = pk2(y[0], y[1]); o.y = pk2(y[2], y[3]); o.z = pk2(y[4], y[5]); o.w = pk2(y[6], y[7]);
            *(u32x4*)(p.br + (size_t)(tf + hb * 8 + i) * DM + c) = o; }
    }
}
__device__ __forceinline__ void sgu_item(const Params& p, int l, int t0, LAS unsigned char* lds) {
    const int tid = ltid(), wid = __builtin_amdgcn_readfirstlane(tid >> 6), lane = tid & 63, fr = lane & 15, fq = lane >> 4;
    LAS bf16_t* VR = (LAS bf16_t*)lds;
    __syncthreads();
    {
        const float* ngp = p.sgu_norm_g + (size_t)l * BWID + 8 * lane; const f32x4 n0 = *(const f32x4*)ngp, n1 = *(const f32x4*)(ngp + 4);
        const float ng[8] = {n0[0], n0[1], n0[2], n0[3], n1[0], n1[1], n1[2], n1[3]};
        u32x4 zr[16];
#pragma unroll
        for (int i = 0; i < 16; ++i) zr[i] = *(const u32x4*)(p.zmix + (size_t)(t0 + wid * 16 + i) * NMIX + C_B + BWID + 8 * lane);
#pragma unroll
        for (int i = 0; i < 16; ++i) { float v[8]; unpk8(zr[i], v); float ss = 0.f;
#pragma unroll
            for (int e = 0; e < 8; ++e) { v[e] = gelu_t(v[e]); ss += v[e] * v[e]; }
            const float rstd = __builtin_amdgcn_rsqf(wave_sum(ss) * (1.f / BWID) + EPS);
            u32x4 o; o.x = pk2(v[0] * rstd * ng[0], v[1] * rstd * ng[1]); o.y = pk2(v[2] * rstd * ng[2], v[3] * rstd * ng[3]);
            o.z = pk2(v[4] * rstd * ng[4], v[5] * rstd * ng[5]); o.w = pk2(v[6] * rstd * ng[6], v[7] * rstd * ng[7]);
            *(LAS u32x4*)(VR + (wid * 16 + i) * VR_STRIDE + 8 * lane) = o; }
    }
    __syncthreads();
    const int g = wid >> 1, dh = wid & 1;
    const int q4 = (lane & 15) >> 2, pl = lane & 3;
    const int vb0 = (int)(uintptr_t)VR + (fq * 8 + q4) * (VR_STRIDE * 2) + (g * 128 + dh * 64 + pl * 4) * 2, vb1 = vb0 + 64 * VR_STRIDE * 2;
    bf16x8 X[4][4];
#define TRX(dst, base, off) asm volatile("ds_read_b64_tr_b16 %0, %1 offset:%2" : "=&v"(dst) : "v"(base), "i"(off) : "memory")
#pragma unroll
    for (int xb = 0; xb < 4; ++xb)
#pragma unroll
        for (int ks = 0; ks < 4; ++ks) { s16x4 lo, hi; constexpr int RB = VR_STRIDE * 2;
            if (ks < 2) { TRX(lo, vb0, xb * 32 + (ks & 1) * 32 * RB); TRX(hi, vb0, xb * 32 + (ks & 1) * 32 * RB + 4 * RB); }
            else        { TRX(lo, vb1, xb * 32 + (ks & 1) * 32 * RB); TRX(hi, vb1, xb * 32 + (ks & 1) * 32 * RB + 4 * RB); }
            asm volatile("s_waitcnt lgkmcnt(0)" ::: "memory");
            X[xb][ks] = (bf16x8){lo[0], lo[1], lo[2], lo[3], hi[0], hi[1], hi[2], hi[3]}; }
#undef TRX
    const bf16_t* W = p.sguW + ((size_t)l * 4 + g) * 128 * 128;
    const float* bias = p.sgu_b + ((size_t)l * 4 + g) * 128;
#pragma unroll 1
    for (int tp = 0; tp < 4; ++tp) {
        bf16x8 Y[2][4]; u32x2 uw[2][4]; float bs[2];
#pragma unroll
        for (int h2 = 0; h2 < 2; ++h2) { const int t = (tp * 2 + h2) * 16 + fr; bs[h2] = bias[t];
#pragma unroll
            for (int ks = 0; ks < 4; ++ks) Y[h2][ks] = *(const bf16x8*)(W + (size_t)t * 128 + ks * 32 + fq * 8);
#pragma unroll
            for (int xb = 0; xb < 4; ++xb) uw[h2][xb] = *(const u32x2*)(p.zmix + (size_t)(t0 + t) * NMIX + C_B + g * 128 + dh * 64 + xb * 16 + 4 * fq); }
#pragma unroll
        for (int h2 = 0; h2 < 2; ++h2) { const int t = (tp * 2 + h2) * 16 + fr;
            f32x4 acc[4];
#pragma unroll
            for (int xb = 0; xb < 4; ++xb) acc[xb] = (f32x4){0.f, 0.f, 0.f, 0.f};
#pragma unroll
            for (int ks = 0; ks < 4; ++ks)
#pragma unroll
                for (int xb = 0; xb < 4; ++xb) acc[xb] = mfma16(X[xb][ks], Y[h2][ks], acc[xb]);
#pragma unroll
            for (int xb = 0; xb < 4; ++xb) { const int c = g * 128 + dh * 64 + xb * 16 + 4 * fq; const u32x2 u_ = uw[h2][xb];
                const float u0 = gelu_t(bflo(u_.x)), u1 = gelu_t(bfhi(u_.x)), u2 = gelu_t(bflo(u_.y)), u3 = gelu_t(bfhi(u_.y));
                u32x2 o; o.x = pk2(u0 * (acc[xb][0] + bs[h2]), u1 * (acc[xb][1] + bs[h2])); o.y = pk2(u2 * (acc[xb][2] + bs[h2]), u3 * (acc[xb][3] + bs[h2]));
                *(u32x2*)(p.br + (size_t)(t0 + t) * DM + BWID + c) = o; } }
    }
}
template <int W>
__device__ __forceinline__ void pool_fill(const bf16_t* zmix, LAS bf16_t* PL, int t0, int th, int lane) {
    constexpr int G = (W == 2) ? 0 : (W == 4) ? 1 : (W == 8) ? 2 : 3;
    const int ccl = lane & 15, ts = lane >> 4, c = G * 128 + ccl * 8;
#pragma unroll 1
    for (int hp = 0; hp < 2; ++hp) {
        const int tl0 = th * 64 + ts * 16 + hp * 8, ta0 = t0 + tl0;
        u32x4 R[8 + W - 1];
#pragma unroll
        for (int k = 0; k < 8 + W - 1; ++k) { const int ta = ta0 - (W - 1) + k; R[k] = (u32x4){0u, 0u, 0u, 0u}; if (ta >= 0) R[k] = *(const u32x4*)(zmix + (size_t)ta * NMIX + C_C + c); }
        float s[8];
#pragma unroll
        for (int e = 0; e < 8; ++e) s[e] = 0.f;
#pragma unroll
        for (int k = 0; k < W - 1; ++k) { float f[8]; unpk8(R[k], f);
#pragma unroll
            for (int e = 0; e < 8; ++e) s[e] += f[e]; }
#pragma unroll
        for (int i = 0; i < 8; ++i) { float f[8], d[8]; unpk8(R[W - 1 + i], f); unpk8(R[i], d);
            const int ta = ta0 + i; const float inv = 1.f / (float)((ta + 1 < W) ? ta + 1 : W);
            float o[8];
#pragma unroll
            for (int e = 0; e < 8; ++e) { s[e] += f[e]; o[e] = s[e] * inv - f[e]; s[e] -= d[e]; }
            u32x4 w; w.x = pk2(o[0], o[1]); w.y = pk2(o[2], o[3]); w.z = pk2(o[4], o[5]); w.w = pk2(o[6], o[7]);
            *(LAS u32x4*)(PL + (tl0 + i) * PL_STRIDE + c) = w; }
    }
}
__device__ __forceinline__ void pool_item(const Params& p, int l, int t0, LAS unsigned char* lds) {
    const int tid = ltid(), wid = __builtin_amdgcn_readfirstlane(tid >> 6), lane = tid & 63, fr = lane & 15, fq = lane >> 4;
    LAS bf16_t* PL = (LAS bf16_t*)lds;
    const int g = wid >> 1, oh = wid & 1;
    const bf16_t* WT = p.poolWT + ((size_t)l * 4 + g) * 128 * 128;
    __syncthreads();
    {
        const int gg = wid & 3, th = wid >> 2;
        if (gg == 0) pool_fill<2>(p.zmix, PL, t0, th, lane); else if (gg == 1) pool_fill<4>(p.zmix, PL, t0, th, lane);
        else if (gg == 2) pool_fill<8>(p.zmix, PL, t0, th, lane); else pool_fill<16>(p.zmix, PL, t0, th, lane);
    }
    bf16x8 X[4][4];
#pragma unroll
    for (int xb = 0; xb < 4; ++xb)
#pragma unroll
        for (int ks = 0; ks < 4; ++ks) X[xb][ks] = *(const bf16x8*)(WT + (size_t)(oh * 64 + xb * 16 + fr) * 128 + ks * 32 + fq * 8);
    __syncthreads();
    const float* sc = p.pool_scale + (size_t)l * BWID + g * 128;
    f32x4 sv[4];
#pragma unroll
    for (int xb = 0; xb < 4; ++xb) sv[xb] = *(const f32x4*)(sc + oh * 64 + xb * 16 + 4 * fq);
#pragma unroll 2
    for (int tb = 0; tb < 8; ++tb) {
        f32x4 acc[4];
#pragma unroll
        for (int xb = 0; xb < 4; ++xb) acc[xb] = (f32x4){0.f, 0.f, 0.f, 0.f};
#pragma unroll
        for (int ks = 0; ks < 4; ++ks) { const bf16x8 Y = *(const LAS bf16x8*)(PL + (tb * 16 + fr) * PL_STRIDE + g * 128 + ks * 32 + fq * 8);
#pragma unroll
            for (int xb = 0; xb < 4; ++xb) acc[xb] = mfma16(X[xb][ks], Y, acc[xb]); }
        const int t = tb * 16 + fr;
#pragma unroll
        for (int xb = 0; xb < 4; ++xb) { const int o0 = oh * 64 + xb * 16 + 4 * fq;
            u32x2 o; o.x = pk2(acc[xb][0] * sv[xb][0], acc[xb][1] * sv[xb][1]); o.y = pk2(acc[xb][2] * sv[xb][2], acc[xb][3] * sv[xb][3]);
            *(u32x2*)(p.br + (size_t)(t0 + t) * DM + 2 * BWID + g * 128 + o0) = o; }
    }
}
}

template <bool FORGET>
__device__ __forceinline__ void norm_phase(const Params& p, int l, const float* hsrc, const bf16_t* po, const float* gain, int gw, int ngw, int lane) {
    f32x4 gv[8], wf[4][8];
#pragma unroll
    for (int j = 0; j < 8; ++j) { gv[j] = ((const f32x4*)gain)[lane + 64 * j];
        if (FORGET) {
#pragma unroll
            for (int g = 0; g < 4; ++g) wf[g][j] = ((const f32x4*)(p.wfg + ((size_t)l * 4 + g) * DM))[lane + 64 * j]; } }
    for (int t = gw; t < SEQ; t += ngw) {
        const f32x4* hr = (const f32x4*)(hsrc + (size_t)t * DM) + lane;
        f32x4 v[8]; float ss = 0.f;
#pragma unroll
        for (int j = 0; j < 8; ++j) v[j] = hr[64 * j];
        if (po) {
#pragma unroll
            for (int j = 0; j < 8; ++j) { const u32x2 w = ((const u32x2*)(po + (size_t)t * DM))[lane + 64 * j]; v[j][0] += bflo(w.x); v[j][1] += bfhi(w.x); v[j][2] += bflo(w.y); v[j][3] += bfhi(w.y); } }
#pragma unroll
        for (int j = 0; j < 8; ++j) ss += (v[j][0] * v[j][0] + v[j][1] * v[j][1]) + (v[j][2] * v[j][2] + v[j][3] * v[j][3]);
        const float rstd = __builtin_amdgcn_rsqf(wave_sum(ss) * (1.f / DM) + EPS);
        float fd[4] = {0.f, 0.f, 0.f, 0.f};
        u32x2* o8 = (u32x2*)(p.xn + (size_t)t * DM) + lane;
#pragma unroll
        for (int j = 0; j < 8; ++j) { const f32x4 y = v[j] * rstd * gv[j];
            u32x2 w; w.x = pk2(y[0], y[1]); w.y = pk2(y[2], y[3]); o8[64 * j] = w;
            if (!FORGET) { int f8 = __builtin_amdgcn_cvt_pk_fp8_f32(clamp8(y[0]), clamp8(y[1]), 0, false); f8 = __builtin_amdgcn_cvt_pk_fp8_f32(clamp8(y[2]), clamp8(y[3]), f8, true);
                ((unsigned*)(p.hn8 + (size_t)t * DM))[lane + 64 * j] = (unsigned)f8; }
            if (FORGET) {
#pragma unroll
                for (int g = 0; g < 4; ++g) fd[g] += (y[0] * wf[g][j][0] + y[1] * wf[g][j][1]) + (y[2] * wf[g][j][2] + y[3] * wf[g][j][3]); } }
        if (FORGET) {
#pragma unroll
            for (int g = 0; g < 4; ++g) { const float z = wave_sum(fd[g]) + p.forget_b[l * 4 + g];
                const float ls = fminf(z, 0.f) - log1pf(__expf(-fabsf(z)));
                if (lane == 0) p.flog[(size_t)t * 4 + g] = ls; } }
    }
}
__device__ __forceinline__ void final_norm_phase(const Params& p, int gw, int ngw, int lane) {
    for (int t = gw; t < SEQ; t += ngw) {
        const f32x4* hr = (const f32x4*)(p.h + (size_t)t * DM) + lane;
        f32x4 v[8]; float ss = 0.f;
#pragma unroll
        for (int j = 0; j < 8; ++j) { v[j] = hr[64 * j]; const u32x2 w = ((const u32x2*)(p.po + (size_t)t * DM))[lane + 64 * j];
            v[j][0] += bflo(w.x); v[j][1] += bfhi(w.x); v[j][2] += bflo(w.y); v[j][3] += bfhi(w.y);
            ss += (v[j][0] * v[j][0] + v[j][1] * v[j][1]) + (v[j][2] * v[j][2] + v[j][3] * v[j][3]); }
        const float rstd = __builtin_amdgcn_rsqf(wave_sum(ss) * (1.f / DM) + EPS);
        f32x4* o = (f32x4*)(p.out + (size_t)t * DM) + lane;
#pragma unroll
        for (int j = 0; j < 8; ++j) o[64 * j] = v[j] * rstd * ((const f32x4*)p.final_g)[lane + 64 * j];
    }
}
__device__ __forceinline__ void cumsum_head(const Params& p, int g, LAS unsigned char* lds) {
    LAS float* part = (LAS float*)lds;
    const int tid = ltid(), lane = tid & 63, wid = tid >> 6;
    float v[16]; float s = 0.f;
#pragma unroll
    for (int j = 0; j < 16; ++j) { v[j] = p.flog[(size_t)(tid * 16 + j) * 4 + g]; s += v[j]; }
    float x = s;
#pragma unroll
    for (int o = 1; o < 64; o <<= 1) { const float y = __shfl_up(x, o); if (lane >= o) x += y; }
    __syncthreads();
    if (lane == 63) part[wid] = x;
    __syncthreads();
    float pre = x - s;
    for (int w = 0; w < wid; ++w) pre += part[w];
#pragma unroll
    for (int j = 0; j < 16; ++j) { pre += v[j]; p.F[(size_t)g * SEQ + tid * 16 + j] = pre; }
    __syncthreads();
}
__device__ __forceinline__ void knorm_phase(const Params& p, int l, int gw, int ngw, int lane) {
    float mx = 0.f;
#pragma unroll 4
    for (int t = gw; t < SEQ; t += ngw) {
        const u32x4 w = *(const u32x4*)(p.zmix + (size_t)t * NMIX + C_K + lane * 8);
        float s = bflo(w.x) * bflo(w.x) + bfhi(w.x) * bfhi(w.x) + bflo(w.y) * bflo(w.y) + bfhi(w.y) * bfhi(w.y)
                + bflo(w.z) * bflo(w.z) + bfhi(w.z) * bfhi(w.z) + bflo(w.w) * bflo(w.w) + bfhi(w.w) * bfhi(w.w);
#pragma unroll
        for (int o = 1; o < 16; o <<= 1) s += __shfl_xor(s, o);
        mx = fmaxf(mx, s);
    }
    if ((lane & 15) == 0) atomicMax(p.ctl + CW_KN + l * 4 + (lane >> 4), __float_as_uint(mx));
}

namespace pro { __device__ __forceinline__ void conv_share(const Params& p, int L, int half, LAS unsigned char* lds); }
namespace peer {
constexpr int S_STRIDE = 129, TL_STRIDE = 17;
constexpr int OFF_TL = 256 * S_STRIDE * 4;
__device__ __forceinline__ float pack_f(float v, unsigned idx, unsigned mask) { return __uint_as_float((__float_as_uint(v) & ~mask) | idx); }
#define CEX_DESC(x, y) do { const float hi_ = fmaxf((x), (y)), lo_ = fminf((x), (y)); (x) = hi_; (y) = lo_; } while (0)
__device__ __forceinline__ void sort16_desc(float (&a)[16]) {
#pragma unroll
    for (int k = 2; k <= 16; k <<= 1)
#pragma unroll
        for (int j = k >> 1; j > 0; j >>= 1)
#pragma unroll
            for (int i = 0; i < 16; ++i) { const int l = i ^ j; if (l > i) { if ((i & k) == 0 || k == 16) { if (k == 16 || (i & k) == 0) CEX_DESC(a[i], a[l]); } else CEX_DESC(a[l], a[i]); } }
}
__device__ __forceinline__ void merge16_desc(float (&r)[16], const float (&c)[16]) {
#pragma unroll
    for (int i = 0; i < 16; ++i) r[i] = fmaxf(r[i], c[15 - i]);
#pragma unroll
    for (int j = 8; j > 0; j >>= 1)
#pragma unroll
        for (int i = 0; i < 16; ++i) { const int l = i ^ j; if (l > i) CEX_DESC(r[i], r[l]); }
}
__device__ __forceinline__ void topk_item(const Params& p, int l, int t0, int hd, LAS unsigned char* lds) {
    const int tid = ltid(), wid = __builtin_amdgcn_readfirstlane(tid >> 6), lane = tid & 63, fr = lane & 15, fq = lane >> 4;
    LAS float* Sc = (LAS float*)lds; LAS float* TL = (LAS float*)(lds + OFF_TL);
    __syncthreads();
    {
        const int pp = wid >> 2, nq = wid & 3;
        const bf16_t* kb = p.keysB + (((size_t)l * 8 + hd) * 2 + pp) * 128 * 128;
        const bf16_t* qb = p.q + (size_t)t0 * DM + hd * 256 + pp * 128;
        bf16x8 X[2][4];
#pragma unroll
        for (int xb = 0; xb < 2; ++xb)
#pragma unroll
            for (int ks = 0; ks < 4; ++ks) X[xb][ks] = *(const bf16x8*)(kb + (size_t)(nq * 32 + xb * 16 + fr) * 128 + ks * 32 + fq * 8);
        bf16x8 Yq[8][4];
#pragma unroll
        for (int tb = 0; tb < 8; ++tb)
#pragma unroll
            for (int ks = 0; ks < 4; ++ks) Yq[tb][ks] = *(const bf16x8*)(qb + (size_t)(tb * 16 + fr) * DM + ks * 32 + fq * 8);
#pragma unroll
        for (int tb = 0; tb < 8; ++tb) {
            f32x4 acc[2] = {(f32x4){0.f, 0.f, 0.f, 0.f}, (f32x4){0.f, 0.f, 0.f, 0.f}};
#pragma unroll
            for (int ks = 0; ks < 4; ++ks) { const bf16x8 Y = Yq[tb][ks];
                acc[0] = mfma16(X[0][ks], Y, acc[0]); acc[1] = mfma16(X[1][ks], Y, acc[1]); }
            LAS float* row = Sc + (pp * 128 + tb * 16 + fr) * S_STRIDE + nq * 32 + 4 * fq;
#pragma unroll
            for (int xb = 0; xb < 2; ++xb)
#pragma unroll
                for (int r = 0; r < 4; ++r) row[xb * 16 + r] = acc[xb][r];
        }
    }
    __syncthreads();
    if (tid < 256) {
        const LAS float* row = Sc + tid * S_STRIDE;
        float L[16];
#pragma unroll
        for (int i = 0; i < 16; ++i) L[i] = pack_f(row[i], (unsigned)i, 127u);
        sort16_desc(L);
#pragma unroll 1
        for (int ch = 1; ch < 8; ++ch) { float C[16];
#pragma unroll
            for (int i = 0; i < 16; ++i) C[i] = pack_f(row[ch * 16 + i], (unsigned)(ch * 16 + i), 127u);
            sort16_desc(C); merge16_desc(L, C); }
#pragma unroll
        for (int i = 0; i < 16; ++i) TL[tid * TL_STRIDE + i] = L[i];
    }
    __syncthreads();
    if (tid < 128) {
        const LAS float* A = TL + tid * TL_STRIDE; const LAS float* B = TL + (128 + tid) * TL_STRIDE;
        float av[16], bv[16];
#pragma unroll
        for (int i = 0; i < 16; ++i) { av[i] = __uint_as_float(__float_as_uint(A[i]) & ~127u); bv[i] = __uint_as_float(__float_as_uint(B[i]) & ~127u); }
        float L[16];
        {   float cand[64]; int nc = 0;
#pragma unroll
            for (int a = 0; a < 16; ++a)
#pragma unroll
                for (int b = 0; b < 16; ++b) if ((a + 1) * (b + 1) <= 16) { cand[nc] = pack_f(av[a] + bv[b], (unsigned)(a * 16 + b), 255u); ++nc; }
#pragma unroll
            for (int i = 50; i < 64; ++i) cand[i] = -__builtin_inff();
#pragma unroll
            for (int i = 0; i < 16; ++i) L[i] = cand[i];
            sort16_desc(L);
#pragma unroll
            for (int ch = 1; ch < 4; ++ch) { float C[16];
#pragma unroll
                for (int i = 0; i < 16; ++i) C[i] = cand[ch * 16 + i];
                sort16_desc(C); merge16_desc(L, C); }
        }
        float val[16]; int ex[16]; float mx = -__builtin_inff();
#pragma unroll
        for (int i = 0; i < 16; ++i) { const unsigned ab = __float_as_uint(L[i]) & 255u; const unsigned ua = __float_as_uint(A[ab >> 4]), ub = __float_as_uint(B[ab & 15]);
            val[i] = __uint_as_float(ua & ~127u) + __uint_as_float(ub & ~127u); ex[i] = (int)((ua & 127u) * 128u + (ub & 127u)); mx = fmaxf(mx, val[i]); }
        float sum = 0.f;
#pragma unroll
        for (int i = 0; i < 16; ++i) { val[i] = __expf(val[i] - mx); sum += val[i]; }
        const float inv = 1.f / sum;
        int* pi = p.pidx + (size_t)(t0 + tid) * 128 + hd * 16; float* pg = p.pgate + (size_t)(t0 + tid) * 128 + hd * 16;
#pragma unroll
        for (int i = 0; i < 16; ++i) { pi[i] = ex[i]; pg[i] = val[i] * inv; }
    }
}
__device__ __forceinline__ void vm_wait_le(int n) {
    if (n >= 19) asm volatile("s_waitcnt vmcnt(19)" ::: "memory");
    else if (n >= 16) asm volatile("s_waitcnt vmcnt(16)" ::: "memory");
    else if (n >= 15) asm volatile("s_waitcnt vmcnt(15)" ::: "memory");
    else if (n >= 12) asm volatile("s_waitcnt vmcnt(12)" ::: "memory");
    else if (n >= 8) asm volatile("s_waitcnt vmcnt(8)" ::: "memory");
    else if (n >= 4) asm volatile("s_waitcnt vmcnt(4)" ::: "memory");
    else asm volatile("s_waitcnt vmcnt(0)" ::: "memory");
}
__device__ __forceinline__ bool claim_item(unsigned* cnt, unsigned nchunk, volatile LAS unsigned* misc, int tid, int& q, int& chunk) {
    __syncthreads();
    if (tid < 64) {
        const unsigned x2 = (xb_xcc_id() & 7u) * 2u; unsigned res = 0xffffffffu;
        unsigned k = misc[1];
        for (int tries = 0; tries < 32; ++tries) {
            const unsigned qx = (x2 + k) & 15u;
            unsigned c = 0u;
            if (tid == 0) c = __hip_atomic_fetch_add(cnt + 64 * qx, 1u, __ATOMIC_RELAXED, __HIP_MEMORY_SCOPE_AGENT);
            c = __builtin_amdgcn_readfirstlane(c);
            if (c < nchunk) { res = (qx << 16) | c; break; }
            unsigned hv = 0xffffffffu;
            if (tid < 16) hv = __hip_atomic_load(cnt + 64 * ((x2 + (unsigned)tid) & 15u), __ATOMIC_RELAXED, __HIP_MEMORY_SCOPE_AGENT);
            const unsigned long long open = __ballot(hv < nchunk) & 0xffffull;
            if (open == 0ull) break;
            k = (unsigned)__builtin_ctzll(open);
        }
        if (tid == 0) { misc[0] = res; misc[1] = k; }
    }
    __syncthreads();
    const unsigned r = misc[0];
    if (r == 0xffffffffu) return false;
    q = (int)(r >> 16); chunk = (int)(r & 0xffffu); return true;
}
__device__ __forceinline__ void gather1_phase(const Params& p, int l, LAS unsigned char* lds, int rep = 0) {
    const int tid = ltid(), wid = __builtin_amdgcn_readfirstlane(tid >> 6), lane = tid & 63, r = lane & 15, c = lane >> 4;
    volatile LAS unsigned* misc = (volatile LAS unsigned*)(lds + LDS_MISC);
    unsigned* cnt = p.ctl + CW_QCNT + ((l * 2 + 0) * 2 + rep) * 16 * 64;
    if (tid == 0) misc[1] = 0u;
    LAS unsigned char* buf = lds + wid * 16384;
    LAS unsigned char* sm = lds + 131072 + wid * 2304;
    const int rowi = lane >> 3, j = lane & 7, fw = rowi >> 1, frd = (r >> 1) & 7;
    const int bk0 = (int)(uintptr_t)buf + r * 128 + ((c ^ frd) * 16), bk1 = (int)(uintptr_t)buf + r * 128 + (((4 + c) ^ frd) * 16);
    float mk[8];
#pragma unroll
    for (int g = 0; g < 8; ++g) mk[g] = ((r >> 1) == g) ? 1.f : 0.f;
    const bool odd = (r & 1) != 0;
    int q, chunk;
    const int cpos = (lbid() >> 3) % 5; bool cpend = (l + 1 < DEPTH) && rep == 0;
    bool dry = false;
    for (int ndone = 0;; ++ndone) {
        if (cpend && (dry || ndone == cpos)) { pro::conv_share(p, l + 1, 0, lds); cpend = false; }
        if (dry) break;
        if (!claim_item(cnt, (unsigned)(SEQ / (8 * TPW)), misc, tid, q, chunk)) { dry = true; if (!cpend) break; continue; }

        const int tw = chunk * (8 * TPW) + wid * TPW;
        float acc[TPW][2];
#pragma unroll
        for (int i = 0; i < TPW; ++i) { acc[i][0] = 0.f; acc[i][1] = 0.f; }
#define G1_DMAQ(Q, EN) do { _Pragma("unroll") for (int nn = 0; nn < 4; ++nn) { const int n = ((Q) & 1) * 4 + nn; const int e = (EN)[(Q) * 4 + nn]; \
                        const unsigned char* src = ub + (unsigned)((unsigned)e * 128u + (unsigned)((j ^ ((n & 1) * 4 + fw)) * 16)); \
                        __builtin_amdgcn_global_load_lds((const unsigned*)src, (LAS unsigned*)(buf + ((Q) >> 1) * 8192 + n * 1024), 16, 0, 0); } } while (0)
#define G1_CQ(Q, H0, H1, I) do { const int gga = ((Q) & 1) * 2, ga = ((Q) >> 1) * 4 + gga;     \
                        const i64x2 A0a = *(const LAS i64x2*)(uintptr_t)(bk0 + ((Q) >> 1) * 8192 + gga * 2048), A1a = *(const LAS i64x2*)(uintptr_t)(bk1 + ((Q) >> 1) * 8192 + gga * 2048); \
                        const i64x2 A0b = *(const LAS i64x2*)(uintptr_t)(bk0 + ((Q) >> 1) * 8192 + gga * 2048 + 2048), A1b = *(const LAS i64x2*)(uintptr_t)(bk1 + ((Q) >> 1) * 8192 + gga * 2048 + 2048); \
                        f32x4 Ca = __builtin_amdgcn_mfma_f32_16x16x32_fp8_fp8(A0a[0], (H0)[0], (f32x4){0.f, 0.f, 0.f, 0.f}, 0, 0, 0); \
                        f32x4 Cb = __builtin_amdgcn_mfma_f32_16x16x32_fp8_fp8(A0b[0], (H0)[0], (f32x4){0.f, 0.f, 0.f, 0.f}, 0, 0, 0); \
                        Ca = __builtin_amdgcn_mfma_f32_16x16x32_fp8_fp8(A0a[1], (H0)[1], Ca, 0, 0, 0); Cb = __builtin_amdgcn_mfma_f32_16x16x32_fp8_fp8(A0b[1], (H0)[1], Cb, 0, 0, 0); \
                        Ca = __builtin_amdgcn_mfma_f32_16x16x32_fp8_fp8(A1a[0], (H1)[0], Ca, 0, 0, 0); Cb = __builtin_amdgcn_mfma_f32_16x16x32_fp8_fp8(A1b[0], (H1)[0], Cb, 0, 0, 0); \
                        Ca = __builtin_amdgcn_mfma_f32_16x16x32_fp8_fp8(A1a[1], (H1)[1], Ca, 0, 0, 0); Cb = __builtin_amdgcn_mfma_f32_16x16x32_fp8_fp8(A1b[1], (H1)[1], Cb, 0, 0, 0); \
                        acc[I][0] = fmaf(mk[ga], odd ? Ca[2] : Ca[0], acc[I][0]); acc[I][1] = fmaf(mk[ga], odd ? Ca[3] : Ca[1], acc[I][1]); \
                        acc[I][0] = fmaf(mk[ga + 1], odd ? Cb[2] : Cb[0], acc[I][0]); acc[I][1] = fmaf(mk[ga + 1], odd ? Cb[3] : Cb[1], acc[I][1]); \
                        asm volatile("s_waitcnt lgkmcnt(0)" ::: "memory"); } while (0)
#define G1_SMALLD(SLOT, TI) do { const int* ip_ = p.pidx + (size_t)(tw + (TI)) * 128 + lane; \
                        __builtin_amdgcn_global_load_lds((const unsigned*)ip_, (LAS unsigned*)(sm + (SLOT) * 768), 4, 0, 0); \
                        __builtin_amdgcn_global_load_lds((const unsigned*)(ip_ + 64), (LAS unsigned*)(sm + (SLOT) * 768 + 256), 4, 0, 0); \
                        __builtin_amdgcn_global_load_lds((const unsigned*)(hs0 + (size_t)(TI) * DM), (LAS unsigned*)(sm + (SLOT) * 768 + 512), 4, 0, 0); } while (0)
#define G1_RDIX(SLOT, EN) do { _Pragma("unroll") for (int m = 0; m < 16; ++m) (EN)[m] = *(const LAS int*)(sm + (SLOT) * 768 + (m * 8 + rowi) * 4); } while (0)
#define G1_RDHY(SLOT, H0, H1) do { H0 = *(const LAS i64x2*)(sm + (SLOT) * 768 + 512 + c * 16); H1 = *(const LAS i64x2*)(sm + (SLOT) * 768 + 512 + 64 + c * 16); } while (0)
        {
            const int s = q;
            const unsigned char* ub = p.uS8 + ((size_t)(l * 16 + s) * PEER_N) * 128;
            const unsigned char* hs0 = p.hn8 + (size_t)tw * DM + s * 128 + (lane & 31) * 4;
            int en[16]; i64x2 hyc0, hyc1;
            G1_SMALLD(0, 0); G1_SMALLD(1, 1);
            asm volatile("s_waitcnt vmcnt(0)" ::: "memory"); __builtin_amdgcn_sched_barrier(0);
            G1_RDIX(0, en);
            G1_DMAQ(0, en); G1_DMAQ(1, en); G1_DMAQ(2, en); G1_DMAQ(3, en);
            __builtin_amdgcn_sched_barrier(0);
#pragma unroll
            for (int i = 0; i < TPW; ++i) {
#pragma unroll
                for (int qq = 0; qq < 4; ++qq) {
                    const int nyoung = 4 * ((3 - qq) + ((i + 1 < TPW) ? qq : 0)) + ((qq > 0 && i + 2 < TPW) ? 3 : 0);
                    vm_wait_le(nyoung); __builtin_amdgcn_sched_barrier(0);
                    if (qq == 0) {
                        G1_RDHY(i % 3, hyc0, hyc1);
                        if (i + 1 < TPW) G1_RDIX((i + 1) % 3, en);
                        if (i + 2 < TPW) G1_SMALLD((i + 2) % 3, i + 2);
                        __builtin_amdgcn_sched_barrier(0); }
                    G1_CQ(qq, hyc0, hyc1, i);
                    if (i + 1 < TPW) G1_DMAQ(qq, en);
                    __builtin_amdgcn_sched_barrier(0);
                }
            }
        }
#undef G1_SMALLD
#undef G1_RDIX
#undef G1_RDHY
#undef G1_DMAQ
#undef G1_CQ
        const int j0 = 16 * (r >> 1) + 4 * c + 2 * (r & 1);
#pragma unroll
        for (int i = 0; i < TPW; ++i) *(unsigned*)((bf16_t*)p.pq + ((size_t)q * SEQ + tw + i) * 128 + j0) = cvtpk(acc[i][0], acc[i][1]);
    }
}
__device__ __forceinline__ void gather_reduce_phase(const Params& p, const float* rs2, size_t gtid, size_t ngt) {
    for (size_t i = gtid; i < (size_t)SEQ * 128 / 4; i += ngt) {
        f32x4 sum = (f32x4){0.f, 0.f, 0.f, 0.f};
#pragma unroll
        for (int q = 0; q < 16; ++q) { const u32x2 w = ((const u32x2*)((const bf16_t*)p.pq + (size_t)q * SEQ * 128))[i]; sum[0] += bflo(w.x); sum[1] += bfhi(w.x); sum[2] += bflo(w.y); sum[3] += bfhi(w.y); }
        sum *= (1.0f / U_SCALE) * rs2[i >> 5];
        const f32x4 g = ((const f32x4*)p.pgate)[i];
        int w = __builtin_amdgcn_cvt_pk_fp8_f32(clamp8(A_SCALE * g[0] * gelu_t(sum[0])), clamp8(A_SCALE * g[1] * gelu_t(sum[1])), 0, false);
        w = __builtin_amdgcn_cvt_pk_fp8_f32(clamp8(A_SCALE * g[2] * gelu_t(sum[2])), clamp8(A_SCALE * g[3] * gelu_t(sum[3])), w, true);
        ((unsigned*)p.aB8)[i] = (unsigned)w;
    }
}
__device__ __forceinline__ void gather2_phase(const Params& p, int l, LAS unsigned char* lds, int rep = 0) {
    bf16_t* podst = p.po + (rep ? (size_t)SEQ * DM : (size_t)0);
    const int tid = ltid(), wid = __builtin_amdgcn_readfirstlane(tid >> 6), lane = tid & 63, r = lane & 15, c = lane >> 4;
    volatile LAS unsigned* misc = (volatile LAS unsigned*)(lds + LDS_MISC);
    unsigned* cnt = p.ctl + CW_QCNT + ((l * 2 + 1) * 2 + rep) * 16 * 64;
    if (tid == 0) misc[1] = 0u;
    LAS unsigned char* buf = lds + wid * 16384;
    LAS unsigned char* sm = lds + 131072 + wid * 2304;
    const int rowi = lane >> 3, j = lane & 7;
    const int gsw_w = ((rowi >> 1) & 1);
    const int q4 = (lane & 15) >> 2, pl = lane & 3, gl = (q4 >> 1) | ((c & 1) << 1);
    int bnb[4];
#pragma unroll
    for (int nb = 0; nb < 4; ++nb) bnb[nb] = (int)(uintptr_t)buf + (c * 8 + q4) * 128 + pl * 8 + 32 * (nb ^ gl);
    int q, chunk;
    const int cpos = (lbid() >> 3) % 5; bool cpend = (l + 1 < DEPTH) && rep == 0;
    bool dry = false;
    for (int ndone = 0;; ++ndone) {
        if (cpend && (dry || ndone == cpos)) { pro::conv_share(p, l + 1, 1, lds); cpend = false; }
        if (dry) break;
        if (!claim_item(cnt, (unsigned)(SEQ / (8 * TPW)), misc, tid, q, chunk)) { dry = true; if (!cpend) break; continue; }

        const int tw = chunk * (8 * TPW) + wid * TPW;
#define TRR(dst, base, off) asm volatile("ds_read_b64_tr_b16 %0, %1 offset:%2" : "=&v"(dst) : "v"(base), "i"(off) : "memory")
#define EV4(w0, w1) __builtin_amdgcn_perm((w1), (w0), 0x06040200u)
#define OD4(w0, w1) __builtin_amdgcn_perm((w1), (w0), 0x07050301u)
#define G2_CQ(Q, AFQ) do { u32x2 lo[4], hi[4]; \
                        TRR(lo[0], bnb[0], ((Q) >> 1) * 8192 + ((Q) & 1) * 4096); TRR(hi[0], bnb[0], ((Q) >> 1) * 8192 + ((Q) & 1) * 4096 + 512); \
                        TRR(lo[1], bnb[1], ((Q) >> 1) * 8192 + ((Q) & 1) * 4096); TRR(hi[1], bnb[1], ((Q) >> 1) * 8192 + ((Q) & 1) * 4096 + 512); \
                        TRR(lo[2], bnb[2], ((Q) >> 1) * 8192 + ((Q) & 1) * 4096); TRR(hi[2], bnb[2], ((Q) >> 1) * 8192 + ((Q) & 1) * 4096 + 512); \
                        TRR(lo[3], bnb[3], ((Q) >> 1) * 8192 + ((Q) & 1) * 4096); TRR(hi[3], bnb[3], ((Q) >> 1) * 8192 + ((Q) & 1) * 4096 + 512); \
                        asm volatile("s_waitcnt lgkmcnt(0)" ::: "memory"); __builtin_amdgcn_sched_barrier(0); \
                        _Pragma("unroll") for (int nb = 0; nb < 4; ++nb) { \
                            const long E = (long)(((unsigned long long)EV4(hi[nb].x, hi[nb].y) << 32) | EV4(lo[nb].x, lo[nb].y)), O = (long)(((unsigned long long)OD4(hi[nb].x, hi[nb].y) << 32) | OD4(lo[nb].x, lo[nb].y)); \
                            De[nb] = __builtin_amdgcn_mfma_f32_16x16x32_fp8_fp8((AFQ), E, De[nb], 0, 0, 0); Do[nb] = __builtin_amdgcn_mfma_f32_16x16x32_fp8_fp8((AFQ), O, Do[nb], 0, 0, 0); } } while (0)
#define G2_DMAQ(Q, EN) do { _Pragma("unroll") for (int nn = 0; nn < 4; ++nn) { const int n = ((Q) & 1) * 4 + nn; const int e = (EN)[(Q) * 4 + nn]; const int gsw = gsw_w | ((n & 1) << 1); \
                        const unsigned char* src = vb + (unsigned)((unsigned)e * 128u + (unsigned)(((j >> 1) ^ gsw) * 32 + (j & 1) * 16)); \
                        __builtin_amdgcn_global_load_lds((const unsigned*)src, (LAS unsigned*)(buf + ((Q) >> 1) * 8192 + n * 1024), 16, 0, 0); } } while (0)
#define G2_SMALLD(SLOT, TI) do { const int* ip_ = p.pidx + (size_t)(tw + (TI)) * 128 + lane; \
                        __builtin_amdgcn_global_load_lds((const unsigned*)ip_, (LAS unsigned*)(sm + (SLOT) * 768), 4, 0, 0); \
                        __builtin_amdgcn_global_load_lds((const unsigned*)(ip_ + 64), (LAS unsigned*)(sm + (SLOT) * 768 + 256), 4, 0, 0); \
                        __builtin_amdgcn_global_load_lds((const unsigned*)(as0 + (size_t)(TI) * 128), (LAS unsigned*)(sm + (SLOT) * 768 + 512), 4, 0, 0); } while (0)
#define G2_RDIX(SLOT, EN) do { _Pragma("unroll") for (int m = 0; m < 16; ++m) (EN)[m] = *(const LAS int*)(sm + (SLOT) * 768 + (m * 8 + rowi) * 4); } while (0)
#define G2_RDAF(SLOT, AF) do { _Pragma("unroll") for (int ks = 0; ks < 4; ++ks) (AF)[ks] = *(const LAS long*)(sm + (SLOT) * 768 + 512 + ks * 32 + c * 8); } while (0)
        {
            const int s = q;
            const unsigned char* vb = p.vS8 + ((size_t)(l * 16 + s) * PEER_N) * 128;
            const unsigned char* as0 = p.aB8 + (size_t)tw * 128 + (lane & 31) * 4;
            int en[16]; long af[4]; unsigned pend[4];
#pragma unroll
            for (int k = 0; k < 4; ++k) pend[k] = 0u;
            G2_SMALLD(0, 0); G2_SMALLD(1, 1);
            asm volatile("s_waitcnt vmcnt(0)" ::: "memory"); __builtin_amdgcn_sched_barrier(0);
            G2_RDIX(0, en);
            G2_DMAQ(0, en); G2_DMAQ(1, en); G2_DMAQ(2, en); G2_DMAQ(3, en);
            __builtin_amdgcn_sched_barrier(0);
            int sc = 0, sn = 1, s2 = 2;
#pragma unroll 1
            for (int i = 0; i < TPW; ++i) {
                const int t = tw + i;
                f32x4 De[4], Do[4];
#pragma unroll
                for (int nb = 0; nb < 4; ++nb) { De[nb] = (f32x4){0.f, 0.f, 0.f, 0.f}; Do[nb] = (f32x4){0.f, 0.f, 0.f, 0.f}; }
#pragma unroll
                for (int qq = 0; qq < 4; ++qq) {
                    if (qq == 0) vm_wait_le(12);
                    else if (i == TPW - 1) vm_wait_le(4 * (3 - qq) + 4);
                    else if (i >= 1 && i <= TPW - 3) vm_wait_le(19);
                    else vm_wait_le(15);
                    __builtin_amdgcn_sched_barrier(0);
                    if (qq == 0) {
                        G2_RDAF(sc, af);
                        if (i + 1 < TPW) G2_RDIX(sn, en);
                        if (i + 2 < TPW) G2_SMALLD(s2, i + 2);
                        if (i > 0 && c == 0) {
#pragma unroll
                            for (int nb = 0; nb < 4; ++nb) *(unsigned*)(podst + (size_t)(t - 1) * DM + s * 128 + nb * 32 + 2 * r) = pend[nb]; }
                        asm volatile("" ::: "memory"); __builtin_amdgcn_sched_barrier(0); }
                    G2_CQ(qq, af[qq]);
                    if (i + 1 < TPW) G2_DMAQ(qq, en);
                    __builtin_amdgcn_sched_barrier(0);
                }
#pragma unroll
                for (int nb = 0; nb < 4; ++nb) pend[nb] = cvtpk(De[nb][0] * (1.0f / (V_SCALE * A_SCALE)), Do[nb][0] * (1.0f / (V_SCALE * A_SCALE)));
                { const int tmp = sc; sc = sn; sn = s2; s2 = tmp; }
            }
            if (c == 0) {
#pragma unroll
                for (int nb = 0; nb < 4; ++nb) *(unsigned*)(podst + (size_t)(tw + TPW - 1) * DM + s * 128 + nb * 32 + 2 * r) = pend[nb]; }
        }
#undef G2_CQ
#undef G2_DMAQ
#undef G2_SMALLD
#undef G2_RDIX
#undef G2_RDAF
#undef EV4
#undef OD4
#undef TRR
    }
}
}

namespace pro {
__device__ __forceinline__ void tr_item(const float* W, int ldw, int K, bf16_t* WT, int nblk, int item, LAS float* scr, int lane) {
    const int kb = item / nblk, nb = item % nblk, k0 = 64 * kb, n0 = 32 * nb;
    const int kr = lane >> 3, nq = (lane & 7) * 4;
    f32x4 v[8];
#pragma unroll
    for (int i = 0; i < 8; ++i) v[i] = *(const f32x4*)(W + (size_t)(k0 + 8 * i + kr) * ldw + n0 + nq);
#pragma unroll
    for (int i = 0; i < 8; ++i) { LAS float* d = scr + (8 * i + kr) * 33 + nq; d[0] = v[i][0]; d[1] = v[i][1]; d[2] = v[i][2]; d[3] = v[i][3]; }
    asm volatile("s_waitcnt lgkmcnt(0)" ::: "memory");
    const int c = lane & 7;
#pragma unroll
    for (int j = 0; j < 4; ++j) { const int n = (lane >> 3) + 8 * j; const LAS float* s = scr + (8 * c) * 33 + n;
        u32x4 o; o.x = pk2(s[0 * 33], s[1 * 33]); o.y = pk2(s[2 * 33], s[3 * 33]); o.z = pk2(s[4 * 33], s[5 * 33]); o.w = pk2(s[6 * 33], s[7 * 33]);
        *(u32x4*)(WT + (size_t)(n0 + n) * K + k0 + 8 * c) = o; }
    asm volatile("s_waitcnt lgkmcnt(0)" ::: "memory");
}
__device__ __forceinline__ void tr_item2(const float* W, int ldw, int K, bf16_t* WT, int nblk2, int item, LAS float* scr, int lane) {
    const int kb = item / nblk2, nb = item % nblk2, k0 = 64 * kb, n0 = 64 * nb;
    const int kr = lane >> 3, nq = (lane & 7) * 4, c = lane & 7;
    f32x4 v[2][8];
#pragma unroll
    for (int h = 0; h < 2; ++h)
#pragma unroll
        for (int i = 0; i < 8; ++i) v[h][i] = *(const f32x4*)(W + (size_t)(k0 + 8 * i + kr) * ldw + n0 + 32 * h + nq);
#pragma unroll
    for (int h = 0; h < 2; ++h) {
#pragma unroll
        for (int i = 0; i < 8; ++i) { LAS float* d = scr + (8 * i + kr) * 33 + nq; d[0] = v[h][i][0]; d[1] = v[h][i][1]; d[2] = v[h][i][2]; d[3] = v[h][i][3]; }
        asm volatile("s_waitcnt lgkmcnt(0)" ::: "memory");
#pragma unroll
        for (int j = 0; j < 4; ++j) { const int n = (lane >> 3) + 8 * j; const LAS float* sp = scr + (8 * c) * 33 + n;
            u32x4 o; o.x = pk2(sp[0 * 33], sp[1 * 33]); o.y = pk2(sp[2 * 33], sp[3 * 33]); o.z = pk2(sp[4 * 33], sp[5 * 33]); o.w = pk2(sp[6 * 33], sp[7 * 33]);
            *(u32x4*)(WT + (size_t)(n0 + 32 * h + n) * K + k0 + 8 * c) = o; }
        asm volatile("s_waitcnt lgkmcnt(0)" ::: "memory");
    }
}
__device__ __forceinline__ void cvt_stream(const float* src, bf16_t* dst, size_t n8, size_t gtid, size_t ngt) {
    for (size_t i = gtid; i < n8; i += ngt) { const f32x4 a = ((const f32x4*)src)[2 * i], b = ((const f32x4*)src)[2 * i + 1];
        u32x4 o; o.x = pk2(a[0], a[1]); o.y = pk2(a[2], a[3]); o.z = pk2(b[0], b[1]); o.w = pk2(b[2], b[3]); ((u32x4*)dst)[i] = o; }
}
__device__ __forceinline__ void cvt_sliced(const float* src, bf16_t* dst, size_t gtid, size_t ngt) {
    for (size_t i = gtid; i < (size_t)DEPTH * PEER_N * DM / 8; i += ngt) { const f32x4 a = ((const f32x4*)src)[2 * i], b = ((const f32x4*)src)[2 * i + 1];
        const size_t k8 = i & 255, le = i >> 8, e = le & (PEER_N - 1), l = le >> 14;
        u32x4 o; o.x = pk2(a[0], a[1]); o.y = pk2(a[2], a[3]); o.z = pk2(b[0], b[1]); o.w = pk2(b[2], b[3]);
        *(u32x4*)(dst + (((l * 32 + (k8 >> 3)) * PEER_N + e) * 64 + (k8 & 7) * 8)) = o; }
}
__device__ __forceinline__ void cvt_sliced_fp8(const float* src, unsigned char* dst, float scale, size_t gtid, size_t ngt) {
    const size_t n4 = (size_t)DEPTH * PEER_N * DM / 4;
    for (size_t i0 = gtid; i0 < n4; i0 += 4 * ngt) {
        f32x4 v[4];
#pragma unroll
        for (int u = 0; u < 4; ++u) { const size_t i = i0 + u * ngt; if (i < n4) v[u] = ((const f32x4*)src)[i]; }
#pragma unroll
        for (int u = 0; u < 4; ++u) { const size_t i = i0 + u * ngt; if (i < n4) {
            const size_t k4 = i & 511, le = i >> 9, e = le & (PEER_N - 1), l = le >> 14;
            int w = __builtin_amdgcn_cvt_pk_fp8_f32(clamp8(v[u][0] * scale), clamp8(v[u][1] * scale), 0, false); w = __builtin_amdgcn_cvt_pk_fp8_f32(clamp8(v[u][2] * scale), clamp8(v[u][3] * scale), w, true);
            *(unsigned*)(dst + (((l * 16 + (k4 >> 5)) * PEER_N + e) * 128 + (k4 & 31) * 4)) = (unsigned)w; } }
    }
}
constexpr int I_MIX = 32 * 72, I_GATE = 32 * 128, I_BR = 8 * 32, I_SQ = 32 * 32, I_PW = 2 * 2;
constexpr int I_LAYER = I_MIX + I_GATE + 4 * I_BR + 2 * I_SQ + 4 * I_PW;
constexpr int CVT_CHUNKS = 4096;
constexpr int NTW = I_LAYER + 2 * CVT_CHUNKS;
constexpr int NWG_ITEMS = (NTW + 15) / 16;
__device__ __forceinline__ void cvt_chunk_fp8(const float* src, unsigned char* dst, float scale, size_t g0, int lane) {
    f32x4 v[2][8];
#pragma unroll
    for (int u = 0; u < 8; ++u) v[0][u] = ((const f32x4*)src)[g0 + u * 64 + lane];
#pragma unroll
    for (int b = 0; b < 4; ++b) {
        if (b + 1 < 4) {
#pragma unroll
            for (int u = 0; u < 8; ++u) v[(b + 1) & 1][u] = ((const f32x4*)src)[g0 + (b + 1) * 512 + u * 64 + lane]; }
#pragma unroll
        for (int u = 0; u < 8; ++u) { const size_t i = g0 + b * 512 + u * 64 + lane; const f32x4 x = v[b & 1][u];
            const size_t k4 = i & 511, le = i >> 9, e = le & (PEER_N - 1), l = le >> 14;
            int w = __builtin_amdgcn_cvt_pk_fp8_f32(clamp8(x[0] * scale), clamp8(x[1] * scale), 0, false); w = __builtin_amdgcn_cvt_pk_fp8_f32(clamp8(x[2] * scale), clamp8(x[3] * scale), w, true);
            *(unsigned*)(dst + (((l * 16 + (k4 >> 5)) * PEER_N + e) * 128 + (k4 & 31) * 4)) = (unsigned)w; }
    }
}
__device__ __forceinline__ void conv_wave_item(const Params& p, int l, int w, LAS float* scr, int lane) {
    if (w >= NTW) return;
    if (w >= I_LAYER) { const int c = w - I_LAYER, tbl = c / CVT_CHUNKS, chunk = c % CVT_CHUNKS;
        const size_t g0 = (size_t)l * PEER_N * DM / 4 + (size_t)chunk * 2048;
        if (tbl == 0) cvt_chunk_fp8(p.peer_u, p.uS8, U_SCALE, g0, lane); else cvt_chunk_fp8(p.peer_v, p.vS8, V_SCALE, g0, lane);
        return; }
    int r = w;
    const float* win = p.w_in + (size_t)l * DM * INCOLS; bf16_t* wint = p.WinT + (size_t)l * NIN * DM;
    if (r < I_MIX) { tr_item2(win, INCOLS, DM, wint, 72, r, scr, lane); return; } r -= I_MIX;
    if (r < I_GATE) { tr_item2(win + NMIX + 4, INCOLS, DM, wint + (size_t)NMIX * DM, 128, r, scr, lane); return; } r -= I_GATE;
    if (r < 4 * I_BR) { const int n = r / I_BR; tr_item2(p.w_branch + ((size_t)l * 4 + n) * BWID * DM, DM, BWID, p.WbT + ((size_t)l * 4 + n) * DM * BWID, 32, r % I_BR, scr, lane); return; } r -= 4 * I_BR;
    if (r < I_SQ) { tr_item2(p.w_out + (size_t)l * DM * DM, DM, DM, p.WoT + (size_t)l * DM * DM, 32, r, scr, lane); return; } r -= I_SQ;
    if (r < I_SQ) { tr_item2(p.peer_wq + (size_t)l * DM * DM, DM, DM, p.WqT + (size_t)l * DM * DM, 32, r, scr, lane); return; } r -= I_SQ;
    { const int g = r / I_PW; tr_item2(p.pool_w + ((size_t)l * 4 + g) * 128 * 128, 128, 128, p.poolWT + ((size_t)l * 4 + g) * 128 * 128, 2, r % I_PW, scr, lane); }
}
__device__ __forceinline__ void cs_load(const Params& p, int L, int w0, int stp, int B, f32x4 (&v)[8], int lane) {
    const int c = w0 + (B >> 2) * stp - I_LAYER, tbl = c / CVT_CHUNKS, chunk = c % CVT_CHUNKS;
    const size_t g0 = (size_t)L * PEER_N * DM / 4 + (size_t)chunk * 2048 + (size_t)(B & 3) * 512;
    const f32x4* src = (const f32x4*)(tbl ? p.peer_v : p.peer_u);
#pragma unroll
    for (int u = 0; u < 8; ++u) v[u] = src[g0 + u * 64 + lane];
}
__device__ __forceinline__ void cs_store(const Params& p, int L, int w0, int stp, int B, const f32x4 (&v)[8], int lane) {
    const int c = w0 + (B >> 2) * stp - I_LAYER, tbl = c / CVT_CHUNKS, chunk = c % CVT_CHUNKS;
    const size_t g0 = (size_t)L * PEER_N * DM / 4 + (size_t)chunk * 2048 + (size_t)(B & 3) * 512;
    unsigned char* dst = tbl ? p.vS8 : p.uS8; const float scale = tbl ? V_SCALE : U_SCALE;
#pragma unroll
    for (int u = 0; u < 8; ++u) { const size_t i = g0 + u * 64 + lane; const f32x4 x = v[u];
        const size_t k4 = i & 511, le = i >> 9, e = le & (PEER_N - 1), l = le >> 14;
        int w = __builtin_amdgcn_cvt_pk_fp8_f32(clamp8(x[0] * scale), clamp8(x[1] * scale), 0, false); w = __builtin_amdgcn_cvt_pk_fp8_f32(clamp8(x[2] * scale), clamp8(x[3] * scale), w, true);
        *(unsigned*)(dst + (((l * 16 + (k4 >> 5)) * PEER_N + e) * 128 + (k4 & 31) * 4)) = (unsigned)w; }
}
__device__ __forceinline__ void conv_share(const Params& p, int L, int half, LAS unsigned char* lds) {
    const int tid = ltid(), wid = __builtin_amdgcn_readfirstlane(tid >> 6), lane = tid & 63;
    const int ngw = (int)gridDim.x * NWAVES, gw = lbid() * NWAVES + wid, stp = 2 * ngw;
    LAS float* scr = (LAS float*)(lds + wid * 16384);
    int w = gw + half * ngw;
#pragma unroll 1
    for (; w < I_LAYER; w += stp) conv_wave_item(p, L, w, scr, lane);
    const int nB = (w < NTW) ? 4 * ((NTW - 1 - w) / stp + 1) : 0;
    f32x4 va[8], vb[8], vc[8];
    if (nB > 0) cs_load(p, L, w, stp, 0, va, lane);
    if (nB > 1) cs_load(p, L, w, stp, 1, vb, lane);
#pragma unroll 1
    for (int B = 0; B < nB; B += 3) {
        if (B + 2 < nB) cs_load(p, L, w, stp, B + 2, vc, lane);
        cs_store(p, L, w, stp, B, va, lane);
        if (B + 1 < nB) { if (B + 3 < nB) cs_load(p, L, w, stp, B + 3, va, lane); cs_store(p, L, w, stp, B + 1, vb, lane); }
        if (B + 2 < nB) { if (B + 4 < nB) cs_load(p, L, w, stp, B + 4, vb, lane); cs_store(p, L, w, stp, B + 2, vc, lane); }
    }
}
__device__ __forceinline__ void prologue(const Params& p, int vb, int nvb, LAS unsigned char* lds) {
    const int tid = ltid(), wid = __builtin_amdgcn_readfirstlane(tid >> 6), lane = tid & 63;
    const int gw = vb * NWAVES + wid, ngw = nvb * NWAVES;
    LAS float* scr = (LAS float*)(lds + wid * 16384);
    for (int w = gw; w < NTW; w += ngw) conv_wave_item(p, 0, w, scr, lane);
    const size_t gtid = (size_t)vb * NTHREADS + tid, ngt = (size_t)nvb * NTHREADS;
    cvt_stream(p.peer_keys, p.keysB, (size_t)DEPTH * 8 * 2 * 128 * 128 / 8, gtid, ngt);
    for (size_t i = gtid; i < (size_t)DEPTH * 4 * 128 * 128; i += ngt) { const int s = (int)(i & 127), t = (int)((i >> 7) & 127); p.sguW[i] = (bf16_t)(s <= t ? f2bf(p.sgu_w[i]) : 0u); }
    for (size_t i = gtid; i < (size_t)DEPTH * 4 * DM; i += ngt) { const int k = (int)(i % DM), g = (int)((i / DM) & 3), l = (int)(i / (4 * DM)); p.wfg[i] = p.w_in[((size_t)l * DM + k) * INCOLS + NMIX + g]; }
}
}

#define XB_CW_BAR   4096
#define XB_TMO      128
#define XB_XCNT(j)  (256  + 64 * (j))
#define XB_XSUB(j)  (1280 + 64 * (j))
#define XB_XGEN(j)  (2304 + 64 * (j))
#define XB_TOP      3328
#define XB_TOPGEN   3392
#define XCD_BAR_WORDS 3456
#define XB_SPIN_CAP (1u << 18)
__device__ __forceinline__ unsigned xb_ld(unsigned* p)              { return __hip_atomic_load(p, __ATOMIC_RELAXED, __HIP_MEMORY_SCOPE_AGENT); }
__device__ __forceinline__ unsigned xb_add(unsigned* p, unsigned v) { return __hip_atomic_fetch_add(p, v, __ATOMIC_RELAXED, __HIP_MEMORY_SCOPE_AGENT); }
#define XB_SPIN(cond, bar) do { unsigned _sp = 0; while (cond) { __builtin_amdgcn_s_sleep(1); \
    if ((++_sp & 255u) == 0u) { if (xb_ld(&(bar)[XB_TMO])) break; if (_sp > XB_SPIN_CAP) { atomicAdd(&(bar)[XB_TMO], 1u); break; } } } } while (0)
struct XcdBarrier { unsigned* bar; unsigned x; volatile LAS unsigned* st; };
__device__ __forceinline__ XcdBarrier xcd_barrier_post(unsigned* bar, volatile LAS unsigned* st) {
    XcdBarrier b; b.bar = bar; b.x = xb_xcc_id(); b.st = st;
    if (threadIdx.x == 0) (void)xb_add(&bar[XB_XCNT(b.x)], 1u);
    return b;
}
__device__ __forceinline__ void xcd_barrier_complete(unsigned* bar, unsigned x, unsigned& nloc, unsigned& nx) {
    const unsigned G = gridDim.x * gridDim.y * gridDim.z;
    unsigned sum, cnt, mine, sp = 0u;
    for (;;) {
        sum = 0u; cnt = 0u; mine = 0u;
#pragma unroll
        for (unsigned j = 0; j < 16; ++j) { const unsigned c = xb_ld(&bar[XB_XCNT(j)]); sum += c; cnt += (c > 0u) ? 1u : 0u; mine = (j == x) ? c : mine; }
        if (sum == G) break;
        __builtin_amdgcn_s_sleep(1);
        if ((++sp & 255u) == 0u) { if (xb_ld(&bar[XB_TMO])) break; if (sp > XB_SPIN_CAP) { atomicAdd(&bar[XB_TMO], 1u); break; } }
    }
    nloc = mine > 0u ? mine : 1u; nx = cnt > 0u ? cnt : 1u;
}
__device__ __forceinline__ void xcd_barrier(const XcdBarrier& b) {
    asm volatile("s_waitcnt vmcnt(0)" ::: "memory");
    __syncthreads();
    if (threadIdx.x == 0) {
        const unsigned long long wsv = ((const LAS unsigned long long*)((LAS unsigned char*)b.st - LDS_BARW + LDS_PTAB))[19];
        const unsigned wlo = __builtin_amdgcn_readfirstlane((unsigned)wsv), whi = __builtin_amdgcn_readfirstlane((unsigned)(wsv >> 32));
        unsigned* bar = (unsigned*)(GAS unsigned*)((((unsigned long long)whi << 32) | wlo) + WS_CTL + (size_t)XB_CW_BAR * 4);
        __builtin_amdgcn_s_waitcnt(0);
        unsigned nloc = b.st[0], nx = b.st[1];
        if (nloc == 0u) { xcd_barrier_complete(bar, b.x, nloc, nx); b.st[0] = nloc; b.st[1] = nx; }
        const unsigned old = xb_add(&bar[XB_XSUB(b.x)], 1u);
        const unsigned gen = old / nloc;
        if (old + 1u == (gen + 1u) * nloc) {
            __builtin_amdgcn_fence(__ATOMIC_RELEASE, "agent");
            asm volatile("s_waitcnt vmcnt(0)" ::: "memory");
            const unsigned og = xb_add(&bar[XB_TOP], 1u);
            const unsigned tg = og / nx;
            if (og + 1u == (tg + 1u) * nx) xb_add(&bar[XB_TOPGEN], 1u);
            else XB_SPIN(xb_ld(&bar[XB_TOPGEN]) == tg, bar);
            __builtin_amdgcn_fence(__ATOMIC_ACQUIRE, "agent");
            xb_add(&bar[XB_XGEN(b.x)], 1u);
            asm volatile("s_waitcnt vmcnt(0)" ::: "memory");
        } else {
            XB_SPIN(xb_ld(&bar[XB_XGEN(b.x)]) == gen, bar);
            __builtin_amdgcn_fence(__ATOMIC_ACQUIRE, "agent");
            asm volatile("s_waitcnt vmcnt(0)" ::: "memory");
        }
    }
    __syncthreads();
}

constexpr int NPH_LAYER = 9, NPHASES = 2 + DEPTH * NPH_LAYER;
constexpr int CW_BAR = XB_CW_BAR;


template <class T> __device__ __forceinline__ T* ldptr(const LAS unsigned long long* ptab, int i) {
    const unsigned long long v = ptab[i];
    const unsigned lo = __builtin_amdgcn_readfirstlane((unsigned)v), hi = __builtin_amdgcn_readfirstlane((unsigned)(v >> 32));
    return (T*)(GAS T*)(((unsigned long long)hi << 32) | lo);
}
__device__ __forceinline__ Params mkparams(const LAS unsigned long long* ptab) {
    Params p;
    p.x = ldptr<const float>(ptab, 0); p.norm1_g = ldptr<const float>(ptab, 1); p.w_in = ldptr<const float>(ptab, 2); p.conv_w = ldptr<const float>(ptab, 3);
    p.sgu_norm_g = ldptr<const float>(ptab, 4); p.sgu_w = ldptr<const float>(ptab, 5); p.sgu_b = ldptr<const float>(ptab, 6); p.pool_w = ldptr<const float>(ptab, 7);
    p.pool_scale = ldptr<const float>(ptab, 8); p.forget_b = ldptr<const float>(ptab, 9); p.w_branch = ldptr<const float>(ptab, 10); p.w_out = ldptr<const float>(ptab, 11);
    p.norm2_g = ldptr<const float>(ptab, 12); p.peer_wq = ldptr<const float>(ptab, 13); p.peer_keys = ldptr<const float>(ptab, 14); p.peer_u = ldptr<const float>(ptab, 15);
    p.peer_v = ldptr<const float>(ptab, 16); p.final_g = ldptr<const float>(ptab, 17); p.out = ldptr<float>(ptab, 18);
    unsigned char* ws = ldptr<unsigned char>(ptab, 19);
    p.WinT = (bf16_t*)(ws + WS_WIN); p.WbT = (bf16_t*)(ws + WS_WB); p.WoT = (bf16_t*)(ws + WS_WO); p.WqT = (bf16_t*)(ws + WS_WQ); p.keysB = (bf16_t*)(ws + WS_KEYS);
    p.uS = (bf16_t*)(ws + WS_U); p.vS = (bf16_t*)(ws + WS_V); p.sguW = (bf16_t*)(ws + WS_SGUW); p.poolWT = (bf16_t*)(ws + WS_POOLW);
    p.wfg = (float*)(ws + WS_WFG); p.h = (float*)(ws + WS_H); p.macc = (float*)(ws + WS_MACC); p.flog = (float*)(ws + WS_FLOG); p.F = (float*)(ws + WS_F); p.pgate = (float*)(ws + WS_PGATE);
    p.xn = (bf16_t*)(ws + WS_XN); p.zmix = (bf16_t*)(ws + WS_ZMIX); p.zgate = (unsigned char*)(ws + WS_ZGATE); p.po = (bf16_t*)(ws + WS_MACC); p.br = (bf16_t*)(ws + WS_BR); p.merged = (bf16_t*)(ws + WS_MERGED); p.q = (bf16_t*)(ws + WS_Q);
    p.pidx = (int*)(ws + WS_PIDX); p.ctl = (unsigned*)(ws + WS_CTL); p.pq = (float*)(ws + WS_PQ); p.aB = (bf16_t*)(ws + WS_AB); p.uS8 = (unsigned char*)(ws + WS_U); p.vS8 = (unsigned char*)(ws + WS_V); p.hn8 = (unsigned char*)(ws + WS_HN8); p.aB8 = (unsigned char*)(ws + WS_AB); p.ssqp = (float*)(ws + WS_SSQP); p.rs2 = (float*)(ws + WS_RS2);
    return p;
}

__global__ void __launch_bounds__(NTHREADS, 2) mega(Args a) {
    extern __shared__ __attribute__((aligned(16))) unsigned char lds_raw[];
    LAS unsigned char* lds = (LAS unsigned char*)lds_raw;
    const int tid = threadIdx.x;
    LAS unsigned long long* ptab = (LAS unsigned long long*)(lds + LDS_PTAB);
    if (tid == 0) {
#pragma unroll
        for (int i = 0; i < 18; ++i) ptab[i] = (unsigned long long)a.in[i];
        ptab[18] = (unsigned long long)a.out; ptab[19] = (unsigned long long)a.ws;
    }
    const int G = gridDim.x;
    const int lo = a.ph_lo, hi = a.ph_hi;
    volatile LAS unsigned* barw = (volatile LAS unsigned*)(lds + LDS_BARW);
    if (tid == 0) { barw[0] = 0u; barw[1] = 0u; barw[2] = 0u; barw[3] = 0u; }
    __syncthreads();
    XcdBarrier bar; bar.bar = (unsigned*)(a.ws + WS_CTL) + CW_BAR; bar.x = 0; bar.st = barw;
    if (hi - lo > 1) bar = xcd_barrier_post((unsigned*)(a.ws + WS_CTL) + CW_BAR, barw);
#define PP const Params p = mkparams(ptab); const int tid_ = ltid(), vb = lbid(), wid = __builtin_amdgcn_readfirstlane(tid_ >> 6), lane = tid_ & 63, gw = vb * NWAVES + wid, ngw = G * NWAVES; (void)lane; (void)gw; (void)ngw
#ifndef KMASK
#define KMASK 0xFFFF
#endif
#define KON(b) (((KMASK) >> (b)) & 1)
#ifndef REPEAT_KIND
#define REPEAT_KIND -1
#endif
#define REPS(k) (((REPEAT_KIND) == (k) || ((k) == 3 && ((REPEAT_KIND) >= 13 && (REPEAT_KIND) <= 17))) ? 2 : 1)
#define REPLOOP(k) for (int rep = 0; rep < REPS(k); ++rep, (rep < REPS(k) ? xcd_barrier(bar) : (void)0))
#define IN(k) (lo <= (k) && (k) < hi)
#define SEAM(k) do { if (IN(k) && IN((k) + 1)) xcd_barrier(bar); } while (0)

    if (KON(0) && IN(0)) REPLOOP(0) { PP; pro::prologue(p, vb, G, lds); }
    SEAM(0);
#pragma unroll 1
    for (int l = 0; l < DEPTH; ++l) {
        const int base = 1 + NPH_LAYER * l;
        if (KON(1) && IN(base + 0)) REPLOOP(1) { PP; norm_phase<true>(p, l, l == 0 ? p.x : p.h, l == 0 ? (const bf16_t*)nullptr : p.po, p.norm1_g + (size_t)l * DM, gw, ngw, lane); }
        SEAM(base + 0);
        if (KON(2) && IN(base + 1)) REPLOOP(2) { PP;
            if (vb >= G - 4) cumsum_head(p, vb - (G - 4), lds);
            pg8::Gemm g{p.xn, p.WinT + (size_t)l * NIN * DM, SEQ, NIN, DM, DM, DM}; pg8::StaticOrder S; S.init(SEQ, NIN, G, vb);
            if (G == 256) S.imax = 6;
            pg8::EpiInproj E{p.zmix, p.zgate, p.ctl + CW_KN + l * 16};
            pg8::gemm_phase<pg8::EpiInproj, pg8::StaticOrder>(lds, g, S, E);
        }
        SEAM(base + 1);
        if (IN(base + 2)) REPLOOP(3) { PP;
            volatile LAS unsigned* misc = (volatile LAS unsigned*)(lds + LDS_MISC);
            unsigned* head = p.ctl + CW_MIXQ + (l * 2 + rep) * 64;
            for (;;) {
                __syncthreads();
                if (tid_ == 0) misc[0] = __hip_atomic_fetch_add(head, 1u, __ATOMIC_RELAXED, __HIP_MEMORY_SCOPE_AGENT);
                __syncthreads();
                int it = (int)misc[0];
                const int nleft = (G == 256) ? 64 : 0;
                if (it >= nleft + 128 + 192) break;
                if (it < nleft) { if (KON(2) && rep == 0) {
                    pg8::Gemm g{p.xn, p.WinT + (size_t)l * NIN * DM, SEQ, NIN, DM, DM, DM}; pg8::StaticOrder S; S.init(SEQ, NIN, G, it); S.i0 = 6; S.imax = 7;
                    pg8::EpiInproj E{p.zmix, p.zgate, p.ctl + CW_KN + l * 16};
                    pg8::gemm_phase<pg8::EpiInproj, pg8::StaticOrder>(lds, g, S, E); }
                    continue; }
                it -= nleft;
                if (it < 128) { if (KON(3) && (rep == 0 || (REPEAT_KIND) != 14)) { const int qb = 31 - (it >> 2), g = it & 3;
                    fa::attn_unit(p.zmix, p.F + (size_t)g * SEQ, p.br, g, qb, (__uint_as_float(__hip_atomic_load(p.ctl + CW_KN + l * 16 + g * 4 + 0, __ATOMIC_RELAXED, __HIP_MEMORY_SCOPE_AGENT)) + __uint_as_float(__hip_atomic_load(p.ctl + CW_KN + l * 16 + g * 4 + 1, __ATOMIC_RELAXED, __HIP_MEMORY_SCOPE_AGENT)) + __uint_as_float(__hip_atomic_load(p.ctl + CW_KN + l * 16 + g * 4 + 2, __ATOMIC_RELAXED, __HIP_MEMORY_SCOPE_AGENT)) + __uint_as_float(__hip_atomic_load(p.ctl + CW_KN + l * 16 + g * 4 + 3, __ATOMIC_RELAXED, __HIP_MEMORY_SCOPE_AGENT))), (LAS char*)lds); } }
                else if (KON(4) && (rep == 0 || (REPEAT_KIND) != 13)) { const int k = it - 128, t0 = (k & 63) * 128;
                    if (k < 64) { if (rep == 0 || (REPEAT_KIND) == 14 || (REPEAT_KIND) == 15) mix::sgu_item(p, l, t0, lds); }
                    else if (k < 128) { if (rep == 0 || (REPEAT_KIND) == 14 || (REPEAT_KIND) == 16) mix::pool_item(p, l, t0, lds); }
                    else { if (rep == 0 || (REPEAT_KIND) == 14 || (REPEAT_KIND) == 17) mix::conv_item(p, l, t0); } }
            }
            __syncthreads();
        }
        SEAM(base + 2);
        if (KON(5) && IN(base + 3)) REPLOOP(5) { PP;
            pg8::Gemm g{p.br, p.WbT + (size_t)l * 4 * DM * BWID, SEQ, DM, BWID, DM, BWID}; pg8::MergeOrder S; S.so.init(SEQ, DM, G, vb);
            pg8::EpiMerge E{p.zgate, p.merged};
            pg8::gemm_phase<pg8::EpiMerge, pg8::MergeOrder>(lds, g, S, E);
        }
        SEAM(base + 3);
        if (KON(6) && IN(base + 4)) { PP;
            pg8::Gemm g{p.merged, p.WoT + (size_t)l * DM * DM, SEQ, DM, DM, DM, DM}; pg8::StaticOrder S; S.init(SEQ, DM, G, vb);
            pg8::EpiResNorm E{l == 0 ? p.x : p.h, l == 0 ? (const bf16_t*)nullptr : p.po, p.h, p.norm2_g + (size_t)l * DM, p.xn, p.hn8, p.ssqp};
            pg8::gemm_phase<pg8::EpiResNorm, pg8::StaticOrder>(lds, g, S, E);
        }
        SEAM(base + 4);
        if (KON(8) && IN(base + 5)) REPLOOP(8) { PP;
            pg8::Gemm g{p.xn, p.WqT + (size_t)l * DM * DM, SEQ, DM, DM, DM, DM}; pg8::StaticOrder S; S.init(SEQ, DM, G, vb);
            pg8::Unit u0; int tab_pm = -1;
            LAS float* rstab = (LAS float*)(lds + LDS_RSTAB);
            if (S.next(0, u0)) { tab_pm = u0.pm; const int rr = tid_ >> 1, hf = tid_ & 1, r = u0.pm * 256 + rr;
                const f32x4* pp = (const f32x4*)(p.ssqp + (size_t)r * 32 + hf * 16); float sm = 0.f;
#pragma unroll
                for (int k = 0; k < 4; ++k) { const f32x4 v = pp[k]; sm += v[0]; sm += v[1]; sm += v[2]; sm += v[3]; }
                const float so = __shfl_xor(sm, 1); const float tot = hf ? (so + sm) : (sm + so);
                const float rs = __builtin_amdgcn_rsqf(tot * (1.f / DM) + EPS);
                if (hf == 0) { rstab[rr] = rs; if (u0.pn == 0) p.rs2[r] = rs; } }
            __syncthreads();
            pg8::EpiScaleBf16 E{p.q, DM, p.ssqp, rstab, tab_pm};
            pg8::gemm_phase<pg8::EpiScaleBf16, pg8::StaticOrder>(lds, g, S, E);
            pg8::Unit u;
            for (int ui = 0; S.next(ui, u); ++ui) { __syncthreads(); peer::topk_item(p, l, u.pm * 256, u.pn, lds); peer::topk_item(p, l, u.pm * 256 + 128, u.pn, lds); }
            __syncthreads();
        }
        SEAM(base + 5);
        if (KON(10) && IN(base + 6)) REPLOOP(10) { PP; peer::gather1_phase(p, l, lds, rep); }
        SEAM(base + 6);
        if (KON(10) && IN(base + 7)) REPLOOP(12) { PP; peer::gather_reduce_phase(p, p.rs2, (size_t)vb * NTHREADS + tid_, (size_t)G * NTHREADS); }
        SEAM(base + 7);
        if (KON(10) && IN(base + 8)) REPLOOP(11) { PP; peer::gather2_phase(p, l, lds, rep); }
        SEAM(base + 8);
    }
    if (KON(11) && IN(NPHASES - 1)) { PP; final_norm_phase(p, gw, ngw, lane); }
#undef IN
#undef SEAM
}

extern "C" void kernel_launch(void* const* d_in, const int* in_sizes, int n_in, void* d_out, int out_size, void* d_ws, size_t ws_size, hipStream_t stream) {
    static int grid = 0;
    if (grid == 0) {
        if (n_in != 18 || out_size != SEQ * DM || ws_size < WS_END) { fprintf(stderr, "kernel_launch: unexpected shapes (n_in %d, out %d, ws %zu < %zu)\n", n_in, out_size, ws_size, (size_t)WS_END); grid = -1; return; }
        int dev = 0, cus = 0;
        if (hipGetDevice(&dev) != hipSuccess || hipDeviceGetAttribute(&cus, hipDeviceAttributeMultiprocessorCount, dev) != hipSuccess) { grid = -1; return; }
        if (hipFuncSetAttribute((const void*)mega, hipFuncAttributeMaxDynamicSharedMemorySize, LDS_BYTES) != hipSuccess) { fprintf(stderr, "kernel_launch: hipFuncSetAttribute failed\n"); grid = -1; return; }
        int per_cu = 0;
        if (hipOccupancyMaxActiveBlocksPerMultiprocessor(&per_cu, (const void*)mega, NTHREADS, LDS_BYTES) != hipSuccess || per_cu < 1) fprintf(stderr, "kernel_launch: occupancy query reports %d\n", per_cu);
        (void)hipGetLastError();
        grid = cus;
    }
    if (grid < 0) return;
    unsigned char* ws = (unsigned char*)d_ws;
    (void)hipMemsetAsync(ws + WS_CTL, 0, CTL_BYTES, stream);
    Args a{};
    for (int i = 0; i < 18; ++i) a.in[i] = (const float*)d_in[i];
    a.out = (float*)d_out; a.ws = ws;
#if N_LAUNCH_MODE == 1
    a.ph_lo = 0; a.ph_hi = NPHASES;
    hipLaunchKernelGGL(mega, dim3(grid), dim3(NTHREADS), LDS_BYTES, stream, a);
#else
    for (int ph = 0; ph < NPHASES; ++ph) { a.ph_lo = ph; a.ph_hi = ph + 1; hipLaunchKernelGGL(mega, dim3(grid), dim3(NTHREADS), LDS_BYTES, stream, a); }
#endif
}
```

```cpp
#include <hip/hip_runtime.h>
#include <cstdio>
#include <cstdint>

#define LAS __attribute__((address_space(3)))
#define GAS __attribute__((address_space(1)))
typedef unsigned short bf16_t;
typedef short bf16x8 __attribute__((ext_vector_type(8)));
typedef short s16x4 __attribute__((ext_vector_type(4)));
typedef float f32x2 __attribute__((ext_vector_type(2)));
typedef float f32x4 __attribute__((ext_vector_type(4)));
typedef float f32x16 __attribute__((ext_vector_type(16)));
typedef unsigned u32x2 __attribute__((ext_vector_type(2)));
typedef unsigned u32x4 __attribute__((ext_vector_type(4)));
typedef long i64x2 __attribute__((ext_vector_type(2)));

#ifndef N_LAUNCH_MODE
#define N_LAUNCH_MODE 1
#endif

constexpr int SEQ = 8192, DM = 2048, DEPTH = 4, BWID = 512;
constexpr int NMIX = 4608, NGATE = 8192, NIN = 12800, INCOLS = 12804;
constexpr int PEER_N = 16384;
constexpr float A_SCALE = 64.f;
constexpr float V_SCALE = 16.f;
constexpr float U_SCALE = 64.f;
constexpr int C_A = 0, C_B = 1536, C_C = 2560, C_Q = 3072, C_K = 3584, C_V = 4096;
constexpr float EPS = 1e-6f;
constexpr int NTHREADS = 512, NWAVES = 8;

constexpr size_t al256(size_t x) { return (x + 255) & ~(size_t)255; }
constexpr size_t WS_CTL = 0, CTL_BYTES = 1u << 20;
constexpr size_t WS_WIN = WS_CTL + CTL_BYTES;
constexpr size_t WS_WB = WS_WIN + (size_t)DEPTH * NIN * DM * 2;
constexpr size_t WS_WO = WS_WB + (size_t)DEPTH * 4 * DM * BWID * 2;
constexpr size_t WS_WQ = WS_WO + (size_t)DEPTH * DM * DM * 2;
constexpr size_t WS_KEYS = WS_WQ + (size_t)DEPTH * DM * DM * 2;
constexpr size_t WS_U = WS_KEYS + (size_t)DEPTH * 8 * 2 * 128 * 128 * 2;
constexpr size_t WS_V = WS_U + (size_t)DEPTH * PEER_N * DM * 2;
constexpr size_t WS_SGUW = WS_V + (size_t)DEPTH * PEER_N * DM * 2;
constexpr size_t WS_POOLW = WS_SGUW + (size_t)DEPTH * 4 * 128 * 128 * 2;
constexpr size_t WS_WFG = WS_POOLW + (size_t)DEPTH * 4 * 128 * 128 * 2;
constexpr size_t WS_H = WS_WFG + (size_t)DEPTH * 4 * DM * 4;
constexpr size_t WS_MACC = WS_H + (size_t)SEQ * DM * 4;
constexpr size_t WS_XN = WS_MACC + (size_t)SEQ * DM * 4;
constexpr size_t WS_ZMIX = WS_XN + (size_t)SEQ * DM * 2;
constexpr size_t WS_ZGATE = WS_ZMIX + (size_t)SEQ * NMIX * 2;
constexpr size_t WS_BR = WS_ZGATE + (size_t)SEQ * NGATE * 2;
constexpr size_t WS_MERGED = WS_BR + (size_t)SEQ * DM * 2;
constexpr size_t WS_Q = WS_MERGED + (size_t)SEQ * DM * 2;
constexpr size_t WS_FLOG = WS_Q + (size_t)SEQ * DM * 2;
constexpr size_t WS_F = WS_FLOG + (size_t)SEQ * 4 * 4;
constexpr size_t WS_PIDX = WS_F + (size_t)SEQ * 4 * 4;
constexpr size_t WS_PGATE = WS_PIDX + (size_t)SEQ * 128 * 4;
constexpr size_t WS_PQ = WS_PGATE + (size_t)SEQ * 128 * 4;
constexpr size_t WS_AB = WS_PQ + (size_t)8 * SEQ * 128 * 4;
constexpr size_t WS_HN8 = WS_AB + (size_t)SEQ * 128 * 2;
constexpr size_t WS_SSQP = WS_HN8 + (size_t)SEQ * DM;
constexpr size_t WS_RS2 = WS_SSQP + (size_t)SEQ * 32 * 4;
constexpr size_t WS_END = WS_RS2 + (size_t)SEQ * 4;
static_assert(WS_WB % 256 == 0 && WS_U % 256 == 0 && WS_H % 256 == 0 && WS_ZMIX % 256 == 0 && WS_F % 256 == 0, "ws alignment");

constexpr int LDS_BYTES = 155648;
constexpr int LDS_BARW = LDS_BYTES - 64;

struct Params {
    const float *x, *norm1_g, *w_in, *conv_w, *sgu_norm_g, *sgu_w, *sgu_b, *pool_w, *pool_scale, *forget_b, *w_branch, *w_out, *norm2_g, *peer_wq, *peer_keys, *peer_u, *peer_v, *final_g;
    float* out;
    bf16_t *WinT, *WbT, *WoT, *WqT, *keysB, *uS, *vS, *sguW, *poolWT;
    float *wfg, *h, *macc, *flog, *F, *pgate, *pq;
    bf16_t* aB;
    unsigned char *uS8, *vS8, *hn8, *aB8;
    float *ssqp, *rs2;
    bf16_t *xn, *zmix, *br, *merged, *q;
    bf16_t* po;
    unsigned char* zgate;
    int* pidx;
    unsigned* ctl;
};
struct Args { const float* in[18]; float* out; unsigned char* ws; int ph_lo, ph_hi; };
constexpr int TPW = 16;
constexpr int LDS_PTAB = LDS_BYTES - 256;
constexpr int LDS_RSTAB = 135168;
constexpr int LDS_MISC = LDS_BYTES - 512;
constexpr int CW_MIXQ = 8192;
constexpr int CW_KN = 12288;
constexpr int CW_QCNT = 16384;

__device__ __forceinline__ unsigned f2bf(float f) { unsigned u = __float_as_uint(f); return (u + 0x7fffu + ((u >> 16) & 1u)) >> 16; }
__device__ __forceinline__ unsigned pk2(float lo, float hi) { return f2bf(lo) | (f2bf(hi) << 16); }
__device__ __forceinline__ float bflo(unsigned w) { return __uint_as_float(w << 16); }
__device__ __forceinline__ float bfhi(unsigned w) { return __uint_as_float(w & 0xffff0000u); }
__device__ __forceinline__ float bf1(bf16_t v) { return __uint_as_float((unsigned)v << 16); }
__device__ __forceinline__ unsigned cvtpk(float lo, float hi) { unsigned r; asm volatile("v_cvt_pk_bf16_f32 %0, %1, %2" : "=v"(r) : "v"(lo), "v"(hi)); return r; }
__device__ __forceinline__ float clamp8(float x) { return fminf(fmaxf(x, -448.f), 448.f); }
__device__ __forceinline__ float gelu_t(float x) {
    const float u = x + 0.044715f * x * x * x;
    const float e = __builtin_amdgcn_exp2f(-2.3022081985f * u);
    return x * __builtin_amdgcn_rcpf(1.0f + e);
}
__device__ __forceinline__ float sigmoid_f(float x) { return __builtin_amdgcn_rcpf(1.0f + __builtin_amdgcn_exp2f(-1.4426950409f * x)); }
__device__ __forceinline__ float wave_sum(float v) {
#pragma unroll
    for (int o = 1; o < 64; o <<= 1) v += __shfl_xor(v, o);
    return v;
}
__device__ __forceinline__ unsigned xb_xcc_id() { return (unsigned)__builtin_amdgcn_s_getreg((3 << 11) | 20) & 0xFu; }
__device__ __forceinline__ int ltid() { int t = threadIdx.x; asm volatile("" : "+v"(t)); return t; }
__device__ __forceinline__ int lbid() { int b = blockIdx.x; asm volatile("" : "+s"(b)); return b; }
__device__ __forceinline__ f32x4 mfma16(bf16x8 x, bf16x8 y, f32x4 c) { return __builtin_amdgcn_mfma_f32_16x16x32_bf16(x, y, c, 0, 0, 0); }

namespace pg8 {
constexpr int BM = 256, BK = 64, HALF = 128, HTB = HALF * BK * 2, STAGE_BYTES = 8 * HTB, NXCD = 8, WGM = 8;
__host__ __device__ __forceinline__ int lds_byte(int r, int c) { const int st = (r >> 4) * 2 + (c >> 5), rr = r & 15, cc = c & 31, ob = rr * 64 + cc * 2; return st * 1024 + (ob ^ (((ob >> 9) & 1) << 5)); }
__host__ __device__ __forceinline__ void stage_rc(int b, int& R, int& C) { const int st = b / 1024, sb = b % 1024, swz = sb ^ (((sb >> 9) & 1) << 5); R = (st >> 1) * 16 + swz / 64; C = (st & 1) * 32 + (swz % 64) / 2; }
__host__ __device__ __forceinline__ int perm32(int rho) { const int n = rho >> 4, i = rho & 15; return 8 * (i >> 2) + 4 * n + (i & 3); }

struct Unit { int pm, pn, aco, bro; };
struct Gemm { const bf16_t* A; const bf16_t* Bt; int M, N, K, lda, ldb; };

struct StaticOrder {
    int nM, nN, nwg, G, c, i0, imax;
    __host__ __device__ __forceinline__ void init(int M, int N, int G_, int c_) { nM = M / BM; nN = N / BM; nwg = nM * nN; G = G_; c = c_; i0 = 0; imax = 1 << 30; }
    __host__ __device__ __forceinline__ bool next(int i_, Unit& u) const {
        const int i = i_ + i0; if (i >= imax) return false;
        const long L = (long)i * G + c; if (L >= nwg) return false;
        int wgid = (int)L; { const int q = nwg / NXCD, r = nwg % NXCD, xcd = wgid % NXCD, off = wgid / NXCD; wgid = (xcd < r ? xcd * (q + 1) : r * (q + 1) + (xcd - r) * q) + off; }
        const int nig = WGM * nN, gid = wgid / nig, fm = gid * WGM, gsz = (nM - fm) < WGM ? (nM - fm) : WGM;
        u.pm = fm + ((wgid % nig) % gsz); u.pn = (wgid % nig) / gsz; u.aco = 0; u.bro = 0; return true;
    }
};
struct MergeOrder {
    StaticOrder so;
    __host__ __device__ __forceinline__ bool next(int i, Unit& u) const { if (!so.next(i >> 2, u)) return false; const int n = i & 3; u.aco = n * BWID; u.bro = n * DM; return true; }
};

template <class Epi, class Sched>
__device__ __forceinline__ void gemm_phase(LAS unsigned char* lds, const Gemm g, const Sched& S, const Epi& E) {
    const int tid = ltid(), wid = __builtin_amdgcn_readfirstlane(tid >> 6), lane = tid & 63, wr = wid >> 2, wc = wid & 3, fr = lane & 15, fq = lane >> 4;
    const int K = g.K, nt = K / BK;
    unsigned voffA[2], voffB[2];
#pragma unroll
    for (int i = 0; i < 2; ++i) { int R, C; stage_rc(tid * 16 + i * 8192, R, C); const int Rb = Epi::PERM ? ((R & ~31) + perm32(R & 31)) : R;
        voffA[i] = (unsigned)(R * g.lda + C) * 2u; voffB[i] = (unsigned)(Rb * g.ldb + C) * 2u; }
    const size_t kstep = (size_t)(BK * 2);
    const size_t hstepA = (size_t)HALF * g.lda * 2, hstepB = (size_t)HALF * g.ldb * 2;
    const unsigned ldsw = (unsigned)wid * 1024u;
    const int aoff = lds_byte(wr * 64 + fr, fq * 8), boff = lds_byte(wc * 32 + fr, fq * 8);
#define PG8_UA(u) ((const char*)g.A + ((size_t)(u).pm * BM * g.lda + (size_t)(u).aco) * 2)
#define PG8_UB(u) ((const char*)g.Bt + ((size_t)((u).pn * BM + (u).bro) * g.ldb) * 2)
#define PG8_SA(b, h) (((b) * 2 + (h)) * HTB)
#define PG8_SB(b, h) ((4 + (b) * 2 + (h)) * HTB)
#define PG8_STAGE(bufoff, gbase, voff) do { _Pragma("unroll") for (int _i = 0; _i < 2; ++_i) \
        __builtin_amdgcn_global_load_lds((const unsigned*)((const char*)(gbase) + (voff)[_i]), (LAS unsigned*)(lds + (bufoff) + ldsw + _i * 8192), 16, 0, 0); } while (0)
#define PG8_LDA(dst, b, h) do { _Pragma("unroll") for (int m = 0; m < 4; ++m) _Pragma("unroll") for (int k = 0; k < 2; ++k) dst[m][k] = *(const LAS bf16x8*)(lds + PG8_SA(b, h) + aoff + m * 2048 + k * 1024); } while (0)
#define PG8_LDB(dst, b, h) do { _Pragma("unroll") for (int n = 0; n < 2; ++n) _Pragma("unroll") for (int k = 0; k < 2; ++k) dst[n][k] = *(const LAS bf16x8*)(lds + PG8_SB(b, h) + boff + n * 2048 + k * 1024); } while (0)
#define PG8_MMA(ai, bj, At, Bt) do { __builtin_amdgcn_s_setprio(1); _Pragma("unroll") for (int m = 0; m < 4; ++m) _Pragma("unroll") for (int n = 0; n < 2; ++n) _Pragma("unroll") for (int k = 0; k < 2; ++k) \
        acc[ai][bj][m][n] = __builtin_amdgcn_mfma_f32_16x16x32_bf16(Bt[n][k], At[m][k], acc[ai][bj][m][n], 0, 0, 0); __builtin_amdgcn_s_setprio(0); } while (0)
#define PG8_WAIT_V(n) asm volatile("s_waitcnt vmcnt(" #n ")" ::: "memory")
#define PG8_WAIT_L(n) asm volatile("s_waitcnt lgkmcnt(" #n ")" ::: "memory")
#define PG8_BAR __builtin_amdgcn_s_barrier()
#define PG8_SCHED __builtin_amdgcn_sched_barrier(0)
    Unit cur, nxt; int ui = 0;
    if (!S.next(0, cur)) return;
    f32x4 acc[2][2][4][2];
#pragma unroll
    for (int a = 0; a < 2; ++a)
#pragma unroll
        for (int b = 0; b < 2; ++b)
#pragma unroll
            for (int m = 0; m < 4; ++m)
#pragma unroll
                for (int n = 0; n < 2; ++n) acc[a][b][m][n] = (f32x4){0.f, 0.f, 0.f, 0.f};
    bf16x8 At[4][2], B0[2][2], B1[2][2];
    const char* cA = PG8_UA(cur); const char* cB = PG8_UB(cur);
    PG8_STAGE(PG8_SB(0, 0), cB, voffB); PG8_STAGE(PG8_SB(0, 1), cB + hstepB, voffB); PG8_STAGE(PG8_SA(0, 0), cA, voffA); PG8_STAGE(PG8_SA(0, 1), cA + hstepA, voffA);
    if (wr == 1) PG8_BAR;
    PG8_WAIT_V(2); PG8_BAR;
    PG8_STAGE(PG8_SB(1, 0), cB + kstep, voffB); PG8_STAGE(PG8_SA(1, 0), cA + kstep, voffA); PG8_STAGE(PG8_SB(1, 1), cB + hstepB + kstep, voffB);
    PG8_WAIT_V(6); PG8_BAR;
    for (;;) {
        const bool has_next = S.next(ui + 1, nxt);
        const char* nA = has_next ? PG8_UA(nxt) : cA; const char* nB = has_next ? PG8_UB(nxt) : cB;
        for (int t = 0; t < nt; t += 2) {
            const bool last = (t == nt - 2);
            const char* a1 = cA + (size_t)(t + 1) * kstep;
            const char* a2 = last ? nA : cA + (size_t)(t + 2) * kstep; const char* b2 = last ? nB : cB + (size_t)(t + 2) * kstep;
            const char* a3 = a2 + kstep; const char* b3 = b2 + kstep;
            PG8_LDB(B0, 0, 0); PG8_LDB(B1, 0, 1); PG8_SCHED; PG8_LDA(At, 0, 0); PG8_STAGE(PG8_SA(1, 1), a1 + hstepA, voffA);
            PG8_WAIT_V(8); PG8_WAIT_L(0); PG8_BAR; PG8_MMA(0, 0, At, B0); PG8_MMA(0, 1, At, B1); PG8_BAR; PG8_SCHED;
            PG8_LDA(At, 0, 1); PG8_STAGE(PG8_SB(0, 0), b2, voffB); PG8_STAGE(PG8_SB(0, 1), b2 + hstepB, voffB); PG8_STAGE(PG8_SA(0, 0), a2, voffA);
            PG8_WAIT_V(8); PG8_WAIT_L(0); PG8_BAR; PG8_MMA(1, 0, At, B0); PG8_MMA(1, 1, At, B1); PG8_BAR; PG8_SCHED;
            PG8_LDB(B0, 1, 0); PG8_LDB(B1, 1, 1); PG8_SCHED; PG8_LDA(At, 1, 0); PG8_STAGE(PG8_SA(0, 1), a2 + hstepA, voffA);
            PG8_WAIT_V(8); PG8_WAIT_L(0); PG8_BAR; PG8_MMA(0, 0, At, B0); PG8_MMA(0, 1, At, B1); PG8_BAR; PG8_SCHED;
            PG8_LDA(At, 1, 1); PG8_STAGE(PG8_SB(1, 0), b3, voffB); PG8_STAGE(PG8_SB(1, 1), b3 + hstepB, voffB); PG8_STAGE(PG8_SA(1, 0), a3, voffA);
            PG8_WAIT_V(8); PG8_WAIT_L(0); PG8_BAR; PG8_MMA(1, 0, At, B0); PG8_MMA(1, 1, At, B1); PG8_BAR; PG8_SCHED;
        }
        if (wr == 0) PG8_BAR;
        bool keep = false;
        if constexpr (Epi::HORNER) keep = E.scale(acc, cur, wr, wc, fr, fq); else E(acc, cur, wr, wc, fr, fq);
        if (!has_next) break;
        if (!keep) {
#pragma unroll
        for (int a = 0; a < 2; ++a)
#pragma unroll
            for (int b = 0; b < 2; ++b)
#pragma unroll
                for (int m = 0; m < 4; ++m)
#pragma unroll
                    for (int n = 0; n < 2; ++n) acc[a][b][m][n] = (f32x4){0.f, 0.f, 0.f, 0.f};
        }
        cur = nxt; cA = nA; cB = nB; ++ui;
        if (wr == 1) PG8_BAR;
    }
    PG8_WAIT_V(0);
    PG8_BAR;
#undef PG8_UA
#undef PG8_UB
#undef PG8_SA
#undef PG8_SB
#undef PG8_STAGE
#undef PG8_LDA
#undef PG8_LDB
#undef PG8_MMA
#undef PG8_WAIT_V
#undef PG8_WAIT_L
#undef PG8_BAR
#undef PG8_SCHED
}

__device__ __forceinline__ size_t gate_off(int row, int gcol) { return ((size_t)(row >> 4) * (NGATE / 32) + (size_t)(gcol >> 5)) * 512 + (size_t)((row & 15) * 32 + (gcol & 31)); }
struct EpiInproj {
    static constexpr bool PERM = true; static constexpr bool HORNER = false;
    bf16_t* zmix; unsigned char* zgate; unsigned* kn;
    __device__ __forceinline__ void operator()(const f32x4 (&acc)[2][2][4][2], const Unit& u, int wr, int wc, int fr, int fq) const {
        if (u.pn == C_K / BM || u.pn == C_K / BM + 1) {
#pragma unroll
            for (int bj = 0; bj < 2; ++bj) { float mx = 0.f;
#pragma unroll
                for (int ai = 0; ai < 2; ++ai)
#pragma unroll
                    for (int m = 0; m < 4; ++m) { const f32x4 a = acc[ai][bj][m][0], b = acc[ai][bj][m][1];
                        float q2 = (a[0] * a[0] + a[1] * a[1]) + (a[2] * a[2] + a[3] * a[3]) + (b[0] * b[0] + b[1] * b[1]) + (b[2] * b[2] + b[3] * b[3]);
                        q2 += __shfl_xor(q2, 16); q2 += __shfl_xor(q2, 32); mx = fmaxf(mx, q2); }
#pragma unroll
                for (int o = 1; o < 16; o <<= 1) mx = fmaxf(mx, __shfl_xor(mx, o));
                if ((threadIdx.x & 63) == 0) atomicMax(kn + ((u.pn - C_K / BM) * 2 + bj) * 4 + wc, __float_as_uint(mx)); }
        }
        const int row0 = u.pm * BM + wr * 64 + fr; int colt = u.pn * BM; const bool gate = colt >= NMIX;
        if (gate) {
            const int col0 = colt - NMIX + wc * 32 + 8 * fq;
#pragma unroll
            for (int ai = 0; ai < 2; ++ai)
#pragma unroll
                for (int m = 0; m < 4; ++m) { const int grow = row0 + ai * HALF + m * 16;
#pragma unroll
                    for (int bj = 0; bj < 2; ++bj) { const f32x4 v0 = acc[ai][bj][m][0], v1 = acc[ai][bj][m][1]; unsigned w0 = 0u, w1 = 0u;
#pragma unroll
                        for (int e = 0; e < 4; ++e) { w0 = __builtin_amdgcn_cvt_pk_u8_f32(__builtin_truncf(sigmoid_f(v0[e]) * 255.f + 0.5f), e, w0);
                                                      w1 = __builtin_amdgcn_cvt_pk_u8_f32(__builtin_truncf(sigmoid_f(v1[e]) * 255.f + 0.5f), e, w1); }
                        *(u32x2*)(zgate + gate_off(grow, col0 + bj * HALF)) = (u32x2){w0, w1}; } }
            return;
        }
        bf16_t* base = zmix; const int ldc = NMIX;
        const int col0 = colt + wc * 32 + 8 * fq;
#pragma unroll
        for (int ai = 0; ai < 2; ++ai)
#pragma unroll
            for (int m = 0; m < 4; ++m) { bf16_t* rowp = base + (size_t)(row0 + ai * HALF + m * 16) * ldc + col0;
#pragma unroll
                for (int bj = 0; bj < 2; ++bj) { const f32x4 v0 = acc[ai][bj][m][0], v1 = acc[ai][bj][m][1];
                    u32x4 w; w.x = cvtpk(v0[0], v0[1]); w.y = cvtpk(v0[2], v0[3]); w.z = cvtpk(v1[0], v1[1]); w.w = cvtpk(v1[2], v1[3]);
                    *(u32x4*)(rowp + bj * HALF) = w; } }
    }
};
struct EpiBf16 {
    static constexpr bool PERM = true; static constexpr bool HORNER = false;
    bf16_t* O; int ldc;
    __device__ __forceinline__ void operator()(const f32x4 (&acc)[2][2][4][2], const Unit& u, int wr, int wc, int fr, int fq) const {
        const int row0 = u.pm * BM + wr * 64 + fr; const int col0 = u.pn * BM + wc * 32 + 8 * fq;
#pragma unroll
        for (int ai = 0; ai < 2; ++ai)
#pragma unroll
            for (int m = 0; m < 4; ++m) { bf16_t* rowp = O + (size_t)(row0 + ai * HALF + m * 16) * ldc + col0;
#pragma unroll
                for (int bj = 0; bj < 2; ++bj) { const f32x4 v0 = acc[ai][bj][m][0], v1 = acc[ai][bj][m][1];
                    u32x4 w; w.x = cvtpk(v0[0], v0[1]); w.y = cvtpk(v0[2], v0[3]); w.z = cvtpk(v1[0], v1[1]); w.w = cvtpk(v1[2], v1[3]);
                    *(u32x4*)(rowp + bj * HALF) = w; } }
    }
};
struct EpiMerge {
    static constexpr bool PERM = true; static constexpr bool HORNER = true;
    const unsigned char* G; bf16_t* merged;
    __device__ __forceinline__ bool scale(f32x4 (&acc)[2][2][4][2], const Unit& u, int wr, int wc, int fr, int fq) const {
        const int n = u.aco >> 9; const int col0 = u.pn * BM + wc * 32 + 8 * fq; const bool last = (n == 3);
#pragma unroll
        for (int ai = 0; ai < 2; ++ai) {
            u32x2 gw[4][2], gx[4][2];
#pragma unroll
            for (int m = 0; m < 4; ++m) { const int r = u.pm * BM + ai * HALF + wr * 64 + m * 16 + fr;
#pragma unroll
                for (int bj = 0; bj < 2; ++bj) { const int c = col0 + bj * HALF;
                    gw[m][bj] = *(const u32x2*)(G + gate_off(r, n * DM + c));
                    gx[m][bj] = last ? gw[m][bj] : *(const u32x2*)(G + gate_off(r, (n + 1) * DM + c)); } }
#pragma unroll
            for (int m = 0; m < 4; ++m) { const int r = u.pm * BM + ai * HALF + wr * 64 + m * 16 + fr;
#pragma unroll
                for (int bj = 0; bj < 2; ++bj) { const int c = col0 + bj * HALF; const u32x2 g = gw[m][bj], x = gx[m][bj];
                    f32x4 v0 = acc[ai][bj][m][0], v1 = acc[ai][bj][m][1];
#pragma unroll
                    for (int e = 0; e < 4; ++e) {
                        const float k0 = fmaxf((float)((g.x >> (8 * e)) & 0xffu), 1.f), k1 = fmaxf((float)((g.y >> (8 * e)) & 0xffu), 1.f);
                        const float d0 = last ? (1.f / 255.f) : __builtin_amdgcn_rcpf(fmaxf((float)((x.x >> (8 * e)) & 0xffu), 1.f));
                        const float d1 = last ? (1.f / 255.f) : __builtin_amdgcn_rcpf(fmaxf((float)((x.y >> (8 * e)) & 0xffu), 1.f));
                        v0[e] *= k0 * d0; v1[e] *= k1 * d1; }
                    if (last) { u32x4 w; w.x = cvtpk(v0[0], v0[1]); w.y = cvtpk(v0[2], v0[3]); w.z = cvtpk(v1[0], v1[1]); w.w = cvtpk(v1[2], v1[3]);
                        *(u32x4*)(merged + (size_t)r * DM + c) = w; }
                    else { acc[ai][bj][m][0] = v0; acc[ai][bj][m][1] = v1; } } }
        }
        return !last;
    }
};
struct EpiResNorm {
    static constexpr bool PERM = true; static constexpr bool HORNER = false;
    const float* base; const bf16_t* po; float* h; const float* gain; bf16_t* xn; unsigned char* hn8; float* part;
    __device__ __forceinline__ void operator()(const f32x4 (&acc)[2][2][4][2], const Unit& u, int wr, int wc, int fr, int fq) const {
        const int col0 = u.pn * BM + wc * 32 + 8 * fq;
        f32x4 gv[2][2];
#pragma unroll
        for (int bj = 0; bj < 2; ++bj) { gv[bj][0] = *(const f32x4*)(gain + col0 + bj * HALF); gv[bj][1] = *(const f32x4*)(gain + col0 + bj * HALF + 4); }
#pragma unroll
        for (int ai = 0; ai < 2; ++ai)
#pragma unroll
            for (int mp2 = 0; mp2 < 2; ++mp2) {
                f32x4 bv[2][2][2]; u32x4 pv[2][2];
#pragma unroll
                for (int mm = 0; mm < 2; ++mm) { const int r = u.pm * BM + ai * HALF + wr * 64 + (mp2 * 2 + mm) * 16 + fr;
#pragma unroll
                    for (int bj = 0; bj < 2; ++bj) { const f32x4* bp = (const f32x4*)(base + (size_t)r * DM + col0 + bj * HALF); bv[mm][bj][0] = bp[0]; bv[mm][bj][1] = bp[1];
                        pv[mm][bj] = (u32x4){0u, 0u, 0u, 0u}; if (po) pv[mm][bj] = *(const u32x4*)(po + (size_t)r * DM + col0 + bj * HALF); } }
#pragma unroll
                for (int mm = 0; mm < 2; ++mm) { const int m = mp2 * 2 + mm; const int r = u.pm * BM + ai * HALF + wr * 64 + m * 16 + fr; float q2 = 0.f;
#pragma unroll
                    for (int bj = 0; bj < 2; ++bj) { const size_t off = (size_t)r * DM + col0 + bj * HALF; const u32x4 pw_ = pv[mm][bj];
                        const f32x4 v0 = bv[mm][bj][0] + acc[ai][bj][m][0] + (f32x4){bflo(pw_.x), bfhi(pw_.x), bflo(pw_.y), bfhi(pw_.y)}, v1 = bv[mm][bj][1] + acc[ai][bj][m][1] + (f32x4){bflo(pw_.z), bfhi(pw_.z), bflo(pw_.w), bfhi(pw_.w)};
                        f32x4* hp = (f32x4*)(h + off); hp[0] = v0; hp[1] = v1;
                        q2 += (v0[0] * v0[0] + v0[1] * v0[1]) + (v0[2] * v0[2] + v0[3] * v0[3]) + (v1[0] * v1[0] + v1[1] * v1[1]) + (v1[2] * v1[2] + v1[3] * v1[3]);
                        const f32x4 y0 = v0 * gv[bj][0], y1 = v1 * gv[bj][1];
                        u32x4 w; w.x = cvtpk(y0[0], y0[1]); w.y = cvtpk(y0[2], y0[3]); w.z = cvtpk(y1[0], y1[1]); w.w = cvtpk(y1[2], y1[3]);
                        *(u32x4*)(xn + off) = w;
                        int f0 = __builtin_amdgcn_cvt_pk_fp8_f32(clamp8(y0[0]), clamp8(y0[1]), 0, false); f0 = __builtin_amdgcn_cvt_pk_fp8_f32(clamp8(y0[2]), clamp8(y0[3]), f0, true);
                        int f1 = __builtin_amdgcn_cvt_pk_fp8_f32(clamp8(y1[0]), clamp8(y1[1]), 0, false); f1 = __builtin_amdgcn_cvt_pk_fp8_f32(clamp8(y1[2]), clamp8(y1[3]), f1, true);
                        *(u32x2*)(hn8 + off) = (u32x2){(unsigned)f0, (unsigned)f1}; }
                    q2 += __shfl_xor(q2, 16); q2 += __shfl_xor(q2, 32);
                    if (fq == 0) part[(size_t)r * 32 + u.pn * 4 + wc] = q2; }
            }
    }
};
__device__ __forceinline__ float row_rs(const float* part, int r) {
    const f32x4* pp = (const f32x4*)(part + (size_t)r * 32); float s = 0.f;
#pragma unroll
    for (int k = 0; k < 8; ++k) { const f32x4 v = pp[k]; s += v[0]; s += v[1]; s += v[2]; s += v[3]; }
    return __builtin_amdgcn_rsqf(s * (1.f / DM) + EPS);
}
struct EpiScaleBf16 {
    static constexpr bool PERM = true; static constexpr bool HORNER = false;
    bf16_t* O; int ldc; const float* part; const LAS float* rstab; int tab_pm;
    __device__ __forceinline__ void operator()(const f32x4 (&acc)[2][2][4][2], const Unit& u, int wr, int wc, int fr, int fq) const {
        const int row0 = u.pm * BM + wr * 64 + fr; const int col0 = u.pn * BM + wc * 32 + 8 * fq;
#pragma unroll
        for (int ai = 0; ai < 2; ++ai)
#pragma unroll
            for (int m = 0; m < 4; ++m) { const int r = row0 + ai * HALF + m * 16; bf16_t* rowp = O + (size_t)r * ldc + col0;
                const float rs = (u.pm == tab_pm) ? rstab[r - u.pm * BM] : row_rs(part, r);
#pragma unroll
                for (int bj = 0; bj < 2; ++bj) { const f32x4 v0 = acc[ai][bj][m][0] * rs, v1 = acc[ai][bj][m][1] * rs;
                    u32x4 w; w.x = cvtpk(v0[0], v0[1]); w.y = cvtpk(v0[2], v0[3]); w.z = cvtpk(v1[0], v1[1]); w.w = cvtpk(v1[2], v1[3]);
                    *(u32x4*)(rowp + bj * HALF) = w; } }
    }
};
}

namespace fa {
constexpr float SCALE = 0.08838834764831845f, INV_SCALE = 11.313708498984761f, THR = 8.f;
constexpr int QBLK = 32, KVBLK = 64, QB = 256;
constexpr int SHM_V = KVBLK * 128 * 2, SHM_K = KVBLK * 128 * 2;
constexpr int OFF_V = 0, OFF_K = 2 * SHM_V, OFF_FK = OFF_K + 2 * SHM_K, OFF_WS = OFF_FK + 2 * 64 * 4;
#define KSWZ(row, colB) ((row) * 256 + ((colB) ^ (((row) & 7) << 4)))
#define SBAR() __builtin_amdgcn_sched_barrier(0)
__device__ __forceinline__ int v_st(int k, int c) { const int kk = (k & ~0xC) | ((k & 4) << 1) | ((k & 8) >> 1); return ((kk >> 3) * 4 + (c >> 5)) * 512 + ((kk & 7) * 32 + (c & 31)) * 2; }
__device__ __forceinline__ int v_rd_base(int lane) { return ((lane & 3) << 3) | (((lane >> 2) & 3) << 6) | (((lane >> 4) & 1) << 5) | (((lane >> 5) & 1) << 8); }
constexpr int v_rd_off(int d0, int ks, int half) { return d0 * 512 + ks * 4096 + half * 2048; }
__device__ __forceinline__ int crow(int r, int hi) { return (r & 3) + 8 * (r >> 2) + 4 * hi; }
__device__ __forceinline__ void mask_tile(f32x16& p0, f32x16& p1, int dq) {
    const float NEG = -__builtin_inff();
#pragma unroll
    for (int r = 0; r < 16; ++r) {
        const int c = (r & 3) + 8 * (r >> 2);
        if (dq - c < 0) p0[r] = NEG;
        if (dq - c - 32 < 0) p1[r] = NEG;
    }
}
__device__ __forceinline__ void partialSM(f32x16& p0, f32x16& p1, float& m_reg, float& mn, float& alpha) {
    float pmax = p0[0];
#pragma unroll
    for (int r = 1; r < 16; ++r) pmax = fmaxf(pmax, p0[r]);
#pragma unroll
    for (int r = 0; r < 16; ++r) pmax = fmaxf(pmax, p1[r]);
    { auto rr = __builtin_amdgcn_permlane32_swap(__float_as_uint(pmax), __float_as_uint(pmax), false, false);
      pmax = fmaxf(__uint_as_float(rr[0]), __uint_as_float(rr[1])); }
    constexpr float C2 = 1.4426950408889634f * SCALE;
    if (__builtin_expect(__all((pmax - m_reg) * SCALE <= THR), 1)) { mn = m_reg; alpha = 1.f; }
    else { mn = fmaxf(m_reg, pmax); alpha = __builtin_amdgcn_exp2f((m_reg - mn) * C2); m_reg = mn; }
    const float mnL = -mn * C2;
#pragma unroll
    for (int r = 0; r < 16; ++r) p0[r] = fmaf(p0[r], C2, mnL);
#pragma unroll
    for (int r = 0; r < 16; ++r) p1[r] = fmaf(p1[r], C2, mnL);
#pragma unroll
    for (int r = 0; r < 16; ++r) p0[r] = __builtin_amdgcn_exp2f(p0[r]);
}
__device__ __forceinline__ void finishSM(f32x16& p0, f32x16& p1, float alpha, float& l_reg, bf16x8& pa0, bf16x8& pa1, bf16x8& pa2, bf16x8& pa3) {
#pragma unroll
    for (int r = 0; r < 16; ++r) p1[r] = __builtin_amdgcn_exp2f(p1[r]);
    float ps = 0;
#pragma unroll
    for (int r = 0; r < 16; ++r) ps += p0[r];
#pragma unroll
    for (int r = 0; r < 16; ++r) ps += p1[r];
    { auto rr = __builtin_amdgcn_permlane32_swap(__float_as_uint(ps), __float_as_uint(ps), false, false);
      ps = __uint_as_float(rr[0]) + __uint_as_float(rr[1]); }
    l_reg = l_reg * alpha + ps;
#define PK4(P, B_, OUT) do { unsigned a0 = cvtpk(P[B_+0], P[B_+1]), a1 = cvtpk(P[B_+2], P[B_+3]);                          \
        unsigned b0 = cvtpk(P[B_+4], P[B_+5]), b1 = cvtpk(P[B_+6], P[B_+7]);                                             \
        auto r0 = __builtin_amdgcn_permlane32_swap(a0, b0, false, false); auto r1 = __builtin_amdgcn_permlane32_swap(a1, b1, false, false); \
        u32x4 w = {r0[0], r1[0], r0[1], r1[1]}; OUT = *reinterpret_cast<bf16x8*>(&w); } while (0)
    PK4(p0, 0, pa0); PK4(p0, 8, pa1); PK4(p1, 0, pa2); PK4(p1, 8, pa3);
#undef PK4
}
__device__ __forceinline__ void qkt(f32x16& p0, f32x16& p1, const LAS char* kbuf, const LAS float* fk, float Fq, int r32, int hi, const bf16x8* qr) {
#pragma unroll
    for (int a = 0; a < 4; ++a) { const f32x4 f0 = *(const LAS f32x4*)(fk + 8 * a + 4 * hi), f1 = *(const LAS f32x4*)(fk + 32 + 8 * a + 4 * hi);
#pragma unroll
        for (int b = 0; b < 4; ++b) { p0[4 * a + b] = (Fq - f0[b]) * INV_SCALE; p1[4 * a + b] = (Fq - f1[b]) * INV_SCALE; } }
    const LAS char* kb[4];
#pragma unroll
    for (int dd = 0; dd < 4; ++dd) kb[dd] = kbuf + KSWZ(r32, (dd * 16 + hi * 8) * 2);
#pragma unroll
    for (int d0 = 0; d0 < 8; ++d0) { const LAS char* a = kb[d0 & 3] + (d0 >> 2) * 128;
        bf16x8 b0 = *reinterpret_cast<const LAS bf16x8*>(a);
        bf16x8 b1 = *reinterpret_cast<const LAS bf16x8*>(a + 32 * 256);
        p0 = __builtin_amdgcn_mfma_f32_32x32x16_bf16(b0, qr[d0], p0, 0, 0, 0);
        p1 = __builtin_amdgcn_mfma_f32_32x32x16_bf16(b1, qr[d0], p1, 0, 0, 0); }
}
__device__ __forceinline__ void pv_tile(f32x16* o, int vb0, bf16x8 pa0, bf16x8 pa1, bf16x8 pa2, bf16x8 pa3) {
#define TRRD(dst, off) asm volatile("ds_read_b64_tr_b16 %0, %1 offset:%2" : "=&v"(dst) : "v"(vb0), "i"(off) : "memory")
#define PV_D0(d0) do { s16x4 l0, l1, l2, l3, h0, h1, h2, h3; constexpr int b_ = v_rd_off(d0, 0, 0); \
        TRRD(l0, b_); TRRD(h0, b_ + 2048); TRRD(l1, b_ + 4096); TRRD(h1, b_ + 6144); TRRD(l2, b_ + 8192); TRRD(h2, b_ + 10240); TRRD(l3, b_ + 12288); TRRD(h3, b_ + 14336); \
        asm volatile("s_waitcnt lgkmcnt(0)" ::: "memory"); SBAR();   \
        o[d0] = __builtin_amdgcn_mfma_f32_32x32x16_bf16(pa0, (bf16x8){l0[0], l0[1], l0[2], l0[3], h0[0], h0[1], h0[2], h0[3]}, o[d0], 0, 0, 0);   \
        o[d0] = __builtin_amdgcn_mfma_f32_32x32x16_bf16(pa1, (bf16x8){l1[0], l1[1], l1[2], l1[3], h1[0], h1[1], h1[2], h1[3]}, o[d0], 0, 0, 0);   \
        o[d0] = __builtin_amdgcn_mfma_f32_32x32x16_bf16(pa2, (bf16x8){l2[0], l2[1], l2[2], l2[3], h2[0], h2[1], h2[2], h2[3]}, o[d0], 0, 0, 0);   \
        o[d0] = __builtin_amdgcn_mfma_f32_32x32x16_bf16(pa3, (bf16x8){l3[0], l3[1], l3[2], l3[3], h3[0], h3[1], h3[2], h3[3]}, o[d0], 0, 0, 0); } while (0)
    PV_D0(0); PV_D0(1); PV_D0(2); PV_D0(3);
#undef PV_D0
#undef TRRD
}
__device__ __forceinline__ void attn_unit(const bf16_t* __restrict__ zmix, const float* __restrict__ Fh, bf16_t* __restrict__ br, int g, int qb, float kn2, LAS char* lds) {
    const int tid = ltid(), wid = __builtin_amdgcn_readfirstlane(tid >> 6), lane = tid & 63, r32 = lane & 31, hi = lane >> 5;
    const bf16_t* Zq = zmix + C_Q + g * 128; const bf16_t* Zk = zmix + C_K + g * 128; const bf16_t* Zv = zmix + C_V + g * 128;
    const int P0 = qb * QB, j_hi = (P0 + QB) / KVBLK;
    const int qlo = P0 + wid * QBLK, qm = qlo + r32 - 4 * hi;
    LAS char* V_lds = lds + OFF_V; LAS char* K_lds = lds + OFF_K; LAS float* FK_lds = (LAS float*)(lds + OFF_FK);
    LAS float* wsf = (LAS float*)(lds + OFF_WS) + wid * 64; LAS float* li_l = wsf; LAS float* al_l = wsf + 32;
    bf16x8 qr[8];
#pragma unroll
    for (int d0 = 0; d0 < 8; ++d0) qr[d0] = *(const bf16x8*)(Zq + (size_t)(qlo + r32) * NMIX + d0 * 16 + hi * 8);
    const float Fq = Fh[qlo + r32];
    int j_lo; float qrow2;
    {
        float qs = 0.f;
#pragma unroll
        for (int d0 = 0; d0 < 8; ++d0)
#pragma unroll
            for (int e = 0; e < 8; ++e) { const float v = bf1((bf16_t)qr[d0][e]); qs = fmaf(v, v, qs); }
        { auto rr = __builtin_amdgcn_permlane32_swap(__float_as_uint(qs), __float_as_uint(qs), false, false); qs = __uint_as_float(rr[0]) + __uint_as_float(rr[1]); }
        qrow2 = qs;
#pragma unroll
        for (int o_ = 1; o_ < 32; o_ <<= 1) qs = fmaxf(qs, __shfl_xor(qs, o_));
        LAS float* red = (LAS float*)(lds + OFF_WS);
        __syncthreads();
        if (lane == 0) red[wid] = qs;
        __syncthreads();
        float qn2 = red[0];
#pragma unroll
        for (int w = 1; w < 8; ++w) qn2 = fmaxf(qn2, red[w]);
        const float B2 = 2.f * sqrtf(qn2 * kn2) * SCALE * 1.01f + 0.5f;
        const float thr = -18.f - B2 - Fh[P0];
        const int ndiag0 = P0 / KVBLK;
        int cntskip = 0;
        if (tid < 128) { const bool sk = (tid < ndiag0) && (-Fh[tid * KVBLK + KVBLK - 1] < thr); const unsigned long long bal = __ballot(sk); cntskip = __popcll(bal); }
        __syncthreads();
        if (tid == 0 || tid == 64) red[8 + (tid >> 6)] = (float)cntskip;
        __syncthreads();
        j_lo = (int)(red[8] + red[9]);
        __syncthreads();
    }
    float m_reg = -1e30f, l_reg = 0.f; f32x16 o[4];
#pragma unroll
    for (int d = 0; d < 4; ++d)
#pragma unroll
        for (int r = 0; r < 16; ++r) o[d][r] = 0.f;
    const int sr = tid >> 4, sc = (tid & 15) * 8, vst0 = v_st(sr, sc), vst1 = v_st(32 + sr, sc), kws = KSWZ(sr, sc * 2);
    const int vbase = (int)(uintptr_t)V_lds + v_rd_base(lane);
    bf16x8 st_k0, st_k1, st_v0, st_v1; float st_f = 0.f;
#define SLOAD(kb) do { st_k0 = *(const bf16x8*)(Zk + (size_t)((kb) + sr) * NMIX + sc); st_k1 = *(const bf16x8*)(Zk + (size_t)((kb) + 32 + sr) * NMIX + sc); \
                       st_v0 = *(const bf16x8*)(Zv + (size_t)((kb) + sr) * NMIX + sc); st_v1 = *(const bf16x8*)(Zv + (size_t)((kb) + 32 + sr) * NMIX + sc); \
                       if (tid < 64) st_f = Fh[(kb) + tid]; } while (0)
#define SWRITE(bf) do { *(LAS bf16x8*)(K_lds + (bf) * SHM_K + kws) = st_k0; *(LAS bf16x8*)(K_lds + (bf) * SHM_K + kws + 32 * 256) = st_k1; \
                        *(LAS bf16x8*)(V_lds + (bf) * SHM_V + vst0) = st_v0; *(LAS bf16x8*)(V_lds + (bf) * SHM_V + vst1) = st_v1; \
                        if (tid < 64) FK_lds[(bf) * 64 + tid] = st_f; } while (0)
    const float cbase = -(sqrtf(qrow2 * kn2) * SCALE * 1.01f + 0.25f) - Fq;
    LAS float* stopm = (LAS float*)(lds + OFF_WS + 2048);
    __syncthreads();
    int j = j_hi - 1;
    SLOAD(j * KVBLK); SWRITE(0);
    __syncthreads();
    f32x16 p0, p1; float mn, alpha; bf16x8 pa0, pa1, pa2, pa3;
    for (int t = 0;; ++t) {
        const int buf = t & 1, kb = j * KVBLK; const bool has_next = j > j_lo;
        if (has_next) SLOAD(kb - KVBLK);
        if (kb <= qlo + QBLK - 1) {
            qkt(p0, p1, K_lds + buf * SHM_K, FK_lds + buf * 64, Fq, r32, hi, qr);
            if (kb + KVBLK - 1 > qlo) mask_tile(p0, p1, qm - kb);
            partialSM(p0, p1, m_reg, mn, alpha);
            if (__any(alpha < 1.f)) { if (hi == 0) al_l[r32] = alpha; asm volatile("s_waitcnt lgkmcnt(0)" ::: "memory");
#pragma unroll
                for (int d_ = 0; d_ < 4; ++d_)
#pragma unroll
                    for (int r = 0; r < 16; ++r) o[d_][r] *= al_l[crow(r, hi)]; }
            finishSM(p0, p1, alpha, l_reg, pa0, pa1, pa2, pa3);
            pv_tile(o, vbase + buf * SHM_V, pa0, pa1, pa2, pa3);
        }
        float cm = fmaf(m_reg, SCALE, cbase);
#pragma unroll
        for (int o_ = 1; o_ < 32; o_ <<= 1) cm = fminf(cm, __shfl_xor(cm, o_));
        if (lane == 0) stopm[buf * 8 + wid] = cm;
        if (has_next) SWRITE(buf ^ 1);
        __syncthreads();
        if (!has_next) break;
        float cmin = stopm[buf * 8];
#pragma unroll
        for (int w = 1; w < 8; ++w) cmin = fminf(cmin, stopm[buf * 8 + w]);
        if (cmin >= 18.f - FK_lds[(buf ^ 1) * 64 + 63]) break;
        --j;
    }
#undef SLOAD
#undef SWRITE
    if (hi == 0) li_l[r32] = l_reg; asm volatile("s_waitcnt lgkmcnt(0)" ::: "memory");
    float rli[16];
#pragma unroll
    for (int r = 0; r < 16; ++r) rli[r] = __builtin_amdgcn_rcpf(li_l[crow(r, hi)]);
    bf16_t* Ow = br + (size_t)qlo * DM + 3 * BWID + g * 128;
#pragma unroll
    for (int r = 0; r < 16; ++r) { const int orow = crow(r, hi);
#pragma unroll
        for (int d0 = 0; d0 < 4; ++d0) { const float v = o[d0][r] * rli[r]; const float vn = __shfl_xor(v, 1);
            if ((r32 & 1) == 0) *(unsigned*)(Ow + (size_t)orow * DM + d0 * 32 + r32) = cvtpk(v, vn); } }
}
}

namespace mix {
constexpr int VR_STRIDE = 520;
constexpr int PL_STRIDE = 520;
__device__ __forceinline__ void unpk8(const u32x4 w, float (&f)[8]) { f[0] = bflo(w.x); f[1] = bfhi(w.x); f[2] = bflo(w.y); f[3] = bfhi(w.y); f[4] = bflo(w.z); f[5] = bfhi(w.z); f[6] = bflo(w.w); f[7] = bfhi(w.w); }
__device__ __forceinline__ void conv_item(const Params& p, int l, int t0) {
    const int tid = ltid(), cc = tid & 63, tg = tid >> 6, c = cc * 8, tf = t0 + tg * 16;
    const float* cw = p.conv_w + (size_t)l * 3 * BWID + c;
    float w[3][8];
#pragma unroll
    for (int j = 0; j < 3; ++j) { const f32x4 a = *(const f32x4*)(cw + j * BWID), b = *(const f32x4*)(cw + j * BWID + 4);
        w[j][0] = a[0]; w[j][1] = a[1]; w[j][2] = a[2]; w[j][3] = a[3]; w[j][4] = b[0]; w[j][5] = b[1]; w[j][6] = b[2]; w[j][7] = b[3]; }
    const bf16_t* zb = p.zmix + C_A + c; const bf16_t* zc = zb + BWID; const bf16_t* zh = zb + 2 * BWID;
    float z2[8], z1[8];
    { u32x4 c2 = {0u, 0u, 0u, 0u}, h2 = c2, c1 = c2, h1 = c2;
      if (tf >= 2) { c2 = *(const u32x4*)(zc + (size_t)(tf - 2) * NMIX); h2 = *(const u32x4*)(zh + (size_t)(tf - 2) * NMIX); }
      if (tf >= 1) { c1 = *(const u32x4*)(zc + (size_t)(tf - 1) * NMIX); h1 = *(const u32x4*)(zh + (size_t)(tf - 1) * NMIX); }
      float a[8], b[8]; unpk8(c2, a); unpk8(h2, b);
#pragma unroll
      for (int e = 0; e < 8; ++e) z2[e] = a[e] * b[e];
      unpk8(c1, a); unpk8(h1, b);
#pragma unroll
      for (int e = 0; e < 8; ++e) z1[e] = a[e] * b[e]; }
#pragma unroll 1
    for (int hb = 0; hb < 2; ++hb) {
        u32x4 cv[8], hv[8], bv[8];
#pragma unroll
        for (int i = 0; i < 8; ++i) { const size_t ro = (size_t)(tf + hb * 8 + i) * NMIX; cv[i] = *(const u32x4*)(zc + ro); hv[i] = *(const u32x4*)(zh + ro); bv[i] = *(const u32x4*)(zb + ro); }
#pragma unroll
        for (int i = 0; i < 8; ++i) { float a[8], b[8], g[8], y[8]; unpk8(cv[i], a); unpk8(hv[i], b); unpk8(bv[i], g);
#pragma unroll
            for (int e = 0; e < 8; ++e) { const float z0 = a[e] * b[e]; y[e] = g[e] * (w[0][e] * z2[e] + w[1][e] * z1[e] + w[2][e] * z0); z2[e] = z1[e]; z1[e] = z0; }
            u32x4 o; o.x = pk2(y[0], y[1]); o.y = pk2(y[2], y[3]); o.z = pk2(y[4], y[5]); o.w = pk2(y[6], y[7]);
            *(u32x4*)(p.br + (size_t)(tf + hb * 8 + i) * DM + c) = o; }
    }
}
__device__ __forceinline__ void sgu_item(const Params& p, int l, int t0, LAS unsigned char* lds) {
    const int tid = ltid(), wid = __builtin_amdgcn_readfirstlane(tid >> 6), lane = tid & 63, fr = lane & 15, fq = lane >> 4;
    LAS bf16_t* VR = (LAS bf16_t*)lds;
    __syncthreads();
    {
        const float* ngp = p.sgu_norm_g + (size_t)l * BWID + 8 * lane; const f32x4 n0 = *(const f32x4*)ngp, n1 = *(const f32x4*)(ngp + 4);
        const float ng[8] = {n0[0], n0[1], n0[2], n0[3], n1[0], n1[1], n1[2], n1[3]};
        u32x4 zr[16];
#pragma unroll
        for (int i = 0; i < 16; ++i) zr[i] = *(const u32x4*)(p.zmix + (size_t)(t0 + wid * 16 + i) * NMIX + C_B + BWID + 8 * lane);
#pragma unroll
        for (int i = 0; i < 16; ++i) { float v[8]; unpk8(zr[i], v); float ss = 0.f;
#pragma unroll
            for (int e = 0; e < 8; ++e) { v[e] = gelu_t(v[e]); ss += v[e] * v[e]; }
            const float rstd = __builtin_amdgcn_rsqf(wave_sum(ss) * (1.f / BWID) + EPS);
            u32x4 o; o.x = pk2(v[0] * rstd * ng[0], v[1] * rstd * ng[1]); o.y = pk2(v[2] * rstd * ng[2], v[3] * rstd * ng[3]);
            o.z = pk2(v[4] * rstd * ng[4], v[5] * rstd * ng[5]); o.w = pk2(v[6] * rstd * ng[6], v[7] * rstd * ng[7]);
            *(LAS u32x4*)(VR + (wid * 16 + i) * VR_STRIDE + 8 * lane) = o; }
    }
    __syncthreads();
    const int g = wid >> 1, dh = wid & 1;
    const int q4 = (lane & 15) >> 2, pl = lane & 3;
    const int vb0 = (int)(uintptr_t)VR + (fq * 8 + q4) * (VR_STRIDE * 2) + (g * 128 + dh * 64 + pl * 4) * 2, vb1 = vb0 + 64 * VR_STRIDE * 2;
    bf16x8 X[4][4];
#define TRX(dst, base, off) asm volatile("ds_read_b64_tr_b16 %0, %1 offset:%2" : "=&v"(dst) : "v"(base), "i"(off) : "memory")
#pragma unroll
    for (int xb = 0; xb < 4; ++xb)
#pragma unroll
        for (int ks = 0; ks < 4; ++ks) { s16x4 lo, hi; constexpr int RB = VR_STRIDE * 2;
            if (ks < 2) { TRX(lo, vb0, xb * 32 + (ks & 1) * 32 * RB); TRX(hi, vb0, xb * 32 + (ks & 1) * 32 * RB + 4 * RB); }
            else        { TRX(lo, vb1, xb * 32 + (ks & 1) * 32 * RB); TRX(hi, vb1, xb * 32 + (ks & 1) * 32 * RB + 4 * RB); }
            asm volatile("s_waitcnt lgkmcnt(0)" ::: "memory");
            X[xb][ks] = (bf16x8){lo[0], lo[1], lo[2], lo[3], hi[0], hi[1], hi[2], hi[3]}; }
#undef TRX
    const bf16_t* W = p.sguW + ((size_t)l * 4 + g) * 128 * 128;
    const float* bias = p.sgu_b + ((size_t)l * 4 + g) * 128;
#pragma unroll 1
    for (int tp = 0; tp < 4; ++tp) {
        bf16x8 Y[2][4]; u32x2 uw[2][4]; float bs[2];
#pragma unroll
        for (int h2 = 0; h2 < 2; ++h2) { const int t = (tp * 2 + h2) * 16 + fr; bs[h2] = bias[t];
#pragma unroll
            for (int ks = 0; ks < 4; ++ks) Y[h2][ks] = *(const bf16x8*)(W + (size_t)t * 128 + ks * 32 + fq * 8);
#pragma unroll
            for (int xb = 0; xb < 4; ++xb) uw[h2][xb] = *(const u32x2*)(p.zmix + (size_t)(t0 + t) * NMIX + C_B + g * 128 + dh * 64 + xb * 16 + 4 * fq); }
#pragma unroll
        for (int h2 = 0; h2 < 2; ++h2) { const int t = (tp * 2 + h2) * 16 + fr;
            f32x4 acc[4];
#pragma unroll
            for (int xb = 0; xb < 4; ++xb) acc[xb] = (f32x4){0.f, 0.f, 0.f, 0.f};
#pragma unroll
            for (int ks = 0; ks < 4; ++ks)
#pragma unroll
                for (int xb = 0; xb < 4; ++xb) acc[xb] = mfma16(X[xb][ks], Y[h2][ks], acc[xb]);
#pragma unroll
            for (int xb = 0; xb < 4; ++xb) { const int c = g * 128 + dh * 64 + xb * 16 + 4 * fq; const u32x2 u_ = uw[h2][xb];
                const float u0 = gelu_t(bflo(u_.x)), u1 = gelu_t(bfhi(u_.x)), u2 = gelu_t(bflo(u_.y)), u3 = gelu_t(bfhi(u_.y));
                u32x2 o; o.x = pk2(u0 * (acc[xb][0] + bs[h2]), u1 * (acc[xb][1] + bs[h2])); o.y = pk2(u2 * (acc[xb][2] + bs[h2]), u3 * (acc[xb][3] + bs[h2]));
                *(u32x2*)(p.br + (size_t)(t0 + t) * DM + BWID + c) = o; } }
    }
}
template <int W>
__device__ __forceinline__ void pool_fill(const bf16_t* zmix, LAS bf16_t* PL, int t0, int th, int lane) {
    constexpr int G = (W == 2) ? 0 : (W == 4) ? 1 : (W == 8) ? 2 : 3;
    const int ccl = lane & 15, ts = lane >> 4, c = G * 128 + ccl * 8;
#pragma unroll 1
    for (int hp = 0; hp < 2; ++hp) {
        const int tl0 = th * 64 + ts * 16 + hp * 8, ta0 = t0 + tl0;
        u32x4 R[8 + W - 1];
#pragma unroll
        for (int k = 0; k < 8 + W - 1; ++k) { const int ta = ta0 - (W - 1) + k; R[k] = (u32x4){0u, 0u, 0u, 0u}; if (ta >= 0) R[k] = *(const u32x4*)(zmix + (size_t)ta * NMIX + C_C + c); }
        float s[8];
#pragma unroll
        for (int e = 0; e < 8; ++e) s[e] = 0.f;
#pragma unroll
        for (int k = 0; k < W - 1; ++k) { float f[8]; unpk8(R[k], f);
#pragma unroll
            for (int e = 0; e < 8; ++e) s[e] += f[e]; }
#pragma unroll
        for (int i = 0; i < 8; ++i) { float f[8], d[8]; unpk8(R[W - 1 + i], f); unpk8(R[i], d);
            const int ta = ta0 + i; const float inv = 1.f / (float)((ta + 1 < W) ? ta + 1 : W);
            float o[8];
#pragma unroll
            for (int e = 0; e < 8; ++e) { s[e] += f[e]; o[e] = s[e] * inv - f[e]; s[e] -= d[e]; }
            u32x4 w; w.x = pk2(o[0], o[1]); w.y = pk2(o[2], o[3]); w.z = pk2(o[4], o[5]); w.w = pk2(o[6], o[7]);
            *(LAS u32x4*)(PL + (tl0 + i) * PL_STRIDE + c) = w; }
    }
}
__device__ __forceinline__ void pool_item(const Params& p, int l, int t0, LAS unsigned char* lds) {
    const int tid = ltid(), wid = __builtin_amdgcn_readfirstlane(tid >> 6), lane = tid & 63, fr = lane & 15, fq = lane >> 4;
    LAS bf16_t* PL = (LAS bf16_t*)lds;
    const int g = wid >> 1, oh = wid & 1;
    const bf16_t* WT = p.poolWT + ((size_t)l * 4 + g) * 128 * 128;
    __syncthreads();
    {
        const int gg = wid & 3, th = wid >> 2;
        if (gg == 0) pool_fill<2>(p.zmix, PL, t0, th, lane); else if (gg == 1) pool_fill<4>(p.zmix, PL, t0, th, lane);
        else if (gg == 2) pool_fill<8>(p.zmix, PL, t0, th, lane); else pool_fill<16>(p.zmix, PL, t0, th, lane);
    }
    bf16x8 X[4][4];
#pragma unroll
    for (int xb = 0; xb < 4; ++xb)
#pragma unroll
        for (int ks = 0; ks < 4; ++ks) X[xb][ks] = *(const bf16x8*)(WT + (size_t)(oh * 64 + xb * 16 + fr) * 128 + ks * 32 + fq * 8);
    __syncthreads();
    const float* sc = p.pool_scale + (size_t)l * BWID + g * 128;
    f32x4 sv[4];
#pragma unroll
    for (int xb = 0; xb < 4; ++xb) sv[xb] = *(const f32x4*)(sc + oh * 64 + xb * 16 + 4 * fq);
#pragma unroll 2
    for (int tb = 0; tb < 8; ++tb) {
        f32x4 acc[4];
#pragma unroll
        for (int xb = 0; xb < 4; ++xb) acc[xb] = (f32x4){0.f, 0.f, 0.f, 0.f};
#pragma unroll
        for (int ks = 0; ks < 4; ++ks) { const bf16x8 Y = *(const LAS bf16x8*)(PL + (tb * 16 + fr) * PL_STRIDE + g * 128 + ks * 32 + fq * 8);
#pragma unroll
            for (int xb = 0; xb < 4; ++xb) acc[xb] = mfma16(X[xb][ks], Y, acc[xb]); }
        const int t = tb * 16 + fr;
#pragma unroll
        for (int xb = 0; xb < 4; ++xb) { const int o0 = oh * 64 + xb * 16 + 4 * fq;
            u32x2 o; o.x = pk2(acc[xb][0] * sv[xb][0], acc[xb][1] * sv[xb][1]); o.y = pk2(acc[xb][2] * sv[xb][2], acc[xb][3] * sv[xb][3]);
            *(u32x2*)(p.br + (size_t)(t0 + t) * DM + 2 * BWID + g * 128 + o0) = o; }
    }
}
}

template <bool FORGET>
__device__ __forceinline__ void norm_phase(const Params& p, int l, const float* hsrc, const bf16_t* po, const float* gain, int gw, int ngw, int lane) {
    f32x4 gv[8], wf[4][8];
#pragma unroll
    for (int j = 0; j < 8; ++j) { gv[j] = ((const f32x4*)gain)[lane + 64 * j];
        if (FORGET) {
#pragma unroll
            for (int g = 0; g < 4; ++g) wf[g][j] = ((const f32x4*)(p.wfg + ((size_t)l * 4 + g) * DM))[lane + 64 * j]; } }
    for (int t = gw; t < SEQ; t += ngw) {
        const f32x4* hr = (const f32x4*)(hsrc + (size_t)t * DM) + lane;
        f32x4 v[8]; float ss = 0.f;
#pragma unroll
        for (int j = 0; j < 8; ++j) v[j] = hr[64 * j];
        if (po) {
#pragma unroll
            for (int j = 0; j < 8; ++j) { const u32x2 w = ((const u32x2*)(po + (size_t)t * DM))[lane + 64 * j]; v[j][0] += bflo(w.x); v[j][1] += bfhi(w.x); v[j][2] += bflo(w.y); v[j][3] += bfhi(w.y); } }
#pragma unroll
        for (int j = 0; j < 8; ++j) ss += (v[j][0] * v[j][0] + v[j][1] * v[j][1]) + (v[j][2] * v[j][2] + v[j][3] * v[j][3]);
        const float rstd = __builtin_amdgcn_rsqf(wave_sum(ss) * (1.f / DM) + EPS);
        float fd[4] = {0.f, 0.f, 0.f, 0.f};
        u32x2* o8 = (u32x2*)(p.xn + (size_t)t * DM) + lane;
#pragma unroll
        for (int j = 0; j < 8; ++j) { const f32x4 y = v[j] * rstd * gv[j];
            u32x2 w; w.x = pk2(y[0], y[1]); w.y = pk2(y[2], y[3]); o8[64 * j] = w;
            if (!FORGET) { int f8 = __builtin_amdgcn_cvt_pk_fp8_f32(clamp8(y[0]), clamp8(y[1]), 0, false); f8 = __builtin_amdgcn_cvt_pk_fp8_f32(clamp8(y[2]), clamp8(y[3]), f8, true);
                ((unsigned*)(p.hn8 + (size_t)t * DM))[lane + 64 * j] = (unsigned)f8; }
            if (FORGET) {
#pragma unroll
                for (int g = 0; g < 4; ++g) fd[g] += (y[0] * wf[g][j][0] + y[1] * wf[g][j][1]) + (y[2] * wf[g][j][2] + y[3] * wf[g][j][3]); } }
        if (FORGET) {
#pragma unroll
            for (int g = 0; g < 4; ++g) { const float z = wave_sum(fd[g]) + p.forget_b[l * 4 + g];
                const float ls = fminf(z, 0.f) - log1pf(__expf(-fabsf(z)));
                if (lane == 0) p.flog[(size_t)t * 4 + g] = ls; } }
    }
}
__device__ __forceinline__ void final_norm_phase(const Params& p, int gw, int ngw, int lane) {
    for (int t = gw; t < SEQ; t += ngw) {
        const f32x4* hr = (const f32x4*)(p.h + (size_t)t * DM) + lane;
        f32x4 v[8]; float ss = 0.f;
#pragma unroll
        for (int j = 0; j < 8; ++j) { v[j] = hr[64 * j]; const u32x2 w = ((const u32x2*)(p.po + (size_t)t * DM))[lane + 64 * j];
            v[j][0] += bflo(w.x); v[j][1] += bfhi(w.x); v[j][2] += bflo(w.y); v[j][3] += bfhi(w.y);
            ss += (v[j][0] * v[j][0] + v[j][1] * v[j][1]) + (v[j][2] * v[j][2] + v[j][3] * v[j][3]); }
        const float rstd = __builtin_amdgcn_rsqf(wave_sum(ss) * (1.f / DM) + EPS);
        f32x4* o = (f32x4*)(p.out + (size_t)t * DM) + lane;
#pragma unroll
        for (int j = 0; j < 8; ++j) o[64 * j] = v[j] * rstd * ((const f32x4*)p.final_g)[lane + 64 * j];
    }
}
__device__ __forceinline__ void cumsum_head(const Params& p, int g, LAS unsigned char* lds) {
    LAS float* part = (LAS float*)lds;
    const int tid = ltid(), lane = tid & 63, wid = tid >> 6;
    float v[16]; float s = 0.f;
#pragma unroll
    for (int j = 0; j < 16; ++j) { v[j] = p.flog[(size_t)(tid * 16 + j) * 4 + g]; s += v[j]; }
    float x = s;
#pragma unroll
    for (int o = 1; o < 64; o <<= 1) { const float y = __shfl_up(x, o); if (lane >= o) x += y; }
    __syncthreads();
    if (lane == 63) part[wid] = x;
    __syncthreads();
    float pre = x - s;
    for (int w = 0; w < wid; ++w) pre += part[w];
#pragma unroll
    for (int j = 0; j < 16; ++j) { pre += v[j]; p.F[(size_t)g * SEQ + tid * 16 + j] = pre; }
    __syncthreads();
}
__device__ __forceinline__ void knorm_phase(const Params& p, int l, int gw, int ngw, int lane) {
    float mx = 0.f;
#pragma unroll 4
    for (int t = gw; t < SEQ; t += ngw) {
        const u32x4 w = *(const u32x4*)(p.zmix + (size_t)t * NMIX + C_K + lane * 8);
        float s = bflo(w.x) * bflo(w.x) + bfhi(w.x) * bfhi(w.x) + bflo(w.y) * bflo(w.y) + bfhi(w.y) * bfhi(w.y)
                + bflo(w.z) * bflo(w.z) + bfhi(w.z) * bfhi(w.z) + bflo(w.w) * bflo(w.w) + bfhi(w.w) * bfhi(w.w);
#pragma unroll
        for (int o = 1; o < 16; o <<= 1) s += __shfl_xor(s, o);
        mx = fmaxf(mx, s);
    }
    if ((lane & 15) == 0) atomicMax(p.ctl + CW_KN + l * 4 + (lane >> 4), __float_as_uint(mx));
}

namespace pro { __device__ __forceinline__ void conv_share(const Params& p, int L, int half, LAS unsigned char* lds); }
namespace peer {
constexpr int S_STRIDE = 129, TL_STRIDE = 17;
constexpr int OFF_TL = 256 * S_STRIDE * 4;
__device__ __forceinline__ float pack_f(float v, unsigned idx, unsigned mask) { return __uint_as_float((__float_as_uint(v) & ~mask) | idx); }
#define CEX_DESC(x, y) do { const float hi_ = fmaxf((x), (y)), lo_ = fminf((x), (y)); (x) = hi_; (y) = lo_; } while (0)
__device__ __forceinline__ void sort16_desc(float (&a)[16]) {
#pragma unroll
    for (int k = 2; k <= 16; k <<= 1)
#pragma unroll
        for (int j = k >> 1; j > 0; j >>= 1)
#pragma unroll
            for (int i = 0; i < 16; ++i) { const int l = i ^ j; if (l > i) { if ((i & k) == 0 || k == 16) { if (k == 16 || (i & k) == 0) CEX_DESC(a[i], a[l]); } else CEX_DESC(a[l], a[i]); } }
}
__device__ __forceinline__ void merge16_desc(float (&r)[16], const float (&c)[16]) {
#pragma unroll
    for (int i = 0; i < 16; ++i) r[i] = fmaxf(r[i], c[15 - i]);
#pragma unroll
    for (int j = 8; j > 0; j >>= 1)
#pragma unroll
        for (int i = 0; i < 16; ++i) { const int l = i ^ j; if (l > i) CEX_DESC(r[i], r[l]); }
}
__device__ __forceinline__ void topk_item(const Params& p, int l, int t0, int hd, LAS unsigned char* lds) {
    const int tid = ltid(), wid = __builtin_amdgcn_readfirstlane(tid >> 6), lane = tid & 63, fr = lane & 15, fq = lane >> 4;
    LAS float* Sc = (LAS float*)lds; LAS float* TL = (LAS float*)(lds + OFF_TL);
    __syncthreads();
    {
        const int pp = wid >> 2, nq = wid & 3;
        const bf16_t* kb = p.keysB + (((size_t)l * 8 + hd) * 2 + pp) * 128 * 128;
        const bf16_t* qb = p.q + (size_t)t0 * DM + hd * 256 + pp * 128;
        bf16x8 X[2][4];
#pragma unroll
        for (int xb = 0; xb < 2; ++xb)
#pragma unroll
            for (int ks = 0; ks < 4; ++ks) X[xb][ks] = *(const bf16x8*)(kb + (size_t)(nq * 32 + xb * 16 + fr) * 128 + ks * 32 + fq * 8);
        bf16x8 Yq[8][4];
#pragma unroll
        for (int tb = 0; tb < 8; ++tb)
#pragma unroll
            for (int ks = 0; ks < 4; ++ks) Yq[tb][ks] = *(const bf16x8*)(qb + (size_t)(tb * 16 + fr) * DM + ks * 32 + fq * 8);
#pragma unroll
        for (int tb = 0; tb < 8; ++tb) {
            f32x4 acc[2] = {(f32x4){0.f, 0.f, 0.f, 0.f}, (f32x4){0.f, 0.f, 0.f, 0.f}};
#pragma unroll
            for (int ks = 0; ks < 4; ++ks) { const bf16x8 Y = Yq[tb][ks];
                acc[0] = mfma16(X[0][ks], Y, acc[0]); acc[1] = mfma16(X[1][ks], Y, acc[1]); }
            LAS float* row = Sc + (pp * 128 + tb * 16 + fr) * S_STRIDE + nq * 32 + 4 * fq;
#pragma unroll
            for (int xb = 0; xb < 2; ++xb)
#pragma unroll
                for (int r = 0; r < 4; ++r) row[xb * 16 + r] = acc[xb][r];
        }
    }
    __syncthreads();
    if (tid < 256) {
        const LAS float* row = Sc + tid * S_STRIDE;
        float L[16];
#pragma unroll
        for (int i = 0; i < 16; ++i) L[i] = pack_f(row[i], (unsigned)i, 127u);
        sort16_desc(L);
#pragma unroll 1
        for (int ch = 1; ch < 8; ++ch) { float C[16];
#pragma unroll
            for (int i = 0; i < 16; ++i) C[i] = pack_f(row[ch * 16 + i], (unsigned)(ch * 16 + i), 127u);
            sort16_desc(C); merge16_desc(L, C); }
#pragma unroll
        for (int i = 0; i < 16; ++i) TL[tid * TL_STRIDE + i] = L[i];
    }
    __syncthreads();
    if (tid < 128) {
        const LAS float* A = TL + tid * TL_STRIDE; const LAS float* B = TL + (128 + tid) * TL_STRIDE;
        float av[16], bv[16];
#pragma unroll
        for (int i = 0; i < 16; ++i) { av[i] = __uint_as_float(__float_as_uint(A[i]) & ~127u); bv[i] = __uint_as_float(__float_as_uint(B[i]) & ~127u); }
        float L[16];
        {   float cand[64]; int nc = 0;
#pragma unroll
            for (int a = 0; a < 16; ++a)
#pragma unroll
                for (int b = 0; b < 16; ++b) if ((a + 1) * (b + 1) <= 16) { cand[nc] = pack_f(av[a] + bv[b], (unsigned)(a * 16 + b), 255u); ++nc; }
#pragma unroll
            for (int i = 50; i < 64; ++i) cand[i] = -__builtin_inff();
#pragma unroll
            for (int i = 0; i < 16; ++i) L[i] = cand[i];
            sort16_desc(L);
#pragma unroll
            for (int ch = 1; ch < 4; ++ch) { float C[16];
#pragma unroll
                for (int i = 0; i < 16; ++i) C[i] = cand[ch * 16 + i];
                sort16_desc(C); merge16_desc(L, C); }
        }
        float val[16]; int ex[16]; float mx = -__builtin_inff();
#pragma unroll
        for (int i = 0; i < 16; ++i) { const unsigned ab = __float_as_uint(L[i]) & 255u; const unsigned ua = __float_as_uint(A[ab >> 4]), ub = __float_as_uint(B[ab & 15]);
            val[i] = __uint_as_float(ua & ~127u) + __uint_as_float(ub & ~127u); ex[i] = (int)((ua & 127u) * 128u + (ub & 127u)); mx = fmaxf(mx, val[i]); }
        float sum = 0.f;
#pragma unroll
        for (int i = 0; i < 16; ++i) { val[i] = __expf(val[i] - mx); sum += val[i]; }
        const float inv = 1.f / sum;
        int* pi = p.pidx + (size_t)(t0 + tid) * 128 + hd * 16; float* pg = p.pgate + (size_t)(t0 + tid) * 128 + hd * 16;
#pragma unroll
        for (int i = 0; i < 16; ++i) { pi[i] = ex[i]; pg[i] = val[i] * inv; }
    }
}
__device__ __forceinline__ void vm_wait_le(int n) {
    if (n >= 19) asm volatile("s_waitcnt vmcnt(19)" ::: "memory");
    else if (n >= 16) asm volatile("s_waitcnt vmcnt(16)" ::: "memory");
    else if (n >= 15) asm volatile("s_waitcnt vmcnt(15)" ::: "memory");
    else if (n >= 12) asm volatile("s_waitcnt vmcnt(12)" ::: "memory");
    else if (n >= 8) asm volatile("s_waitcnt vmcnt(8)" ::: "memory");
    else if (n >= 4) asm volatile("s_waitcnt vmcnt(4)" ::: "memory");
    else asm volatile("s_waitcnt vmcnt(0)" ::: "memory");
}
__device__ __forceinline__ bool claim_item(unsigned* cnt, unsigned nchunk, volatile LAS unsigned* misc, int tid, int& q, int& chunk) {
    __syncthreads();
    if (tid < 64) {
        const unsigned x2 = (xb_xcc_id() & 7u) * 2u; unsigned res = 0xffffffffu;
        unsigned k = misc[1];
        for (int tries = 0; tries < 32; ++tries) {
            const unsigned qx = (x2 + k) & 15u;
            unsigned c = 0u;
            if (tid == 0) c = __hip_atomic_fetch_add(cnt + 64 * qx, 1u, __ATOMIC_RELAXED, __HIP_MEMORY_SCOPE_AGENT);
            c = __builtin_amdgcn_readfirstlane(c);
            if (c < nchunk) { res = (qx << 16) | c; break; }
            unsigned hv = 0xffffffffu;
            if (tid < 16) hv = __hip_atomic_load(cnt + 64 * ((x2 + (unsigned)tid) & 15u), __ATOMIC_RELAXED, __HIP_MEMORY_SCOPE_AGENT);
            const unsigned long long open = __ballot(hv < nchunk) & 0xffffull;
            if (open == 0ull) break;
            k = (unsigned)__builtin_ctzll(open);
        }
        if (tid == 0) { misc[0] = res; misc[1] = k; }
    }
    __syncthreads();
    const unsigned r = misc[0];
    if (r == 0xffffffffu) return false;
    q = (int)(r >> 16); chunk = (int)(r & 0xffffu); return true;
}
__device__ __forceinline__ void gather1_phase(const Params& p, int l, LAS unsigned char* lds, int rep = 0) {
    const int tid = ltid(), wid = __builtin_amdgcn_readfirstlane(tid >> 6), lane = tid & 63, r = lane & 15, c = lane >> 4;
    volatile LAS unsigned* misc = (volatile LAS unsigned*)(lds + LDS_MISC);
    unsigned* cnt = p.ctl + CW_QCNT + ((l * 2 + 0) * 2 + rep) * 16 * 64;
    if (tid == 0) misc[1] = 0u;
    LAS unsigned char* buf = lds + wid * 16384;
    LAS unsigned char* sm = lds + 131072 + wid * 2304;
    const int rowi = lane >> 3, j = lane & 7, fw = rowi >> 1, frd = (r >> 1) & 7;
    const int bk0 = (int)(uintptr_t)buf + r * 128 + ((c ^ frd) * 16), bk1 = (int)(uintptr_t)buf + r * 128 + (((4 + c) ^ frd) * 16);
    float mk[8];
#pragma unroll
    for (int g = 0; g < 8; ++g) mk[g] = ((r >> 1) == g) ? 1.f : 0.f;
    const bool odd = (r & 1) != 0;
    int q, chunk;
    const int cpos = (lbid() >> 3) % 5; bool cpend = (l + 1 < DEPTH) && rep == 0;
    bool dry = false;
    for (int ndone = 0;; ++ndone) {
        if (cpend && (dry || ndone == cpos)) { pro::conv_share(p, l + 1, 0, lds); cpend = false; }
        if (dry) break;
        if (!claim_item(cnt, (unsigned)(SEQ / (8 * TPW)), misc, tid, q, chunk)) { dry = true; if (!cpend) break; continue; }

        const int tw = chunk * (8 * TPW) + wid * TPW;
        float acc[TPW][2];
#pragma unroll
        for (int i = 0; i < TPW; ++i) { acc[i][0] = 0.f; acc[i][1] = 0.f; }
#define G1_DMAQ(Q, EN) do { _Pragma("unroll") for (int nn = 0; nn < 4; ++nn) { const int n = ((Q) & 1) * 4 + nn; const int e = (EN)[(Q) * 4 + nn]; \
                        const unsigned char* src = ub + (unsigned)((unsigned)e * 128u + (unsigned)((j ^ ((n & 1) * 4 + fw)) * 16)); \
                        __builtin_amdgcn_global_load_lds((const unsigned*)src, (LAS unsigned*)(buf + ((Q) >> 1) * 8192 + n * 1024), 16, 0, 0); } } while (0)
#define G1_CQ(Q, H0, H1, I) do { const int gga = ((Q) & 1) * 2, ga = ((Q) >> 1) * 4 + gga;     \
                        const i64x2 A0a = *(const LAS i64x2*)(uintptr_t)(bk0 + ((Q) >> 1) * 8192 + gga * 2048), A1a = *(const LAS i64x2*)(uintptr_t)(bk1 + ((Q) >> 1) * 8192 + gga * 2048); \
                        const i64x2 A0b = *(const LAS i64x2*)(uintptr_t)(bk0 + ((Q) >> 1) * 8192 + gga * 2048 + 2048), A1b = *(const LAS i64x2*)(uintptr_t)(bk1 + ((Q) >> 1) * 8192 + gga * 2048 + 2048); \
                        f32x4 Ca = __builtin_amdgcn_mfma_f32_16x16x32_fp8_fp8(A0a[0], (H0)[0], (f32x4){0.f, 0.f, 0.f, 0.f}, 0, 0, 0); \
                        f32x4 Cb = __builtin_amdgcn_mfma_f32_16x16x32_fp8_fp8(A0b[0], (H0)[0], (f32x4){0.f, 0.f, 0.f, 0.f}, 0, 0, 0); \
                        Ca = __builtin_amdgcn_mfma_f32_16x16x32_fp8_fp8(A0a[1], (H0)[1], Ca, 0, 0, 0); Cb = __builtin_amdgcn_mfma_f32_16x16x32_fp8_fp8(A0b[1], (H0)[1], Cb, 0, 0, 0); \
                        Ca = __builtin_amdgcn_mfma_f32_16x16x32_fp8_fp8(A1a[0], (H1)[0], Ca, 0, 0, 0); Cb = __builtin_amdgcn_mfma_f32_16x16x32_fp8_fp8(A1b[0], (H1)[0], Cb, 0, 0, 0); \
                        Ca = __builtin_amdgcn_mfma_f32_16x16x32_fp8_fp8(A1a[1], (H1)[1], Ca, 0, 0, 0); Cb = __builtin_amdgcn_mfma_f32_16x16x32_fp8_fp8(A1b[1], (H1)[1], Cb, 0, 0, 0); \
                        acc[I][0] = fmaf(mk[ga], odd ? Ca[2] : Ca[0], acc[I][0]); acc[I][1] = fmaf(mk[ga], odd ? Ca[3] : Ca[1], acc[I][1]); \
                        acc[I][0] = fmaf(mk[ga + 1], odd ? Cb[2] : Cb[0], acc[I][0]); acc[I][1] = fmaf(mk[ga + 1], odd ? Cb[3] : Cb[1], acc[I][1]); \
                        asm volatile("s_waitcnt lgkmcnt(0)" ::: "memory"); } while (0)
#define G1_SMALLD(SLOT, TI) do { const int* ip_ = p.pidx + (size_t)(tw + (TI)) * 128 + lane; \
                        __builtin_amdgcn_global_load_lds((const unsigned*)ip_, (LAS unsigned*)(sm + (SLOT) * 768), 4, 0, 0); \
                        __builtin_amdgcn_global_load_lds((const unsigned*)(ip_ + 64), (LAS unsigned*)(sm + (SLOT) * 768 + 256), 4, 0, 0); \
                        __builtin_amdgcn_global_load_lds((const unsigned*)(hs0 + (size_t)(TI) * DM), (LAS unsigned*)(sm + (SLOT) * 768 + 512), 4, 0, 0); } while (0)
#define G1_RDIX(SLOT, EN) do { _Pragma("unroll") for (int m = 0; m < 16; ++m) (EN)[m] = *(const LAS int*)(sm + (SLOT) * 768 + (m * 8 + rowi) * 4); } while (0)
#define G1_RDHY(SLOT, H0, H1) do { H0 = *(const LAS i64x2*)(sm + (SLOT) * 768 + 512 + c * 16); H1 = *(const LAS i64x2*)(sm + (SLOT) * 768 + 512 + 64 + c * 16); } while (0)
        {
            const int s = q;
            const unsigned char* ub = p.uS8 + ((size_t)(l * 16 + s) * PEER_N) * 128;
            const unsigned char* hs0 = p.hn8 + (size_t)tw * DM + s * 128 + (lane & 31) * 4;
            int en[16]; i64x2 hyc0, hyc1;
            G1_SMALLD(0, 0); G1_SMALLD(1, 1);
            asm volatile("s_waitcnt vmcnt(0)" ::: "memory"); __builtin_amdgcn_sched_barrier(0);
            G1_RDIX(0, en);
            G1_DMAQ(0, en); G1_DMAQ(1, en); G1_DMAQ(2, en); G1_DMAQ(3, en);
            __builtin_amdgcn_sched_barrier(0);
#pragma unroll
            for (int i = 0; i < TPW; ++i) {
#pragma unroll
                for (int qq = 0; qq < 4; ++qq) {
                    const int nyoung = 4 * ((3 - qq) + ((i + 1 < TPW) ? qq : 0)) + ((qq > 0 && i + 2 < TPW) ? 3 : 0);
                    vm_wait_le(nyoung); __builtin_amdgcn_sched_barrier(0);
                    if (qq == 0) {
                        G1_RDHY(i % 3, hyc0, hyc1);
                        if (i + 1 < TPW) G1_RDIX((i + 1) % 3, en);
                        if (i + 2 < TPW) G1_SMALLD((i + 2) % 3, i + 2);
                        __builtin_amdgcn_sched_barrier(0); }
                    G1_CQ(qq, hyc0, hyc1, i);
                    if (i + 1 < TPW) G1_DMAQ(qq, en);
                    __builtin_amdgcn_sched_barrier(0);
                }
            }
        }
#undef G1_SMALLD
#undef G1_RDIX
#undef G1_RDHY
#undef G1_DMAQ
#undef G1_CQ
        const int j0 = 16 * (r >> 1) + 4 * c + 2 * (r & 1);
#pragma unroll
        for (int i = 0; i < TPW; ++i) *(unsigned*)((bf16_t*)p.pq + ((size_t)q * SEQ + tw + i) * 128 + j0) = cvtpk(acc[i][0], acc[i][1]);
    }
}
__device__ __forceinline__ void gather_reduce_phase(const Params& p, const float* rs2, size_t gtid, size_t ngt) {
    for (size_t i = gtid; i < (size_t)SEQ * 128 / 4; i += ngt) {
        f32x4 sum = (f32x4){0.f, 0.f, 0.f, 0.f};
#pragma unroll
        for (int q = 0; q < 16; ++q) { const u32x2 w = ((const u32x2*)((const bf16_t*)p.pq + (size_t)q * SEQ * 128))[i]; sum[0] += bflo(w.x); sum[1] += bfhi(w.x); sum[2] += bflo(w.y); sum[3] += bfhi(w.y); }
        sum *= (1.0f / U_SCALE) * rs2[i >> 5];
        const f32x4 g = ((const f32x4*)p.pgate)[i];
        int w = __builtin_amdgcn_cvt_pk_fp8_f32(clamp8(A_SCALE * g[0] * gelu_t(sum[0])), clamp8(A_SCALE * g[1] * gelu_t(sum[1])), 0, false);
        w = __builtin_amdgcn_cvt_pk_fp8_f32(clamp8(A_SCALE * g[2] * gelu_t(sum[2])), clamp8(A_SCALE * g[3] * gelu_t(sum[3])), w, true);
        ((unsigned*)p.aB8)[i] = (unsigned)w;
    }
}
__device__ __forceinline__ void gather2_phase(const Params& p, int l, LAS unsigned char* lds, int rep = 0) {
    bf16_t* podst = p.po + (rep ? (size_t)SEQ * DM : (size_t)0);
    const int tid = ltid(), wid = __builtin_amdgcn_readfirstlane(tid >> 6), lane = tid & 63, r = lane & 15, c = lane >> 4;
    volatile LAS unsigned* misc = (volatile LAS unsigned*)(lds + LDS_MISC);
    unsigned* cnt = p.ctl + CW_QCNT + ((l * 2 + 1) * 2 + rep) * 16 * 64;
    if (tid == 0) misc[1] = 0u;
    LAS unsigned char* buf = lds + wid * 16384;
    LAS unsigned char* sm = lds + 131072 + wid * 2304;
    const int rowi = lane >> 3, j = lane & 7;
    const int gsw_w = ((rowi >> 1) & 1);
    const int q4 = (lane & 15) >> 2, pl = lane & 3, gl = (q4 >> 1) | ((c & 1) << 1);
    int bnb[4];
#pragma unroll
    for (int nb = 0; nb < 4; ++nb) bnb[nb] = (int)(uintptr_t)buf + (c * 8 + q4) * 128 + pl * 8 + 32 * (nb ^ gl);
    int q, chunk;
    const int cpos = (lbid() >> 3) % 5; bool cpend = (l + 1 < DEPTH) && rep == 0;
    bool dry = false;
    for (int ndone = 0;; ++ndone) {
        if (cpend && (dry || ndone == cpos)) { pro::conv_share(p, l + 1, 1, lds); cpend = false; }
        if (dry) break;
        if (!claim_item(cnt, (unsigned)(SEQ / (8 * TPW)), misc, tid, q, chunk)) { dry = true; if (!cpend) break; continue; }

        const int tw = chunk * (8 * TPW) + wid * TPW;
#define TRR(dst, base, off) asm volatile("ds_read_b64_tr_b16 %0, %1 offset:%2" : "=&v"(dst) : "v"(base), "i"(off) : "memory")
#define EV4(w0, w1) __builtin_amdgcn_perm((w1), (w0), 0x06040200u)
#define OD4(w0, w1) __builtin_amdgcn_perm((w1), (w0), 0x07050301u)
#define G2_CQ(Q, AFQ) do { u32x2 lo[4], hi[4]; \
                        TRR(lo[0], bnb[0], ((Q) >> 1) * 8192 + ((Q) & 1) * 4096); TRR(hi[0], bnb[0], ((Q) >> 1) * 8192 + ((Q) & 1) * 4096 + 512); \
                        TRR(lo[1], bnb[1], ((Q) >> 1) * 8192 + ((Q) & 1) * 4096); TRR(hi[1], bnb[1], ((Q) >> 1) * 8192 + ((Q) & 1) * 4096 + 512); \
                        TRR(lo[2], bnb[2], ((Q) >> 1) * 8192 + ((Q) & 1) * 4096); TRR(hi[2], bnb[2], ((Q) >> 1) * 8192 + ((Q) & 1) * 4096 + 512); \
                        TRR(lo[3], bnb[3], ((Q) >> 1) * 8192 + ((Q) & 1) * 4096); TRR(hi[3], bnb[3], ((Q) >> 1) * 8192 + ((Q) & 1) * 4096 + 512); \
                        asm volatile("s_waitcnt lgkmcnt(0)" ::: "memory"); __builtin_amdgcn_sched_barrier(0); \
                        _Pragma("unroll") for (int nb = 0; nb < 4; ++nb) { \
                            const long E = (long)(((unsigned long long)EV4(hi[nb].x, hi[nb].y) << 32) | EV4(lo[nb].x, lo[nb].y)), O = (long)(((unsigned long long)OD4(hi[nb].x, hi[nb].y) << 32) | OD4(lo[nb].x, lo[nb].y)); \
                            De[nb] = __builtin_amdgcn_mfma_f32_16x16x32_fp8_fp8((AFQ), E, De[nb], 0, 0, 0); Do[nb] = __builtin_amdgcn_mfma_f32_16x16x32_fp8_fp8((AFQ), O, Do[nb], 0, 0, 0); } } while (0)
#define G2_DMAQ(Q, EN) do { _Pragma("unroll") for (int nn = 0; nn < 4; ++nn) { const int n = ((Q) & 1) * 4 + nn; const int e = (EN)[(Q) * 4 + nn]; const int gsw = gsw_w | ((n & 1) << 1); \
                        const unsigned char* src = vb + (unsigned)((unsigned)e * 128u + (unsigned)(((j >> 1) ^ gsw) * 32 + (j & 1) * 16)); \
                        __builtin_amdgcn_global_load_lds((const unsigned*)src, (LAS unsigned*)(buf + ((Q) >> 1) * 8192 + n * 1024), 16, 0, 0); } } while (0)
#define G2_SMALLD(SLOT, TI) do { const int* ip_ = p.pidx + (size_t)(tw + (TI)) * 128 + lane; \
                        __builtin_amdgcn_global_load_lds((const unsigned*)ip_, (LAS unsigned*)(sm + (SLOT) * 768), 4, 0, 0); \
                        __builtin_amdgcn_global_load_lds((const unsigned*)(ip_ + 64), (LAS unsigned*)(sm + (SLOT) * 768 + 256), 4, 0, 0); \
                        __builtin_amdgcn_global_load_lds((const unsigned*)(as0 + (size_t)(TI) * 128), (LAS unsigned*)(sm + (SLOT) * 768 + 512), 4, 0, 0); } while (0)
#define G2_RDIX(SLOT, EN) do { _Pragma("unroll") for (int m = 0; m < 16; ++m) (EN)[m] = *(const LAS int*)(sm + (SLOT) * 768 + (m * 8 + rowi) * 4); } while (0)
#define G2_RDAF(SLOT, AF) do { _Pragma("unroll") for (int ks = 0; ks < 4; ++ks) (AF)[ks] = *(const LAS long*)(sm + (SLOT) * 768 + 512 + ks * 32 + c * 8); } while (0)
        {
            const int s = q;
            const unsigned char* vb = p.vS8 + ((size_t)(l * 16 + s) * PEER_N) * 128;
            const unsigned char* as0 = p.aB8 + (size_t)tw * 128 + (lane & 31) * 4;
            int en[16]; long af[4]; unsigned pend[4];
#pragma unroll
            for (int k = 0; k < 4; ++k) pend[k] = 0u;
            G2_SMALLD(0, 0); G2_SMALLD(1, 1);
            asm volatile("s_waitcnt vmcnt(0)" ::: "memory"); __builtin_amdgcn_sched_barrier(0);
            G2_RDIX(0, en);
            G2_DMAQ(0, en); G2_DMAQ(1, en); G2_DMAQ(2, en); G2_DMAQ(3, en);
            __builtin_amdgcn_sched_barrier(0);
            int sc = 0, sn = 1, s2 = 2;
#pragma unroll 1
            for (int i = 0; i < TPW; ++i) {
                const int t = tw + i;
                f32x4 De[4], Do[4];
#pragma unroll
                for (int nb = 0; nb < 4; ++nb) { De[nb] = (f32x4){0.f, 0.f, 0.f, 0.f}; Do[nb] = (f32x4){0.f, 0.f, 0.f, 0.f}; }
#pragma unroll
                for (int qq = 0; qq < 4; ++qq) {
                    if (qq == 0) vm_wait_le(12);
                    else if (i == TPW - 1) vm_wait_le(4 * (3 - qq) + 4);
                    else if (i >= 1 && i <= TPW - 3) vm_wait_le(19);
                    else vm_wait_le(15);
                    __builtin_amdgcn_sched_barrier(0);
                    if (qq == 0) {
                        G2_RDAF(sc, af);
                        if (i + 1 < TPW) G2_RDIX(sn, en);
                        if (i + 2 < TPW) G2_SMALLD(s2, i + 2);
                        if (i > 0 && c == 0) {
#pragma unroll
                            for (int nb = 0; nb < 4; ++nb) *(unsigned*)(podst + (size_t)(t - 1) * DM + s * 128 + nb * 32 + 2 * r) = pend[nb]; }
                        asm volatile("" ::: "memory"); __builtin_amdgcn_sched_barrier(0); }
                    G2_CQ(qq, af[qq]);
                    if (i + 1 < TPW) G2_DMAQ(qq, en);
                    __builtin_amdgcn_sched_barrier(0);
                }
#pragma unroll
                for (int nb = 0; nb < 4; ++nb) pend[nb] = cvtpk(De[nb][0] * (1.0f / (V_SCALE * A_SCALE)), Do[nb][0] * (1.0f / (V_SCALE * A_SCALE)));
                { const int tmp = sc; sc = sn; sn = s2; s2 = tmp; }
            }
            if (c == 0) {
#pragma unroll
                for (int nb = 0; nb < 4; ++nb) *(unsigned*)(podst + (size_t)(tw + TPW - 1) * DM + s * 128 + nb * 32 + 2 * r) = pend[nb]; }
        }
#undef G2_CQ
#undef G2_DMAQ
#undef G2_SMALLD
#undef G2_RDIX
#undef G2_RDAF
#undef EV4
#undef OD4
#undef TRR
    }
}
}

namespace pro {
__device__ __forceinline__ void tr_item(const float* W, int ldw, int K, bf16_t* WT, int nblk, int item, LAS float* scr, int lane) {
    const int kb = item / nblk, nb = item % nblk, k0 = 64 * kb, n0 = 32 * nb;
    const int kr = lane >> 3, nq = (lane & 7) * 4;
    f32x4 v[8];
#pragma unroll
    for (int i = 0; i < 8; ++i) v[i] = *(const f32x4*)(W + (size_t)(k0 + 8 * i + kr) * ldw + n0 + nq);
#pragma unroll
    for (int i = 0; i < 8; ++i) { LAS float* d = scr + (8 * i + kr) * 33 + nq; d[0] = v[i][0]; d[1] = v[i][1]; d[2] = v[i][2]; d[3] = v[i][3]; }
    asm volatile("s_waitcnt lgkmcnt(0)" ::: "memory");
    const int c = lane & 7;
#pragma unroll
    for (int j = 0; j < 4; ++j) { const int n = (lane >> 3) + 8 * j; const LAS float* s = scr + (8 * c) * 33 + n;
        u32x4 o; o.x = pk2(s[0 * 33], s[1 * 33]); o.y = pk2(s[2 * 33], s[3 * 33]); o.z = pk2(s[4 * 33], s[5 * 33]); o.w = pk2(s[6 * 33], s[7 * 33]);
        *(u32x4*)(WT + (size_t)(n0 + n) * K + k0 + 8 * c) = o; }
    asm volatile("s_waitcnt lgkmcnt(0)" ::: "memory");
}
__device__ __forceinline__ void tr_item2(const float* W, int ldw, int K, bf16_t* WT, int nblk2, int item, LAS float* scr, int lane) {
    const int kb = item / nblk2, nb = item % nblk2, k0 = 64 * kb, n0 = 64 * nb;
    const int kr = lane >> 3, nq = (lane & 7) * 4, c = lane & 7;
    f32x4 v[2][8];
#pragma unroll
    for (int h = 0; h < 2; ++h)
#pragma unroll
        for (int i = 0; i < 8; ++i) v[h][i] = *(const f32x4*)(W + (size_t)(k0 + 8 * i + kr) * ldw + n0 + 32 * h + nq);
#pragma unroll
    for (int h = 0; h < 2; ++h) {
#pragma unroll
        for (int i = 0; i < 8; ++i) { LAS float* d = scr + (8 * i + kr) * 33 + nq; d[0] = v[h][i][0]; d[1] = v[h][i][1]; d[2] = v[h][i][2]; d[3] = v[h][i][3]; }
        asm volatile("s_waitcnt lgkmcnt(0)" ::: "memory");
#pragma unroll
        for (int j = 0; j < 4; ++j) { const int n = (lane >> 3) + 8 * j; const LAS float* sp = scr + (8 * c) * 33 + n;
            u32x4 o; o.x = pk2(sp[0 * 33], sp[1 * 33]); o.y = pk2(sp[2 * 33], sp[3 * 33]); o.z = pk2(sp[4 * 33], sp[5 * 33]); o.w = pk2(sp[6 * 33], sp[7 * 33]);
            *(u32x4*)(WT + (size_t)(n0 + 32 * h + n) * K + k0 + 8 * c) = o; }
        asm volatile("s_waitcnt lgkmcnt(0)" ::: "memory");
    }
}
__device__ __forceinline__ void cvt_stream(const float* src, bf16_t* dst, size_t n8, size_t gtid, size_t ngt) {
    for (size_t i = gtid; i < n8; i += ngt) { const f32x4 a = ((const f32x4*)src)[2 * i], b = ((const f32x4*)src)[2 * i + 1];
        u32x4 o; o.x = pk2(a[0], a[1]); o.y = pk2(a[2], a[3]); o.z = pk2(b[0], b[1]); o.w = pk2(b[2], b[3]); ((u32x4*)dst)[i] = o; }
}
__device__ __forceinline__ void cvt_sliced(const float* src, bf16_t* dst, size_t gtid, size_t ngt) {
    for (size_t i = gtid; i < (size_t)DEPTH * PEER_N * DM / 8; i += ngt) { const f32x4 a = ((const f32x4*)src)[2 * i], b = ((const f32x4*)src)[2 * i + 1];
        const size_t k8 = i & 255, le = i >> 8, e = le & (PEER_N - 1), l = le >> 14;
        u32x4 o; o.x = pk2(a[0], a[1]); o.y = pk2(a[2], a[3]); o.z = pk2(b[0], b[1]); o.w = pk2(b[2], b[3]);
        *(u32x4*)(dst + (((l * 32 + (k8 >> 3)) * PEER_N + e) * 64 + (k8 & 7) * 8)) = o; }
}
__device__ __forceinline__ void cvt_sliced_fp8(const float* src, unsigned char* dst, float scale, size_t gtid, size_t ngt) {
    const size_t n4 = (size_t)DEPTH * PEER_N * DM / 4;
    for (size_t i0 = gtid; i0 < n4; i0 += 4 * ngt) {
        f32x4 v[4];
#pragma unroll
        for (int u = 0; u < 4; ++u) { const size_t i = i0 + u * ngt; if (i < n4) v[u] = ((const f32x4*)src)[i]; }
#pragma unroll
        for (int u = 0; u < 4; ++u) { const size_t i = i0 + u * ngt; if (i < n4) {
            const size_t k4 = i & 511, le = i >> 9, e = le & (PEER_N - 1), l = le >> 14;
            int w = __builtin_amdgcn_cvt_pk_fp8_f32(clamp8(v[u][0] * scale), clamp8(v[u][1] * scale), 0, false); w = __builtin_amdgcn_cvt_pk_fp8_f32(clamp8(v[u][2] * scale), clamp8(v[u][3] * scale), w, true);
            *(unsigned*)(dst + (((l * 16 + (k4 >> 5)) * PEER_N + e) * 128 + (k4 & 31) * 4)) = (unsigned)w; } }
    }
}
constexpr int I_MIX = 32 * 72, I_GATE = 32 * 128, I_BR = 8 * 32, I_SQ = 32 * 32, I_PW = 2 * 2;
constexpr int I_LAYER = I_MIX + I_GATE + 4 * I_BR + 2 * I_SQ + 4 * I_PW;
constexpr int CVT_CHUNKS = 4096;
constexpr int NTW = I_LAYER + 2 * CVT_CHUNKS;
constexpr int NWG_ITEMS = (NTW + 15) / 16;
__device__ __forceinline__ void cvt_chunk_fp8(const float* src, unsigned char* dst, float scale, size_t g0, int lane) {
    f32x4 v[2][8];
#pragma unroll
    for (int u = 0; u < 8; ++u) v[0][u] = ((const f32x4*)src)[g0 + u * 64 + lane];
#pragma unroll
    for (int b = 0; b < 4; ++b) {
        if (b + 1 < 4) {
#pragma unroll
            for (int u = 0; u < 8; ++u) v[(b + 1) & 1][u] = ((const f32x4*)src)[g0 + (b + 1) * 512 + u * 64 + lane]; }
#pragma unroll
        for (int u = 0; u < 8; ++u) { const size_t i = g0 + b * 512 + u * 64 + lane; const f32x4 x = v[b & 1][u];
            const size_t k4 = i & 511, le = i >> 9, e = le & (PEER_N - 1), l = le >> 14;
            int w = __builtin_amdgcn_cvt_pk_fp8_f32(clamp8(x[0] * scale), clamp8(x[1] * scale), 0, false); w = __builtin_amdgcn_cvt_pk_fp8_f32(clamp8(x[2] * scale), clamp8(x[3] * scale), w, true);
            *(unsigned*)(dst + (((l * 16 + (k4 >> 5)) * PEER_N + e) * 128 + (k4 & 31) * 4)) = (unsigned)w; }
    }
}
__device__ __forceinline__ void conv_wave_item(const Params& p, int l, int w, LAS float* scr, int lane) {
    if (w >= NTW) return;
    if (w >= I_LAYER) { const int c = w - I_LAYER, tbl = c / CVT_CHUNKS, chunk = c % CVT_CHUNKS;
        const size_t g0 = (size_t)l * PEER_N * DM / 4 + (size_t)chunk * 2048;
        if (tbl == 0) cvt_chunk_fp8(p.peer_u, p.uS8, U_SCALE, g0, lane); else cvt_chunk_fp8(p.peer_v, p.vS8, V_SCALE, g0, lane);
        return; }
    int r = w;
    const float* win = p.w_in + (size_t)l * DM * INCOLS; bf16_t* wint = p.WinT + (size_t)l * NIN * DM;
    if (r < I_MIX) { tr_item2(win, INCOLS, DM, wint, 72, r, scr, lane); return; } r -= I_MIX;
    if (r < I_GATE) { tr_item2(win + NMIX + 4, INCOLS, DM, wint + (size_t)NMIX * DM, 128, r, scr, lane); return; } r -= I_GATE;
    if (r < 4 * I_BR) { const int n = r / I_BR; tr_item2(p.w_branch + ((size_t)l * 4 + n) * BWID * DM, DM, BWID, p.WbT + ((size_t)l * 4 + n) * DM * BWID, 32, r % I_BR, scr, lane); return; } r -= 4 * I_BR;
    if (r < I_SQ) { tr_item2(p.w_out + (size_t)l * DM * DM, DM, DM, p.WoT + (size_t)l * DM * DM, 32, r, scr, lane); return; } r -= I_SQ;
    if (r < I_SQ) { tr_item2(p.peer_wq + (size_t)l * DM * DM, DM, DM, p.WqT + (size_t)l * DM * DM, 32, r, scr, lane); return; } r -= I_SQ;
    { const int g = r / I_PW; tr_item2(p.pool_w + ((size_t)l * 4 + g) * 128 * 128, 128, 128, p.poolWT + ((size_t)l * 4 + g) * 128 * 128, 2, r % I_PW, scr, lane); }
}
__device__ __forceinline__ void conv_share(const Params& p, int L, int half, LAS unsigned char* lds) {
    const int tid = ltid(), wid = __builtin_amdgcn_readfirstlane(tid >> 6), lane = tid & 63;
    const int ngw = (int)gridDim.x * NWAVES, gw = lbid() * NWAVES + wid;
    LAS float* scr = (LAS float*)(lds + wid * 16384);
#pragma unroll 1
    for (int w = gw + half * ngw; w < NTW; w += 2 * ngw) conv_wave_item(p, L, w, scr, lane);
}
__device__ __forceinline__ void prologue(const Params& p, int vb, int nvb, LAS unsigned char* lds) {
    const int tid = ltid(), wid = __builtin_amdgcn_readfirstlane(tid >> 6), lane = tid & 63;
    const int gw = vb * NWAVES + wid, ngw = nvb * NWAVES;
    LAS float* scr = (LAS float*)(lds + wid * 16384);
    for (int w = gw; w < NTW; w += ngw) conv_wave_item(p, 0, w, scr, lane);
    const size_t gtid = (size_t)vb * NTHREADS + tid, ngt = (size_t)nvb * NTHREADS;
    cvt_stream(p.peer_keys, p.keysB, (size_t)DEPTH * 8 * 2 * 128 * 128 / 8, gtid, ngt);
    for (size_t i = gtid; i < (size_t)DEPTH * 4 * 128 * 128; i += ngt) { const int s = (int)(i & 127), t = (int)((i >> 7) & 127); p.sguW[i] = (bf16_t)(s <= t ? f2bf(p.sgu_w[i]) : 0u); }
    for (size_t i = gtid; i < (size_t)DEPTH * 4 * DM; i += ngt) { const int k = (int)(i % DM), g = (int)((i / DM) & 3), l = (int)(i / (4 * DM)); p.wfg[i] = p.w_in[((size_t)l * DM + k) * INCOLS + NMIX + g]; }
}
}

#define XB_CW_BAR   4096
#define XB_TMO      128
#define XB_XCNT(j)  (256  + 64 * (j))
#define XB_XSUB(j)  (1280 + 64 * (j))
#define XB_XGEN(j)  (2304 + 64 * (j))
#define XB_TOP      3328
#define XB_TOPGEN   3392
#define XCD_BAR_WORDS 3456
#define XB_SPIN_CAP (1u << 18)
__device__ __forceinline__ unsigned xb_ld(unsigned* p)              { return __hip_atomic_load(p, __ATOMIC_RELAXED, __HIP_MEMORY_SCOPE_AGENT); }
__device__ __forceinline__ unsigned xb_add(unsigned* p, unsigned v) { return __hip_atomic_fetch_add(p, v, __ATOMIC_RELAXED, __HIP_MEMORY_SCOPE_AGENT); }
#define XB_SPIN(cond, bar) do { unsigned _sp = 0; while (cond) { __builtin_amdgcn_s_sleep(1); \
    if ((++_sp & 255u) == 0u) { if (xb_ld(&(bar)[XB_TMO])) break; if (_sp > XB_SPIN_CAP) { atomicAdd(&(bar)[XB_TMO], 1u); break; } } } } while (0)
struct XcdBarrier { unsigned* bar; unsigned x; volatile LAS unsigned* st; };
__device__ __forceinline__ XcdBarrier xcd_barrier_post(unsigned* bar, volatile LAS unsigned* st) {
    XcdBarrier b; b.bar = bar; b.x = xb_xcc_id(); b.st = st;
    if (threadIdx.x == 0) (void)xb_add(&bar[XB_XCNT(b.x)], 1u);
    return b;
}
__device__ __forceinline__ void xcd_barrier_complete(unsigned* bar, unsigned x, unsigned& nloc, unsigned& nx) {
    const unsigned G = gridDim.x * gridDim.y * gridDim.z;
    unsigned sum, cnt, mine, sp = 0u;
    for (;;) {
        sum = 0u; cnt = 0u; mine = 0u;
#pragma unroll
        for (unsigned j = 0; j < 16; ++j) { const unsigned c = xb_ld(&bar[XB_XCNT(j)]); sum += c; cnt += (c > 0u) ? 1u : 0u; mine = (j == x) ? c : mine; }
        if (sum == G) break;
        __builtin_amdgcn_s_sleep(1);
        if ((++sp & 255u) == 0u) { if (xb_ld(&bar[XB_TMO])) break; if (sp > XB_SPIN_CAP) { atomicAdd(&bar[XB_TMO], 1u); break; } }
    }
    nloc = mine > 0u ? mine : 1u; nx = cnt > 0u ? cnt : 1u;
}
__device__ __forceinline__ void xcd_barrier(const XcdBarrier& b) {
    asm volatile("s_waitcnt vmcnt(0)" ::: "memory");
    __syncthreads();
    if (threadIdx.x == 0) {
        const unsigned long long wsv = ((const LAS unsigned long long*)((LAS unsigned char*)b.st - LDS_BARW + LDS_PTAB))[19];
        const unsigned wlo = __builtin_amdgcn_readfirstlane((unsigned)wsv), whi = __builtin_amdgcn_readfirstlane((unsigned)(wsv >> 32));
        unsigned* bar = (unsigned*)(GAS unsigned*)((((unsigned long long)whi << 32) | wlo) + WS_CTL + (size_t)XB_CW_BAR * 4);
        __builtin_amdgcn_s_waitcnt(0);
        unsigned nloc = b.st[0], nx = b.st[1];
        if (nloc == 0u) { xcd_barrier_complete(bar, b.x, nloc, nx); b.st[0] = nloc; b.st[1] = nx; }
        const unsigned old = xb_add(&bar[XB_XSUB(b.x)], 1u);
        const unsigned gen = old / nloc;
        if (old + 1u == (gen + 1u) * nloc) {
            __builtin_amdgcn_fence(__ATOMIC_RELEASE, "agent");
            asm volatile("s_waitcnt vmcnt(0)" ::: "memory");
            const unsigned og = xb_add(&bar[XB_TOP], 1u);
            const unsigned tg = og / nx;
            if (og + 1u == (tg + 1u) * nx) xb_add(&bar[XB_TOPGEN], 1u);
            else XB_SPIN(xb_ld(&bar[XB_TOPGEN]) == tg, bar);
            __builtin_amdgcn_fence(__ATOMIC_ACQUIRE, "agent");
            xb_add(&bar[XB_XGEN(b.x)], 1u);
            asm volatile("s_waitcnt vmcnt(0)" ::: "memory");
        } else {
            XB_SPIN(xb_ld(&bar[XB_XGEN(b.x)]) == gen, bar);
            __builtin_amdgcn_fence(__ATOMIC_ACQUIRE, "agent");
            asm volatile("s_waitcnt vmcnt(0)" ::: "memory");
        }
    }
    __syncthreads();
}

constexpr int NPH_LAYER = 9, NPHASES = 2 + DEPTH * NPH_LAYER;
constexpr int CW_BAR = XB_CW_BAR;


template <class T> __device__ __forceinline__ T* ldptr(const LAS unsigned long long* ptab, int i) {
    const unsigned long long v = ptab[i];
    const unsigned lo = __builtin_amdgcn_readfirstlane((unsigned)v), hi = __builtin_amdgcn_readfirstlane((unsigned)(v >> 32));
    return (T*)(GAS T*)(((unsigned long long)hi << 32) | lo);
}
__device__ __forceinline__ Params mkparams(const LAS unsigned long long* ptab) {
    Params p;
    p.x = ldptr<const float>(ptab, 0); p.norm1_g = ldptr<const float>(ptab, 1); p.w_in = ldptr<const float>(ptab, 2); p.conv_w = ldptr<const float>(ptab, 3);
    p.sgu_norm_g = ldptr<const float>(ptab, 4); p.sgu_w = ldptr<const float>(ptab, 5); p.sgu_b = ldptr<const float>(ptab, 6); p.pool_w = ldptr<const float>(ptab, 7);
    p.pool_scale = ldptr<const float>(ptab, 8); p.forget_b = ldptr<const float>(ptab, 9); p.w_branch = ldptr<const float>(ptab, 10); p.w_out = ldptr<const float>(ptab, 11);
    p.norm2_g = ldptr<const float>(ptab, 12); p.peer_wq = ldptr<const float>(ptab, 13); p.peer_keys = ldptr<const float>(ptab, 14); p.peer_u = ldptr<const float>(ptab, 15);
    p.peer_v = ldptr<const float>(ptab, 16); p.final_g = ldptr<const float>(ptab, 17); p.out = ldptr<float>(ptab, 18);
    unsigned char* ws = ldptr<unsigned char>(ptab, 19);
    p.WinT = (bf16_t*)(ws + WS_WIN); p.WbT = (bf16_t*)(ws + WS_WB); p.WoT = (bf16_t*)(ws + WS_WO); p.WqT = (bf16_t*)(ws + WS_WQ); p.keysB = (bf16_t*)(ws + WS_KEYS);
    p.uS = (bf16_t*)(ws + WS_U); p.vS = (bf16_t*)(ws + WS_V); p.sguW = (bf16_t*)(ws + WS_SGUW); p.poolWT = (bf16_t*)(ws + WS_POOLW);
    p.wfg = (float*)(ws + WS_WFG); p.h = (float*)(ws + WS_H); p.macc = (float*)(ws + WS_MACC); p.flog = (float*)(ws + WS_FLOG); p.F = (float*)(ws + WS_F); p.pgate = (float*)(ws + WS_PGATE);
    p.xn = (bf16_t*)(ws + WS_XN); p.zmix = (bf16_t*)(ws + WS_ZMIX); p.zgate = (unsigned char*)(ws + WS_ZGATE); p.po = (bf16_t*)(ws + WS_MACC); p.br = (bf16_t*)(ws + WS_BR); p.merged = (bf16_t*)(ws + WS_MERGED); p.q = (bf16_t*)(ws + WS_Q);
    p.pidx = (int*)(ws + WS_PIDX); p.ctl = (unsigned*)(ws + WS_CTL); p.pq = (float*)(ws + WS_PQ); p.aB = (bf16_t*)(ws + WS_AB); p.uS8 = (unsigned char*)(ws + WS_U); p.vS8 = (unsigned char*)(ws + WS_V); p.hn8 = (unsigned char*)(ws + WS_HN8); p.aB8 = (unsigned char*)(ws + WS_AB); p.ssqp = (float*)(ws + WS_SSQP); p.rs2 = (float*)(ws + WS_RS2);
    return p;
}

__global__ void __launch_bounds__(NTHREADS, 2) mega(Args a) {
    extern __shared__ __attribute__((aligned(16))) unsigned char lds_raw[];
    LAS unsigned char* lds = (LAS unsigned char*)lds_raw;
    const int tid = threadIdx.x;
    LAS unsigned long long* ptab = (LAS unsigned long long*)(lds + LDS_PTAB);
    if (tid == 0) {
#pragma unroll
        for (int i = 0; i < 18; ++i) ptab[i] = (unsigned long long)a.in[i];
        ptab[18] = (unsigned long long)a.out; ptab[19] = (unsigned long long)a.ws;
    }
    const int G = gridDim.x;
    const int lo = a.ph_lo, hi = a.ph_hi;
    volatile LAS unsigned* barw = (volatile LAS unsigned*)(lds + LDS_BARW);
    if (tid == 0) { barw[0] = 0u; barw[1] = 0u; barw[2] = 0u; barw[3] = 0u; }
    __syncthreads();
    XcdBarrier bar; bar.bar = (unsigned*)(a.ws + WS_CTL) + CW_BAR; bar.x = 0; bar.st = barw;
    if (hi - lo > 1) bar = xcd_barrier_post((unsigned*)(a.ws + WS_CTL) + CW_BAR, barw);
#define PP const Params p = mkparams(ptab); const int tid_ = ltid(), vb = lbid(), wid = __builtin_amdgcn_readfirstlane(tid_ >> 6), lane = tid_ & 63, gw = vb * NWAVES + wid, ngw = G * NWAVES; (void)lane; (void)gw; (void)ngw
#ifndef KMASK
#define KMASK 0xFFFF
#endif
#define KON(b) (((KMASK) >> (b)) & 1)
#ifndef REPEAT_KIND
#define REPEAT_KIND -1
#endif
#define REPS(k) (((REPEAT_KIND) == (k) || ((k) == 3 && ((REPEAT_KIND) >= 13 && (REPEAT_KIND) <= 17))) ? 2 : 1)
#define REPLOOP(k) for (int rep = 0; rep < REPS(k); ++rep, (rep < REPS(k) ? xcd_barrier(bar) : (void)0))
#define IN(k) (lo <= (k) && (k) < hi)
#define SEAM(k) do { if (IN(k) && IN((k) + 1)) xcd_barrier(bar); } while (0)

    if (KON(0) && IN(0)) REPLOOP(0) { PP; pro::prologue(p, vb, G, lds); }
    SEAM(0);
#pragma unroll 1
    for (int l = 0; l < DEPTH; ++l) {
        const int base = 1 + NPH_LAYER * l;
        if (KON(1) && IN(base + 0)) REPLOOP(1) { PP; norm_phase<true>(p, l, l == 0 ? p.x : p.h, l == 0 ? (const bf16_t*)nullptr : p.po, p.norm1_g + (size_t)l * DM, gw, ngw, lane); }
        SEAM(base + 0);
        if (KON(2) && IN(base + 1)) REPLOOP(2) { PP;
            if (vb >= G - 4) cumsum_head(p, vb - (G - 4), lds);
            pg8::Gemm g{p.xn, p.WinT + (size_t)l * NIN * DM, SEQ, NIN, DM, DM, DM}; pg8::StaticOrder S; S.init(SEQ, NIN, G, vb);
            if (G == 256) S.imax = 6;
            pg8::EpiInproj E{p.zmix, p.zgate, p.ctl + CW_KN + l * 16};
            pg8::gemm_phase<pg8::EpiInproj, pg8::StaticOrder>(lds, g, S, E);
        }
        SEAM(base + 1);
        if (IN(base + 2)) REPLOOP(3) { PP;
            volatile LAS unsigned* misc = (volatile LAS unsigned*)(lds + LDS_MISC);
            unsigned* head = p.ctl + CW_MIXQ + (l * 2 + rep) * 64;
            for (;;) {
                __syncthreads();
                if (tid_ == 0) misc[0] = __hip_atomic_fetch_add(head, 1u, __ATOMIC_RELAXED, __HIP_MEMORY_SCOPE_AGENT);
                __syncthreads();
                int it = (int)misc[0];
                const int nleft = (G == 256) ? 64 : 0;
                if (it >= nleft + 128 + 192) break;
                if (it < nleft) { if (KON(2) && rep == 0) {
                    pg8::Gemm g{p.xn, p.WinT + (size_t)l * NIN * DM, SEQ, NIN, DM, DM, DM}; pg8::StaticOrder S; S.init(SEQ, NIN, G, it); S.i0 = 6; S.imax = 7;
                    pg8::EpiInproj E{p.zmix, p.zgate, p.ctl + CW_KN + l * 16};
                    pg8::gemm_phase<pg8::EpiInproj, pg8::StaticOrder>(lds, g, S, E); }
                    continue; }
                it -= nleft;
                if (it < 128) { if (KON(3) && (rep == 0 || (REPEAT_KIND) != 14)) { const int qb = 31 - (it >> 2), g = it & 3;
                    fa::attn_unit(p.zmix, p.F + (size_t)g * SEQ, p.br, g, qb, (__uint_as_float(__hip_atomic_load(p.ctl + CW_KN + l * 16 + g * 4 + 0, __ATOMIC_RELAXED, __HIP_MEMORY_SCOPE_AGENT)) + __uint_as_float(__hip_atomic_load(p.ctl + CW_KN + l * 16 + g * 4 + 1, __ATOMIC_RELAXED, __HIP_MEMORY_SCOPE_AGENT)) + __uint_as_float(__hip_atomic_load(p.ctl + CW_KN + l * 16 + g * 4 + 2, __ATOMIC_RELAXED, __HIP_MEMORY_SCOPE_AGENT)) + __uint_as_float(__hip_atomic_load(p.ctl + CW_KN + l * 16 + g * 4 + 3, __ATOMIC_RELAXED, __HIP_MEMORY_SCOPE_AGENT))), (LAS char*)lds); } }
                else if (KON(4) && (rep == 0 || (REPEAT_KIND) != 13)) { const int k = it - 128, t0 = (k & 63) * 128;
                    if (k < 64) { if (rep == 0 || (REPEAT_KIND) == 14 || (REPEAT_KIND) == 15) mix::sgu_item(p, l, t0, lds); }
                    else if (k < 128) { if (rep == 0 || (REPEAT_KIND) == 14 || (REPEAT_KIND) == 16) mix::pool_item(p, l, t0, lds); }
                    else { if (rep == 0 || (REPEAT_KIND) == 14 || (REPEAT_KIND) == 17) mix::conv_item(p, l, t0); } }
            }
            __syncthreads();
        }
        SEAM(base + 2);
        if (KON(5) && IN(base + 3)) REPLOOP(5) { PP;
            pg8::Gemm g{p.br, p.WbT + (size_t)l * 4 * DM * BWID, SEQ, DM, BWID, DM, BWID}; pg8::MergeOrder S; S.so.init(SEQ, DM, G, vb);
            pg8::EpiMerge E{p.zgate, p.merged};
            pg8::gemm_phase<pg8::EpiMerge, pg8::MergeOrder>(lds, g, S, E);
        }
        SEAM(base + 3);
        if (KON(6) && IN(base + 4)) { PP;
            pg8::Gemm g{p.merged, p.WoT + (size_t)l * DM * DM, SEQ, DM, DM, DM, DM}; pg8::StaticOrder S; S.init(SEQ, DM, G, vb);
            pg8::EpiResNorm E{l == 0 ? p.x : p.h, l == 0 ? (const bf16_t*)nullptr : p.po, p.h, p.norm2_g + (size_t)l * DM, p.xn, p.hn8, p.ssqp};
            pg8::gemm_phase<pg8::EpiResNorm, pg8::StaticOrder>(lds, g, S, E);
        }
        SEAM(base + 4);
        if (KON(8) && IN(base + 5)) REPLOOP(8) { PP;
            pg8::Gemm g{p.xn, p.WqT + (size_t)l * DM * DM, SEQ, DM, DM, DM, DM}; pg8::StaticOrder S; S.init(SEQ, DM, G, vb);
            pg8::Unit u0; int tab_pm = -1;
            LAS float* rstab = (LAS float*)(lds + LDS_RSTAB);
            if (S.next(0, u0)) { tab_pm = u0.pm; const int rr = tid_ >> 1, hf = tid_ & 1, r = u0.pm * 256 + rr;
                const f32x4* pp = (const f32x4*)(p.ssqp + (size_t)r * 32 + hf * 16); float sm = 0.f;
#pragma unroll
                for (int k = 0; k < 4; ++k) { const f32x4 v = pp[k]; sm += v[0]; sm += v[1]; sm += v[2]; sm += v[3]; }
                const float so = __shfl_xor(sm, 1); const float tot = hf ? (so + sm) : (sm + so);
                const float rs = __builtin_amdgcn_rsqf(tot * (1.f / DM) + EPS);
                if (hf == 0) { rstab[rr] = rs; if (u0.pn == 0) p.rs2[r] = rs; } }
            __syncthreads();
            pg8::EpiScaleBf16 E{p.q, DM, p.ssqp, rstab, tab_pm};
            pg8::gemm_phase<pg8::EpiScaleBf16, pg8::StaticOrder>(lds, g, S, E);
            pg8::Unit u;
            for (int ui = 0; S.next(ui, u); ++ui) { __syncthreads(); peer::topk_item(p, l, u.pm * 256, u.pn, lds); peer::topk_item(p, l, u.pm * 256 + 128, u.pn, lds); }
            __syncthreads();
        }
        SEAM(base + 5);
        if (KON(10) && IN(base + 6)) REPLOOP(10) { PP; peer::gather1_phase(p, l, lds, rep); }
        SEAM(base + 6);
        if (KON(10) && IN(base + 7)) REPLOOP(12) { PP; peer::gather_reduce_phase(p, p.rs2, (size_t)vb * NTHREADS + tid_, (size_t)G * NTHREADS); }
        SEAM(base + 7);
        if (KON(10) && IN(base + 8)) REPLOOP(11) { PP; peer::gather2_phase(p, l, lds, rep); }
        SEAM(base + 8);
    }
    if (KON(11) && IN(NPHASES - 1)) { PP; final_norm_phase(p, gw, ngw, lane); }
#undef IN
#undef SEAM
}

extern "C" void kernel_launch(void* const* d_in, const int* in_sizes, int n_in, void* d_out, int out_size, void* d_ws, size_t ws_size, hipStream_t stream) {
    static int grid = 0;
    if (grid == 0) {
        if (n_in != 18 || out_size != SEQ * DM || ws_size < WS_END) { fprintf(stderr, "kernel_launch: unexpected shapes (n_in %d, out %d, ws %zu < %zu)\n", n_in, out_size, ws_size, (size_t)WS_END); grid = -1; return; }
        int dev = 0, cus = 0;
        if (hipGetDevice(&dev) != hipSuccess || hipDeviceGetAttribute(&cus, hipDeviceAttributeMultiprocessorCount, dev) != hipSuccess) { grid = -1; return; }
        if (hipFuncSetAttribute((const void*)mega, hipFuncAttributeMaxDynamicSharedMemorySize, LDS_BYTES) != hipSuccess) { fprintf(stderr, "kernel_launch: hipFuncSetAttribute failed\n"); grid = -1; return; }
        int per_cu = 0;
        if (hipOccupancyMaxActiveBlocksPerMultiprocessor(&per_cu, (const void*)mega, NTHREADS, LDS_BYTES) != hipSuccess || per_cu < 1) fprintf(stderr, "kernel_launch: occupancy query reports %d\n", per_cu);
        (void)hipGetLastError();
        grid = cus;
    }
    if (grid < 0) return;
    unsigned char* ws = (unsigned char*)d_ws;
    (void)hipMemsetAsync(ws + WS_CTL, 0, CTL_BYTES, stream);
    Args a{};
    for (int i = 0; i < 18; ++i) a.in[i] = (const float*)d_in[i];
    a.out = (float*)d_out; a.ws = ws;
#if N_LAUNCH_MODE == 1
    a.ph_lo = 0; a.ph_hi = NPHASES;
    hipLaunchKernelGGL(mega, dim3(grid), dim3(NTHREADS), LDS_BYTES, stream, a);
#else
    for (int ph = 0; ph < NPHASES; ++ph) { a.ph_lo = ph; a.ph_hi = ph + 1; hipLaunchKernelGGL(mega, dim3(grid), dim3(NTHREADS), LDS_BYTES, stream, a); }
#endif
}
```

```cpp
#include <hip/hip_runtime.h>
#include <cstdio>
#include <cstdint>

#define LAS __attribute__((address_space(3)))
#define GAS __attribute__((address_space(1)))
typedef unsigned short bf16_t;
typedef short bf16x8 __attribute__((ext_vector_type(8)));
typedef short s16x4 __attribute__((ext_vector_type(4)));
typedef float f32x2 __attribute__((ext_vector_type(2)));
typedef float f32x4 __attribute__((ext_vector_type(4)));
typedef float f32x16 __attribute__((ext_vector_type(16)));
typedef unsigned u32x2 __attribute__((ext_vector_type(2)));
typedef unsigned u32x4 __attribute__((ext_vector_type(4)));
typedef long i64x2 __attribute__((ext_vector_type(2)));

#ifndef N_LAUNCH_MODE
#define N_LAUNCH_MODE 1
#endif

constexpr int SEQ = 8192, DM = 2048, DEPTH = 4, BWID = 512;
constexpr int NMIX = 4608, NGATE = 8192, NIN = 12800, INCOLS = 12804;
constexpr int PEER_N = 16384;
constexpr float A_SCALE = 64.f;
constexpr float V_SCALE = 16.f;
constexpr float U_SCALE = 64.f;
constexpr int C_A = 0, C_B = 1536, C_C = 2560, C_Q = 3072, C_K = 3584, C_V = 4096;
constexpr float EPS = 1e-6f;
constexpr int NTHREADS = 512, NWAVES = 8;

constexpr size_t al256(size_t x) { return (x + 255) & ~(size_t)255; }
constexpr size_t WS_CTL = 0, CTL_BYTES = 1u << 20;
constexpr size_t WS_WIN = WS_CTL + CTL_BYTES;
constexpr size_t WS_WB = WS_WIN + (size_t)DEPTH * NIN * DM * 2;
constexpr size_t WS_WO = WS_WB + (size_t)DEPTH * 4 * DM * BWID * 2;
constexpr size_t WS_WQ = WS_WO + (size_t)DEPTH * DM * DM * 2;
constexpr size_t WS_KEYS = WS_WQ + (size_t)DEPTH * DM * DM * 2;
constexpr size_t WS_U = WS_KEYS + (size_t)DEPTH * 8 * 2 * 128 * 128 * 2;
constexpr size_t WS_V = WS_U + (size_t)DEPTH * PEER_N * DM * 2;
constexpr size_t WS_SGUW = WS_V + (size_t)DEPTH * PEER_N * DM * 2;
constexpr size_t WS_POOLW = WS_SGUW + (size_t)DEPTH * 4 * 128 * 128 * 2;
constexpr size_t WS_WFG = WS_POOLW + (size_t)DEPTH * 4 * 128 * 128 * 2;
constexpr size_t WS_H = WS_WFG + (size_t)DEPTH * 4 * DM * 4;
constexpr size_t WS_MACC = WS_H + (size_t)SEQ * DM * 4;
constexpr size_t WS_XN = WS_MACC + (size_t)SEQ * DM * 4;
constexpr size_t WS_ZMIX = WS_XN + (size_t)SEQ * DM * 2;
constexpr size_t WS_ZGATE = WS_ZMIX + (size_t)SEQ * NMIX * 2;
constexpr size_t WS_BR = WS_ZGATE + (size_t)SEQ * NGATE * 2;
constexpr size_t WS_MERGED = WS_BR + (size_t)SEQ * DM * 2;
constexpr size_t WS_Q = WS_MERGED + (size_t)SEQ * DM * 2;
constexpr size_t WS_FLOG = WS_Q + (size_t)SEQ * DM * 2;
constexpr size_t WS_F = WS_FLOG + (size_t)SEQ * 4 * 4;
constexpr size_t WS_PIDX = WS_F + (size_t)SEQ * 4 * 4;
constexpr size_t WS_PGATE = WS_PIDX + (size_t)SEQ * 128 * 4;
constexpr size_t WS_PQ = WS_PGATE + (size_t)SEQ * 128 * 4;
constexpr size_t WS_AB = WS_PQ + (size_t)8 * SEQ * 128 * 4;
constexpr size_t WS_HN8 = WS_AB + (size_t)SEQ * 128 * 2;
constexpr size_t WS_SSQP = WS_HN8 + (size_t)SEQ * DM;
constexpr size_t WS_RS2 = WS_SSQP + (size_t)SEQ * 32 * 4;
constexpr size_t WS_END = WS_RS2 + (size_t)SEQ * 4;
static_assert(WS_WB % 256 == 0 && WS_U % 256 == 0 && WS_H % 256 == 0 && WS_ZMIX % 256 == 0 && WS_F % 256 == 0, "ws alignment");

constexpr int LDS_BYTES = 155648;
constexpr int LDS_BARW = LDS_BYTES - 64;

struct Params {
    const float *x, *norm1_g, *w_in, *conv_w, *sgu_norm_g, *sgu_w, *sgu_b, *pool_w, *pool_scale, *forget_b, *w_branch, *w_out, *norm2_g, *peer_wq, *peer_keys, *peer_u, *peer_v, *final_g;
    float* out;
    bf16_t *WinT, *WbT, *WoT, *WqT, *keysB, *uS, *vS, *sguW, *poolWT;
    float *wfg, *h, *macc, *flog, *F, *pgate, *pq;
    bf16_t* aB;
    unsigned char *uS8, *vS8, *hn8, *aB8;
    float *ssqp, *rs2;
    bf16_t *xn, *zmix, *br, *merged, *q;
    bf16_t* po;
    unsigned char* zgate;
    int* pidx;
    unsigned* ctl;
};
struct Args { const float* in[18]; float* out; unsigned char* ws; int ph_lo, ph_hi; };
constexpr int TPW = 16;
constexpr int LDS_PTAB = LDS_BYTES - 256;
constexpr int LDS_RSTAB = 135168;
constexpr int LDS_MISC = LDS_BYTES - 512;
constexpr int CW_MIXQ = 8192;
constexpr int CW_KN = 12288;
constexpr int CW_QCNT = 16384;

__device__ __forceinline__ unsigned f2bf(float f) { unsigned u = __float_as_uint(f); return (u + 0x7fffu + ((u >> 16) & 1u)) >> 16; }
__device__ __forceinline__ unsigned pk2(float lo, float hi) { return f2bf(lo) | (f2bf(hi) << 16); }
__device__ __forceinline__ float bflo(unsigned w) { return __uint_as_float(w << 16); }
__device__ __forceinline__ float bfhi(unsigned w) { return __uint_as_float(w & 0xffff0000u); }
__device__ __forceinline__ float bf1(bf16_t v) { return __uint_as_float((unsigned)v << 16); }
__device__ __forceinline__ unsigned cvtpk(float lo, float hi) { unsigned r; asm volatile("v_cvt_pk_bf16_f32 %0, %1, %2" : "=v"(r) : "v"(lo), "v"(hi)); return r; }
__device__ __forceinline__ float clamp8(float x) { return fminf(fmaxf(x, -448.f), 448.f); }
__device__ __forceinline__ float gelu_t(float x) {
    const float u = x + 0.044715f * x * x * x;
    const float e = __builtin_amdgcn_exp2f(-2.3022081985f * u);
    return x * __builtin_amdgcn_rcpf(1.0f + e);
}
__device__ __forceinline__ float sigmoid_f(float x) { return __builtin_amdgcn_rcpf(1.0f + __builtin_amdgcn_exp2f(-1.4426950409f * x)); }
__device__ __forceinline__ float wave_sum(float v) {
#pragma unroll
    for (int o = 1; o < 64; o <<= 1) v += __shfl_xor(v, o);
    return v;
}
__device__ __forceinline__ unsigned xb_xcc_id() { return (unsigned)__builtin_amdgcn_s_getreg((3 << 11) | 20) & 0xFu; }
__device__ __forceinline__ int ltid() { int t = threadIdx.x; asm volatile("" : "+v"(t)); return t; }
__device__ __forceinline__ int lbid() { int b = blockIdx.x; asm volatile("" : "+s"(b)); return b; }
__device__ __forceinline__ f32x4 mfma16(bf16x8 x, bf16x8 y, f32x4 c) { return __builtin_amdgcn_mfma_f32_16x16x32_bf16(x, y, c, 0, 0, 0); }

namespace pg8 {
constexpr int BM = 256, BK = 64, HALF = 128, HTB = HALF * BK * 2, STAGE_BYTES = 8 * HTB, NXCD = 8, WGM = 8;
__host__ __device__ __forceinline__ int lds_byte(int r, int c) { const int st = (r >> 4) * 2 + (c >> 5), rr = r & 15, cc = c & 31, ob = rr * 64 + cc * 2; return st * 1024 + (ob ^ (((ob >> 9) & 1) << 5)); }
__host__ __device__ __forceinline__ void stage_rc(int b, int& R, int& C) { const int st = b / 1024, sb = b % 1024, swz = sb ^ (((sb >> 9) & 1) << 5); R = (st >> 1) * 16 + swz / 64; C = (st & 1) * 32 + (swz % 64) / 2; }
__host__ __device__ __forceinline__ int perm32(int rho) { const int n = rho >> 4, i = rho & 15; return 8 * (i >> 2) + 4 * n + (i & 3); }

struct Unit { int pm, pn, aco, bro; };
struct Gemm { const bf16_t* A; const bf16_t* Bt; int M, N, K, lda, ldb; };

struct StaticOrder {
    int nM, nN, nwg, G, c, i0, imax;
    __host__ __device__ __forceinline__ void init(int M, int N, int G_, int c_) { nM = M / BM; nN = N / BM; nwg = nM * nN; G = G_; c = c_; i0 = 0; imax = 1 << 30; }
    __host__ __device__ __forceinline__ bool next(int i_, Unit& u) const {
        const int i = i_ + i0; if (i >= imax) return false;
        const long L = (long)i * G + c; if (L >= nwg) return false;
        int wgid = (int)L; { const int q = nwg / NXCD, r = nwg % NXCD, xcd = wgid % NXCD, off = wgid / NXCD; wgid = (xcd < r ? xcd * (q + 1) : r * (q + 1) + (xcd - r) * q) + off; }
        const int nig = WGM * nN, gid = wgid / nig, fm = gid * WGM, gsz = (nM - fm) < WGM ? (nM - fm) : WGM;
        u.pm = fm + ((wgid % nig) % gsz); u.pn = (wgid % nig) / gsz; u.aco = 0; u.bro = 0; return true;
    }
};
struct MergeOrder {
    StaticOrder so;
    __host__ __device__ __forceinline__ bool next(int i, Unit& u) const { if (!so.next(i >> 2, u)) return false; const int n = i & 3; u.aco = n * BWID; u.bro = n * DM; return true; }
};

template <class Epi, class Sched>
__device__ __forceinline__ void gemm_phase(LAS unsigned char* lds, const Gemm g, const Sched& S, const Epi& E) {
    const int tid = ltid(), wid = __builtin_amdgcn_readfirstlane(tid >> 6), lane = tid & 63, wr = wid >> 2, wc = wid & 3, fr = lane & 15, fq = lane >> 4;
    const int K = g.K, nt = K / BK;
    unsigned voffA[2], voffB[2];
#pragma unroll
    for (int i = 0; i < 2; ++i) { int R, C; stage_rc(tid * 16 + i * 8192, R, C); const int Rb = Epi::PERM ? ((R & ~31) + perm32(R & 31)) : R;
        voffA[i] = (unsigned)(R * g.lda + C) * 2u; voffB[i] = (unsigned)(Rb * g.ldb + C) * 2u; }
    const size_t kstep = (size_t)(BK * 2);
    const size_t hstepA = (size_t)HALF * g.lda * 2, hstepB = (size_t)HALF * g.ldb * 2;
    const unsigned ldsw = (unsigned)wid * 1024u;
    const int aoff = lds_byte(wr * 64 + fr, fq * 8), boff = lds_byte(wc * 32 + fr, fq * 8);
#define PG8_UA(u) ((const char*)g.A + ((size_t)(u).pm * BM * g.lda + (size_t)(u).aco) * 2)
#define PG8_UB(u) ((const char*)g.Bt + ((size_t)((u).pn * BM + (u).bro) * g.ldb) * 2)
#define PG8_SA(b, h) (((b) * 2 + (h)) * HTB)
#define PG8_SB(b, h) ((4 + (b) * 2 + (h)) * HTB)
#define PG8_STAGE(bufoff, gbase, voff) do { _Pragma("unroll") for (int _i = 0; _i < 2; ++_i) \
        __builtin_amdgcn_global_load_lds((const unsigned*)((const char*)(gbase) + (voff)[_i]), (LAS unsigned*)(lds + (bufoff) + ldsw + _i * 8192), 16, 0, 0); } while (0)
#define PG8_LDA(dst, b, h) do { _Pragma("unroll") for (int m = 0; m < 4; ++m) _Pragma("unroll") for (int k = 0; k < 2; ++k) dst[m][k] = *(const LAS bf16x8*)(lds + PG8_SA(b, h) + aoff + m * 2048 + k * 1024); } while (0)
#define PG8_LDB(dst, b, h) do { _Pragma("unroll") for (int n = 0; n < 2; ++n) _Pragma("unroll") for (int k = 0; k < 2; ++k) dst[n][k] = *(const LAS bf16x8*)(lds + PG8_SB(b, h) + boff + n * 2048 + k * 1024); } while (0)
#define PG8_MMA(ai, bj, At, Bt) do { __builtin_amdgcn_s_setprio(1); _Pragma("unroll") for (int m = 0; m < 4; ++m) _Pragma("unroll") for (int n = 0; n < 2; ++n) _Pragma("unroll") for (int k = 0; k < 2; ++k) \
        acc[ai][bj][m][n] = __builtin_amdgcn_mfma_f32_16x16x32_bf16(Bt[n][k], At[m][k], acc[ai][bj][m][n], 0, 0, 0); __builtin_amdgcn_s_setprio(0); } while (0)
#define PG8_WAIT_V(n) asm volatile("s_waitcnt vmcnt(" #n ")" ::: "memory")
#define PG8_WAIT_L(n) asm volatile("s_waitcnt lgkmcnt(" #n ")" ::: "memory")
#define PG8_BAR __builtin_amdgcn_s_barrier()
#define PG8_SCHED __builtin_amdgcn_sched_barrier(0)
    Unit cur, nxt; int ui = 0;
    if (!S.next(0, cur)) return;
    f32x4 acc[2][2][4][2];
#pragma unroll
    for (int a = 0; a < 2; ++a)
#pragma unroll
        for (int b = 0; b < 2; ++b)
#pragma unroll
            for (int m = 0; m < 4; ++m)
#pragma unroll
                for (int n = 0; n < 2; ++n) acc[a][b][m][n] = (f32x4){0.f, 0.f, 0.f, 0.f};
    bf16x8 At[4][2], B0[2][2], B1[2][2];
    const char* cA = PG8_UA(cur); const char* cB = PG8_UB(cur);
    PG8_STAGE(PG8_SB(0, 0), cB, voffB); PG8_STAGE(PG8_SB(0, 1), cB + hstepB, voffB); PG8_STAGE(PG8_SA(0, 0), cA, voffA); PG8_STAGE(PG8_SA(0, 1), cA + hstepA, voffA);
    if (wr == 1) PG8_BAR;
    PG8_WAIT_V(2); PG8_BAR;
    PG8_STAGE(PG8_SB(1, 0), cB + kstep, voffB); PG8_STAGE(PG8_SA(1, 0), cA + kstep, voffA); PG8_STAGE(PG8_SB(1, 1), cB + hstepB + kstep, voffB);
    PG8_WAIT_V(6); PG8_BAR;
    for (;;) {
        const bool has_next = S.next(ui + 1, nxt);
        const char* nA = has_next ? PG8_UA(nxt) : cA; const char* nB = has_next ? PG8_UB(nxt) : cB;
        for (int t = 0; t < nt; t += 2) {
            const bool last = (t == nt - 2);
            const char* a1 = cA + (size_t)(t + 1) * kstep;
            const char* a2 = last ? nA : cA + (size_t)(t + 2) * kstep; const char* b2 = last ? nB : cB + (size_t)(t + 2) * kstep;
            const char* a3 = a2 + kstep; const char* b3 = b2 + kstep;
            PG8_LDB(B0, 0, 0); PG8_LDB(B1, 0, 1); PG8_SCHED; PG8_LDA(At, 0, 0); PG8_STAGE(PG8_SA(1, 1), a1 + hstepA, voffA);
            PG8_WAIT_V(8); PG8_WAIT_L(0); PG8_BAR; PG8_MMA(0, 0, At, B0); PG8_MMA(0, 1, At, B1); PG8_BAR; PG8_SCHED;
            PG8_LDA(At, 0, 1); PG8_STAGE(PG8_SB(0, 0), b2, voffB); PG8_STAGE(PG8_SB(0, 1), b2 + hstepB, voffB); PG8_STAGE(PG8_SA(0, 0), a2, voffA);
            PG8_WAIT_V(8); PG8_WAIT_L(0); PG8_BAR; PG8_MMA(1, 0, At, B0); PG8_MMA(1, 1, At, B1); PG8_BAR; PG8_SCHED;
            PG8_LDB(B0, 1, 0); PG8_LDB(B1, 1, 1); PG8_SCHED; PG8_LDA(At, 1, 0); PG8_STAGE(PG8_SA(0, 1), a2 + hstepA, voffA);
            PG8_WAIT_V(8); PG8_WAIT_L(0); PG8_BAR; PG8_MMA(0, 0, At, B0); PG8_MMA(0, 1, At, B1); PG8_BAR; PG8_SCHED;
            PG8_LDA(At, 1, 1); PG8_STAGE(PG8_SB(1, 0), b3, voffB); PG8_STAGE(PG8_SB(1, 1), b3 + hstepB, voffB); PG8_STAGE(PG8_SA(1, 0), a3, voffA);
            PG8_WAIT_V(8); PG8_WAIT_L(0); PG8_BAR; PG8_MMA(1, 0, At, B0); PG8_MMA(1, 1, At, B1); PG8_BAR; PG8_SCHED;
        }
        if (wr == 0) PG8_BAR;
        bool keep = false;
        if constexpr (Epi::HORNER) keep = E.scale(acc, cur, wr, wc, fr, fq); else E(acc, cur, wr, wc, fr, fq);
        if (!has_next) break;
        if (!keep) {
#pragma unroll
        for (int a = 0; a < 2; ++a)
#pragma unroll
            for (int b = 0; b < 2; ++b)
#pragma unroll
                for (int m = 0; m < 4; ++m)
#pragma unroll
                    for (int n = 0; n < 2; ++n) acc[a][b][m][n] = (f32x4){0.f, 0.f, 0.f, 0.f};
        }
        cur = nxt; cA = nA; cB = nB; ++ui;
        if (wr == 1) PG8_BAR;
    }
    PG8_WAIT_V(0);
    PG8_BAR;
#undef PG8_UA
#undef PG8_UB
#undef PG8_SA
#undef PG8_SB
#undef PG8_STAGE
#undef PG8_LDA
#undef PG8_LDB
#undef PG8_MMA
#undef PG8_WAIT_V
#undef PG8_WAIT_L
#undef PG8_BAR
#undef PG8_SCHED
}

__device__ __forceinline__ size_t gate_off(int row, int gcol) { return ((size_t)(row >> 4) * (NGATE / 32) + (size_t)(gcol >> 5)) * 512 + (size_t)((row & 15) * 32 + (gcol & 31)); }
struct EpiInproj {
    static constexpr bool PERM = true; static constexpr bool HORNER = false;
    bf16_t* zmix; unsigned char* zgate; unsigned* kn;
    __device__ __forceinline__ void operator()(const f32x4 (&acc)[2][2][4][2], const Unit& u, int wr, int wc, int fr, int fq) const {
        if (u.pn == C_K / BM || u.pn == C_K / BM + 1) {
#pragma unroll
            for (int bj = 0; bj < 2; ++bj) { float mx = 0.f;
#pragma unroll
                for (int ai = 0; ai < 2; ++ai)
#pragma unroll
                    for (int m = 0; m < 4; ++m) { const f32x4 a = acc[ai][bj][m][0], b = acc[ai][bj][m][1];
                        float q2 = (a[0] * a[0] + a[1] * a[1]) + (a[2] * a[2] + a[3] * a[3]) + (b[0] * b[0] + b[1] * b[1]) + (b[2] * b[2] + b[3] * b[3]);
                        q2 += __shfl_xor(q2, 16); q2 += __shfl_xor(q2, 32); mx = fmaxf(mx, q2); }
#pragma unroll
                for (int o = 1; o < 16; o <<= 1) mx = fmaxf(mx, __shfl_xor(mx, o));
                if ((threadIdx.x & 63) == 0) atomicMax(kn + ((u.pn - C_K / BM) * 2 + bj) * 4 + wc, __float_as_uint(mx)); }
        }
        const int row0 = u.pm * BM + wr * 64 + fr; int colt = u.pn * BM; const bool gate = colt >= NMIX;
        if (gate) {
            const int col0 = colt - NMIX + wc * 32 + 8 * fq;
#pragma unroll
            for (int ai = 0; ai < 2; ++ai)
#pragma unroll
                for (int m = 0; m < 4; ++m) { const int grow = row0 + ai * HALF + m * 16;
#pragma unroll
                    for (int bj = 0; bj < 2; ++bj) { const f32x4 v0 = acc[ai][bj][m][0], v1 = acc[ai][bj][m][1]; unsigned w0 = 0u, w1 = 0u;
#pragma unroll
                        for (int e = 0; e < 4; ++e) { w0 = __builtin_amdgcn_cvt_pk_u8_f32(__builtin_truncf(sigmoid_f(v0[e]) * 255.f + 0.5f), e, w0);
                                                      w1 = __builtin_amdgcn_cvt_pk_u8_f32(__builtin_truncf(sigmoid_f(v1[e]) * 255.f + 0.5f), e, w1); }
                        *(u32x2*)(zgate + gate_off(grow, col0 + bj * HALF)) = (u32x2){w0, w1}; } }
            return;
        }
        bf16_t* base = zmix; const int ldc = NMIX;
        const int col0 = colt + wc * 32 + 8 * fq;
#pragma unroll
        for (int ai = 0; ai < 2; ++ai)
#pragma unroll
            for (int m = 0; m < 4; ++m) { bf16_t* rowp = base + (size_t)(row0 + ai * HALF + m * 16) * ldc + col0;
#pragma unroll
                for (int bj = 0; bj < 2; ++bj) { const f32x4 v0 = acc[ai][bj][m][0], v1 = acc[ai][bj][m][1];
                    u32x4 w; w.x = cvtpk(v0[0], v0[1]); w.y = cvtpk(v0[2], v0[3]); w.z = cvtpk(v1[0], v1[1]); w.w = cvtpk(v1[2], v1[3]);
                    *(u32x4*)(rowp + bj * HALF) = w; } }
    }
};
struct EpiBf16 {
    static constexpr bool PERM = true; static constexpr bool HORNER = false;
    bf16_t* O; int ldc;
    __device__ __forceinline__ void operator()(const f32x4 (&acc)[2][2][4][2], const Unit& u, int wr, int wc, int fr, int fq) const {
        const int row0 = u.pm * BM + wr * 64 + fr; const int col0 = u.pn * BM + wc * 32 + 8 * fq;
#pragma unroll
        for (int ai = 0; ai < 2; ++ai)
#pragma unroll
            for (int m = 0; m < 4; ++m) { bf16_t* rowp = O + (size_t)(row0 + ai * HALF + m * 16) * ldc + col0;
#pragma unroll
                for (int bj = 0; bj < 2; ++bj) { const f32x4 v0 = acc[ai][bj][m][0], v1 = acc[ai][bj][m][1];
                    u32x4 w; w.x = cvtpk(v0[0], v0[1]); w.y = cvtpk(v0[2], v0[3]); w.z = cvtpk(v1[0], v1[1]); w.w = cvtpk(v1[2], v1[3]);
                    *(u32x4*)(rowp + bj * HALF) = w; } }
    }
};
struct EpiMerge {
    static constexpr bool PERM = true; static constexpr bool HORNER = true;
    const unsigned char* G; bf16_t* merged;
    __device__ __forceinline__ bool scale(f32x4 (&acc)[2][2][4][2], const Unit& u, int wr, int wc, int fr, int fq) const {
        const int n = u.aco >> 9; const int col0 = u.pn * BM + wc * 32 + 8 * fq; const bool last = (n == 3);
#pragma unroll
        for (int ai = 0; ai < 2; ++ai) {
            u32x2 gw[4][2], gx[4][2];
#pragma unroll
            for (int m = 0; m < 4; ++m) { const int r = u.pm * BM + ai * HALF + wr * 64 + m * 16 + fr;
#pragma unroll
                for (int bj = 0; bj < 2; ++bj) { const int c = col0 + bj * HALF;
                    gw[m][bj] = *(const u32x2*)(G + gate_off(r, n * DM + c));
                    gx[m][bj] = last ? gw[m][bj] : *(const u32x2*)(G + gate_off(r, (n + 1) * DM + c)); } }
#pragma unroll
            for (int m = 0; m < 4; ++m) { const int r = u.pm * BM + ai * HALF + wr * 64 + m * 16 + fr;
#pragma unroll
                for (int bj = 0; bj < 2; ++bj) { const int c = col0 + bj * HALF; const u32x2 g = gw[m][bj], x = gx[m][bj];
                    f32x4 v0 = acc[ai][bj][m][0], v1 = acc[ai][bj][m][1];
#pragma unroll
                    for (int e = 0; e < 4; ++e) {
                        const float k0 = fmaxf((float)((g.x >> (8 * e)) & 0xffu), 1.f), k1 = fmaxf((float)((g.y >> (8 * e)) & 0xffu), 1.f);
                        const float d0 = last ? (1.f / 255.f) : __builtin_amdgcn_rcpf(fmaxf((float)((x.x >> (8 * e)) & 0xffu), 1.f));
                        const float d1 = last ? (1.f / 255.f) : __builtin_amdgcn_rcpf(fmaxf((float)((x.y >> (8 * e)) & 0xffu), 1.f));
                        v0[e] *= k0 * d0; v1[e] *= k1 * d1; }
                    if (last) { u32x4 w; w.x = cvtpk(v0[0], v0[1]); w.y = cvtpk(v0[2], v0[3]); w.z = cvtpk(v1[0], v1[1]); w.w = cvtpk(v1[2], v1[3]);
                        *(u32x4*)(merged + (size_t)r * DM + c) = w; }
                    else { acc[ai][bj][m][0] = v0; acc[ai][bj][m][1] = v1; } } }
        }
        return !last;
    }
};
struct EpiResNorm {
    static constexpr bool PERM = true; static constexpr bool HORNER = false;
    const float* base; const bf16_t* po; float* h; const float* gain; bf16_t* xn; unsigned char* hn8; float* part;
    __device__ __forceinline__ void operator()(const f32x4 (&acc)[2][2][4][2], const Unit& u, int wr, int wc, int fr, int fq) const {
        const int col0 = u.pn * BM + wc * 32 + 8 * fq;
        f32x4 gv[2][2];
#pragma unroll
        for (int bj = 0; bj < 2; ++bj) { gv[bj][0] = *(const f32x4*)(gain + col0 + bj * HALF); gv[bj][1] = *(const f32x4*)(gain + col0 + bj * HALF + 4); }
#pragma unroll
        for (int ai = 0; ai < 2; ++ai)
#pragma unroll
            for (int mp2 = 0; mp2 < 2; ++mp2) {
                f32x4 bv[2][2][2]; u32x4 pv[2][2];
#pragma unroll
                for (int mm = 0; mm < 2; ++mm) { const int r = u.pm * BM + ai * HALF + wr * 64 + (mp2 * 2 + mm) * 16 + fr;
#pragma unroll
                    for (int bj = 0; bj < 2; ++bj) { const f32x4* bp = (const f32x4*)(base + (size_t)r * DM + col0 + bj * HALF); bv[mm][bj][0] = bp[0]; bv[mm][bj][1] = bp[1];
                        pv[mm][bj] = (u32x4){0u, 0u, 0u, 0u}; if (po) pv[mm][bj] = *(const u32x4*)(po + (size_t)r * DM + col0 + bj * HALF); } }
#pragma unroll
                for (int mm = 0; mm < 2; ++mm) { const int m = mp2 * 2 + mm; const int r = u.pm * BM + ai * HALF + wr * 64 + m * 16 + fr; float q2 = 0.f;
#pragma unroll
                    for (int bj = 0; bj < 2; ++bj) { const size_t off = (size_t)r * DM + col0 + bj * HALF; const u32x4 pw_ = pv[mm][bj];
                        const f32x4 v0 = bv[mm][bj][0] + acc[ai][bj][m][0] + (f32x4){bflo(pw_.x), bfhi(pw_.x), bflo(pw_.y), bfhi(pw_.y)}, v1 = bv[mm][bj][1] + acc[ai][bj][m][1] + (f32x4){bflo(pw_.z), bfhi(pw_.z), bflo(pw_.w), bfhi(pw_.w)};
                        f32x4* hp = (f32x4*)(h + off); hp[0] = v0; hp[1] = v1;
                        q2 += (v0[0] * v0[0] + v0[1] * v0[1]) + (v0[2] * v0[2] + v0[3] * v0[3]) + (v1[0] * v1[0] + v1[1] * v1[1]) + (v1[2] * v1[2] + v1[3] * v1[3]);
                        const f32x4 y0 = v0 * gv[bj][0], y1 = v1 * gv[bj][1];
                        u32x4 w; w.x = cvtpk(y0[0], y0[1]); w.y = cvtpk(y0[2], y0[3]); w.z = cvtpk(y1[0], y1[1]); w.w = cvtpk(y1[2], y1[3]);
                        *(u32x4*)(xn + off) = w;
                        int f0 = __builtin_amdgcn_cvt_pk_fp8_f32(clamp8(y0[0]), clamp8(y0[1]), 0, false); f0 = __builtin_amdgcn_cvt_pk_fp8_f32(clamp8(y0[2]), clamp8(y0[3]), f0, true);
                        int f1 = __builtin_amdgcn_cvt_pk_fp8_f32(clamp8(y1[0]), clamp8(y1[1]), 0, false); f1 = __builtin_amdgcn_cvt_pk_fp8_f32(clamp8(y1[2]), clamp8(y1[3]), f1, true);
                        *(u32x2*)(hn8 + off) = (u32x2){(unsigned)f0, (unsigned)f1}; }
                    q2 += __shfl_xor(q2, 16); q2 += __shfl_xor(q2, 32);
                    if (fq == 0) part[(size_t)r * 32 + u.pn * 4 + wc] = q2; }
            }
    }
};
__device__ __forceinline__ float row_rs(const float* part, int r) {
    const f32x4* pp = (const f32x4*)(part + (size_t)r * 32); float s = 0.f;
#pragma unroll
    for (int k = 0; k < 8; ++k) { const f32x4 v = pp[k]; s += v[0]; s += v[1]; s += v[2]; s += v[3]; }
    return __builtin_amdgcn_rsqf(s * (1.f / DM) + EPS);
}
struct EpiScaleBf16 {
    static constexpr bool PERM = true; static constexpr bool HORNER = false;
    bf16_t* O; int ldc; const float* part; const LAS float* rstab; int tab_pm;
    __device__ __forceinline__ void operator()(const f32x4 (&acc)[2][2][4][2], const Unit& u, int wr, int wc, int fr, int fq) const {
        const int row0 = u.pm * BM + wr * 64 + fr; const int col0 = u.pn * BM + wc * 32 + 8 * fq;
#pragma unroll
        for (int ai = 0; ai < 2; ++ai)
#pragma unroll
            for (int m = 0; m < 4; ++m) { const int r = row0 + ai * HALF + m * 16; bf16_t* rowp = O + (size_t)r * ldc + col0;
                const float rs = (u.pm == tab_pm) ? rstab[r - u.pm * BM] : row_rs(part, r);
#pragma unroll
                for (int bj = 0; bj < 2; ++bj) { const f32x4 v0 = acc[ai][bj][m][0] * rs, v1 = acc[ai][bj][m][1] * rs;
                    u32x4 w; w.x = cvtpk(v0[0], v0[1]); w.y = cvtpk(v0[2], v0[3]); w.z = cvtpk(v1[0], v1[1]); w.w = cvtpk(v1[2], v1[3]);
                    *(u32x4*)(rowp + bj * HALF) = w; } }
    }
};
}

namespace fa {
constexpr float SCALE = 0.08838834764831845f, INV_SCALE = 11.313708498984761f, THR = 8.f;
constexpr int QBLK = 32, KVBLK = 64, QB = 256;
constexpr int SHM_V = KVBLK * 128 * 2, SHM_K = KVBLK * 128 * 2;
constexpr int OFF_V = 0, OFF_K = 2 * SHM_V, OFF_FK = OFF_K + 2 * SHM_K, OFF_WS = OFF_FK + 2 * 64 * 4;
#define KSWZ(row, colB) ((row) * 256 + ((colB) ^ (((row) & 7) << 4)))
#define SBAR() __builtin_amdgcn_sched_barrier(0)
__device__ __forceinline__ int v_st(int k, int c) { const int kk = (k & ~0xC) | ((k & 4) << 1) | ((k & 8) >> 1); return ((kk >> 3) * 4 + (c >> 5)) * 512 + ((kk & 7) * 32 + (c & 31)) * 2; }
__device__ __forceinline__ int v_rd_base(int lane) { return ((lane & 3) << 3) | (((lane >> 2) & 3) << 6) | (((lane >> 4) & 1) << 5) | (((lane >> 5) & 1) << 8); }
constexpr int v_rd_off(int d0, int ks, int half) { return d0 * 512 + ks * 4096 + half * 2048; }
__device__ __forceinline__ int crow(int r, int hi) { return (r & 3) + 8 * (r >> 2) + 4 * hi; }
__device__ __forceinline__ void mask_tile(f32x16& p0, f32x16& p1, int dq) {
    const float NEG = -__builtin_inff();
#pragma unroll
    for (int r = 0; r < 16; ++r) {
        const int c = (r & 3) + 8 * (r >> 2);
        if (dq - c < 0) p0[r] = NEG;
        if (dq - c - 32 < 0) p1[r] = NEG;
    }
}
__device__ __forceinline__ void partialSM(f32x16& p0, f32x16& p1, float& m_reg, float& mn, float& alpha) {
    float pmax = p0[0];
#pragma unroll
    for (int r = 1; r < 16; ++r) pmax = fmaxf(pmax, p0[r]);
#pragma unroll
    for (int r = 0; r < 16; ++r) pmax = fmaxf(pmax, p1[r]);
    { auto rr = __builtin_amdgcn_permlane32_swap(__float_as_uint(pmax), __float_as_uint(pmax), false, false);
      pmax = fmaxf(__uint_as_float(rr[0]), __uint_as_float(rr[1])); }
    constexpr float C2 = 1.4426950408889634f * SCALE;
    if (__builtin_expect(__all((pmax - m_reg) * SCALE <= THR), 1)) { mn = m_reg; alpha = 1.f; }
    else { mn = fmaxf(m_reg, pmax); alpha = __builtin_amdgcn_exp2f((m_reg - mn) * C2); m_reg = mn; }
    const float mnL = -mn * C2;
#pragma unroll
    for (int r = 0; r < 16; ++r) p0[r] = fmaf(p0[r], C2, mnL);
#pragma unroll
    for (int r = 0; r < 16; ++r) p1[r] = fmaf(p1[r], C2, mnL);
#pragma unroll
    for (int r = 0; r < 16; ++r) p0[r] = __builtin_amdgcn_exp2f(p0[r]);
}
__device__ __forceinline__ void finishSM(f32x16& p0, f32x16& p1, float alpha, float& l_reg, bf16x8& pa0, bf16x8& pa1, bf16x8& pa2, bf16x8& pa3) {
#pragma unroll
    for (int r = 0; r < 16; ++r) p1[r] = __builtin_amdgcn_exp2f(p1[r]);
    float ps = 0;
#pragma unroll
    for (int r = 0; r < 16; ++r) ps += p0[r];
#pragma unroll
    for (int r = 0; r < 16; ++r) ps += p1[r];
    { auto rr = __builtin_amdgcn_permlane32_swap(__float_as_uint(ps), __float_as_uint(ps), false, false);
      ps = __uint_as_float(rr[0]) + __uint_as_float(rr[1]); }
    l_reg = l_reg * alpha + ps;
#define PK4(P, B_, OUT) do { unsigned a0 = cvtpk(P[B_+0], P[B_+1]), a1 = cvtpk(P[B_+2], P[B_+3]);                          \
        unsigned b0 = cvtpk(P[B_+4], P[B_+5]), b1 = cvtpk(P[B_+6], P[B_+7]);                                             \
        auto r0 = __builtin_amdgcn_permlane32_swap(a0, b0, false, false); auto r1 = __builtin_amdgcn_permlane32_swap(a1, b1, false, false); \
        u32x4 w = {r0[0], r1[0], r0[1], r1[1]}; OUT = *reinterpret_cast<bf16x8*>(&w); } while (0)
    PK4(p0, 0, pa0); PK4(p0, 8, pa1); PK4(p1, 0, pa2); PK4(p1, 8, pa3);
#undef PK4
}
__device__ __forceinline__ void qkt(f32x16& p0, f32x16& p1, const LAS char* kbuf, const LAS float* fk, float Fq, int r32, int hi, const bf16x8* qr) {
#pragma unroll
    for (int a = 0; a < 4; ++a) { const f32x4 f0 = *(const LAS f32x4*)(fk + 8 * a + 4 * hi), f1 = *(const LAS f32x4*)(fk + 32 + 8 * a + 4 * hi);
#pragma unroll
        for (int b = 0; b < 4; ++b) { p0[4 * a + b] = (Fq - f0[b]) * INV_SCALE; p1[4 * a + b] = (Fq - f1[b]) * INV_SCALE; } }
    const LAS char* kb[4];
#pragma unroll
    for (int dd = 0; dd < 4; ++dd) kb[dd] = kbuf + KSWZ(r32, (dd * 16 + hi * 8) * 2);
#pragma unroll
    for (int d0 = 0; d0 < 8; ++d0) { const LAS char* a = kb[d0 & 3] + (d0 >> 2) * 128;
        bf16x8 b0 = *reinterpret_cast<const LAS bf16x8*>(a);
        bf16x8 b1 = *reinterpret_cast<const LAS bf16x8*>(a + 32 * 256);
        p0 = __builtin_amdgcn_mfma_f32_32x32x16_bf16(b0, qr[d0], p0, 0, 0, 0);
        p1 = __builtin_amdgcn_mfma_f32_32x32x16_bf16(b1, qr[d0], p1, 0, 0, 0); }
}
__device__ __forceinline__ void pv_tile(f32x16* o, int vb0, bf16x8 pa0, bf16x8 pa1, bf16x8 pa2, bf16x8 pa3) {
#define TRRD(dst, off) asm volatile("ds_read_b64_tr_b16 %0, %1 offset:%2" : "=&v"(dst) : "v"(vb0), "i"(off) : "memory")
#define PV_D0(d0) do { s16x4 l0, l1, l2, l3, h0, h1, h2, h3; constexpr int b_ = v_rd_off(d0, 0, 0); \
        TRRD(l0, b_); TRRD(h0, b_ + 2048); TRRD(l1, b_ + 4096); TRRD(h1, b_ + 6144); TRRD(l2, b_ + 8192); TRRD(h2, b_ + 10240); TRRD(l3, b_ + 12288); TRRD(h3, b_ + 14336); \
        asm volatile("s_waitcnt lgkmcnt(0)" ::: "memory"); SBAR();   \
        o[d0] = __builtin_amdgcn_mfma_f32_32x32x16_bf16(pa0, (bf16x8){l0[0], l0[1], l0[2], l0[3], h0[0], h0[1], h0[2], h0[3]}, o[d0], 0, 0, 0);   \
        o[d0] = __builtin_amdgcn_mfma_f32_32x32x16_bf16(pa1, (bf16x8){l1[0], l1[1], l1[2], l1[3], h1[0], h1[1], h1[2], h1[3]}, o[d0], 0, 0, 0);   \
        o[d0] = __builtin_amdgcn_mfma_f32_32x32x16_bf16(pa2, (bf16x8){l2[0], l2[1], l2[2], l2[3], h2[0], h2[1], h2[2], h2[3]}, o[d0], 0, 0, 0);   \
        o[d0] = __builtin_amdgcn_mfma_f32_32x32x16_bf16(pa3, (bf16x8){l3[0], l3[1], l3[2], l3[3], h3[0], h3[1], h3[2], h3[3]}, o[d0], 0, 0, 0); } while (0)
    PV_D0(0); PV_D0(1); PV_D0(2); PV_D0(3);
#undef PV_D0
#undef TRRD
}
__device__ __forceinline__ void attn_unit(const bf16_t* __restrict__ zmix, const float* __restrict__ Fh, bf16_t* __restrict__ br, int g, int qb, float kn2, LAS char* lds) {
    const int tid = ltid(), wid = __builtin_amdgcn_readfirstlane(tid >> 6), lane = tid & 63, r32 = lane & 31, hi = lane >> 5;
    const bf16_t* Zq = zmix + C_Q + g * 128; const bf16_t* Zk = zmix + C_K + g * 128; const bf16_t* Zv = zmix + C_V + g * 128;
    const int P0 = qb * QB, j_hi = (P0 + QB) / KVBLK;
    const int qlo = P0 + wid * QBLK, qm = qlo + r32 - 4 * hi;
    LAS char* V_lds = lds + OFF_V; LAS char* K_lds = lds + OFF_K; LAS float* FK_lds = (LAS float*)(lds + OFF_FK);
    LAS float* wsf = (LAS float*)(lds + OFF_WS) + wid * 64; LAS float* li_l = wsf; LAS float* al_l = wsf + 32;
    bf16x8 qr[8];
#pragma unroll
    for (int d0 = 0; d0 < 8; ++d0) qr[d0] = *(const bf16x8*)(Zq + (size_t)(qlo + r32) * NMIX + d0 * 16 + hi * 8);
    const float Fq = Fh[qlo + r32];
    int j_lo; float qrow2;
    {
        float qs = 0.f;
#pragma unroll
        for (int d0 = 0; d0 < 8; ++d0)
#pragma unroll
            for (int e = 0; e < 8; ++e) { const float v = bf1((bf16_t)qr[d0][e]); qs = fmaf(v, v, qs); }
        { auto rr = __builtin_amdgcn_permlane32_swap(__float_as_uint(qs), __float_as_uint(qs), false, false); qs = __uint_as_float(rr[0]) + __uint_as_float(rr[1]); }
        qrow2 = qs;
#pragma unroll
        for (int o_ = 1; o_ < 32; o_ <<= 1) qs = fmaxf(qs, __shfl_xor(qs, o_));
        LAS float* red = (LAS float*)(lds + OFF_WS);
        __syncthreads();
        if (lane == 0) red[wid] = qs;
        __syncthreads();
        float qn2 = red[0];
#pragma unroll
        for (int w = 1; w < 8; ++w) qn2 = fmaxf(qn2, red[w]);
        const float B2 = 2.f * sqrtf(qn2 * kn2) * SCALE * 1.01f + 0.5f;
        const float thr = -18.f - B2 - Fh[P0];
        const int ndiag0 = P0 / KVBLK;
        int cntskip = 0;
        if (tid < 128) { const bool sk = (tid < ndiag0) && (-Fh[tid * KVBLK + KVBLK - 1] < thr); const unsigned long long bal = __ballot(sk); cntskip = __popcll(bal); }
        __syncthreads();
        if (tid == 0 || tid == 64) red[8 + (tid >> 6)] = (float)cntskip;
        __syncthreads();
        j_lo = (int)(red[8] + red[9]);
        __syncthreads();
    }
    float m_reg = -1e30f, l_reg = 0.f; f32x16 o[4];
#pragma unroll
    for (int d = 0; d < 4; ++d)
#pragma unroll
        for (int r = 0; r < 16; ++r) o[d][r] = 0.f;
    const int sr = tid >> 4, sc = (tid & 15) * 8, vst0 = v_st(sr, sc), vst1 = v_st(32 + sr, sc), kws = KSWZ(sr, sc * 2);
    const int vbase = (int)(uintptr_t)V_lds + v_rd_base(lane);
    bf16x8 st_k0, st_k1, st_v0, st_v1; float st_f = 0.f;
#define SLOAD(kb) do { st_k0 = *(const bf16x8*)(Zk + (size_t)((kb) + sr) * NMIX + sc); st_k1 = *(const bf16x8*)(Zk + (size_t)((kb) + 32 + sr) * NMIX + sc); \
                       st_v0 = *(const bf16x8*)(Zv + (size_t)((kb) + sr) * NMIX + sc); st_v1 = *(const bf16x8*)(Zv + (size_t)((kb) + 32 + sr) * NMIX + sc); \
                       if (tid < 64) st_f = Fh[(kb) + tid]; } while (0)
#define SWRITE(bf) do { *(LAS bf16x8*)(K_lds + (bf) * SHM_K + kws) = st_k0; *(LAS bf16x8*)(K_lds + (bf) * SHM_K + kws + 32 * 256) = st_k1; \
                        *(LAS bf16x8*)(V_lds + (bf) * SHM_V + vst0) = st_v0; *(LAS bf16x8*)(V_lds + (bf) * SHM_V + vst1) = st_v1; \
                        if (tid < 64) FK_lds[(bf) * 64 + tid] = st_f; } while (0)
    const float cbase = -(sqrtf(qrow2 * kn2) * SCALE * 1.01f + 0.25f) - Fq;
    LAS float* stopm = (LAS float*)(lds + OFF_WS + 2048);
    __syncthreads();
    int j = j_hi - 1;
    SLOAD(j * KVBLK); SWRITE(0);
    __syncthreads();
    f32x16 p0, p1; float mn, alpha; bf16x8 pa0, pa1, pa2, pa3;
    for (int t = 0;; ++t) {
        const int buf = t & 1, kb = j * KVBLK; const bool has_next = j > j_lo;
        if (has_next) SLOAD(kb - KVBLK);
        if (kb <= qlo + QBLK - 1) {
            qkt(p0, p1, K_lds + buf * SHM_K, FK_lds + buf * 64, Fq, r32, hi, qr);
            if (kb + KVBLK - 1 > qlo) mask_tile(p0, p1, qm - kb);
            partialSM(p0, p1, m_reg, mn, alpha);
            if (__any(alpha < 1.f)) { if (hi == 0) al_l[r32] = alpha; asm volatile("s_waitcnt lgkmcnt(0)" ::: "memory");
#pragma unroll
                for (int d_ = 0; d_ < 4; ++d_)
#pragma unroll
                    for (int r = 0; r < 16; ++r) o[d_][r] *= al_l[crow(r, hi)]; }
            finishSM(p0, p1, alpha, l_reg, pa0, pa1, pa2, pa3);
            pv_tile(o, vbase + buf * SHM_V, pa0, pa1, pa2, pa3);
        }
        float cm = fmaf(m_reg, SCALE, cbase);
#pragma unroll
        for (int o_ = 1; o_ < 32; o_ <<= 1) cm = fminf(cm, __shfl_xor(cm, o_));
        if (lane == 0) stopm[buf * 8 + wid] = cm;
        if (has_next) SWRITE(buf ^ 1);
        __syncthreads();
        if (!has_next) break;
        float cmin = stopm[buf * 8];
#pragma unroll
        for (int w = 1; w < 8; ++w) cmin = fminf(cmin, stopm[buf * 8 + w]);
        if (cmin >= 18.f - FK_lds[(buf ^ 1) * 64 + 63]) break;
        --j;
    }
#undef SLOAD
#undef SWRITE
    if (hi == 0) li_l[r32] = l_reg; asm volatile("s_waitcnt lgkmcnt(0)" ::: "memory");
    float rli[16];
#pragma unroll
    for (int r = 0; r < 16; ++r) rli[r] = __builtin_amdgcn_rcpf(li_l[crow(r, hi)]);
    bf16_t* Ow = br + (size_t)qlo * DM + 3 * BWID + g * 128;
#pragma unroll
    for (int r = 0; r < 16; ++r) { const int orow = crow(r, hi);
#pragma unroll
        for (int d0 = 0; d0 < 4; ++d0) { const float v = o[d0][r] * rli[r]; const float vn = __shfl_xor(v, 1);
            if ((r32 & 1) == 0) *(unsigned*)(Ow + (size_t)orow * DM + d0 * 32 + r32) = cvtpk(v, vn); } }
}
}

namespace mix {
constexpr int VR_STRIDE = 520;
constexpr int PL_STRIDE = 520;
__device__ __forceinline__ void unpk8(const u32x4 w, float (&f)[8]) { f[0] = bflo(w.x); f[1] = bfhi(w.x); f[2] = bflo(w.y); f[3] = bfhi(w.y); f[4] = bflo(w.z); f[5] = bfhi(w.z); f[6] = bflo(w.w); f[7] = bfhi(w.w); }
__device__ __forceinline__ void conv_item(const Params& p, int l, int t0) {
    const int tid = ltid(), cc = tid & 63, tg = tid >> 6, c = cc * 8, tf = t0 + tg * 16;
    const float* cw = p.conv_w + (size_t)l * 3 * BWID + c;
    float w[3][8];
#pragma unroll
    for (int j = 0; j < 3; ++j) { const f32x4 a = *(const f32x4*)(cw + j * BWID), b = *(const f32x4*)(cw + j * BWID + 4);
        w[j][0] = a[0]; w[j][1] = a[1]; w[j][2] = a[2]; w[j][3] = a[3]; w[j][4] = b[0]; w[j][5] = b[1]; w[j][6] = b[2]; w[j][7] = b[3]; }
    const bf16_t* zb = p.zmix + C_A + c; const bf16_t* zc = zb + BWID; const bf16_t* zh = zb + 2 * BWID;
    float z2[8], z1[8];
    { u32x4 c2 = {0u, 0u, 0u, 0u}, h2 = c2, c1 = c2, h1 = c2;
      if (tf >= 2) { c2 = *(const u32x4*)(zc + (size_t)(tf - 2) * NMIX); h2 = *(const u32x4*)(zh + (size_t)(tf - 2) * NMIX); }
      if (tf >= 1) { c1 = *(const u32x4*)(zc + (size_t)(tf - 1) * NMIX); h1 = *(const u32x4*)(zh + (size_t)(tf - 1) * NMIX); }
      float a[8], b[8]; unpk8(c2, a); unpk8(h2, b);
#pragma unroll
      for (int e = 0; e < 8; ++e) z2[e] = a[e] * b[e];
      unpk8(c1, a); unpk8(h1, b);
#pragma unroll
      for (int e = 0; e < 8; ++e) z1[e] = a[e] * b[e]; }
#pragma unroll 1
    for (int hb = 0; hb < 2; ++hb) {
        u32x4 cv[8], hv[8], bv[8];
#pragma unroll
        for (int i = 0; i < 8; ++i) { const size_t ro = (size_t)(tf + hb * 8 + i) * NMIX; cv[i] = *(const u32x4*)(zc + ro); hv[i] = *(const u32x4*)(zh + ro); bv[i] = *(const u32x4*)(zb + ro); }
#pragma unroll
        for (int i = 0; i < 8; ++i) { float a[8], b[8], g[8], y[8]; unpk8(cv[i], a); unpk8(hv[i], b); unpk8(bv[i], g);
#pragma unroll
            for (int e = 0; e < 8; ++e) { const float z0 = a[e] * b[e]; y[e] = g[e] * (w[0][e] * z2[e] + w[1][e] * z1[e] + w[2][e] * z0); z2[e] = z1[e]; z1[e] = z0; }
            u32x4 o; o.x = pk2(y[0], y[1]); o.y = pk2(y[2], y[3]); o.z = pk2(y[4], y[5]); o.w = pk2(y[6], y[7]);
            *(u32x4*)(p.br + (size_t)(tf + hb * 8 + i) * DM + c) = o; }
    }
}
__device__ __forceinline__ void sgu_item(const Params& p, int l, int t0, LAS unsigned char* lds) {
    const int tid = ltid(), wid = __builtin_amdgcn_readfirstlane(tid >> 6), lane = tid & 63, fr = lane & 15, fq = lane >> 4;
    LAS bf16_t* VR = (LAS bf16_t*)lds;
    __syncthreads();
    {
        const float* ngp = p.sgu_norm_g + (size_t)l * BWID + 8 * lane; const f32x4 n0 = *(const f32x4*)ngp, n1 = *(const f32x4*)(ngp + 4);
        const float ng[8] = {n0[0], n0[1], n0[2], n0[3], n1[0], n1[1], n1[2], n1[3]};
        u32x4 zr[16];
#pragma unroll
        for (int i = 0; i < 16; ++i) zr[i] = *(const u32x4*)(p.zmix + (size_t)(t0 + wid * 16 + i) * NMIX + C_B + BWID + 8 * lane);
#pragma unroll
        for (int i = 0; i < 16; ++i) { float v[8]; unpk8(zr[i], v); float ss = 0.f;
#pragma unroll
            for (int e = 0; e < 8; ++e) { v[e] = gelu_t(v[e]); ss += v[e] * v[e]; }
            const float rstd = __builtin_amdgcn_rsqf(wave_sum(ss) * (1.f / BWID) + EPS);
            u32x4 o; o.x = pk2(v[0] * rstd * ng[0], v[1] * rstd * ng[1]); o.y = pk2(v[2] * rstd * ng[2], v[3] * rstd * ng[3]);
            o.z = pk2(v[4] * rstd * ng[4], v[5] * rstd * ng[5]); o.w = pk2(v[6] * rstd * ng[6], v[7] * rstd * ng[7]);
            *(LAS u32x4*)(VR + (wid * 16 + i) * VR_STRIDE + 8 * lane) = o; }
    }
    __syncthreads();
    const int g = wid >> 1, dh = wid & 1;
    const int q4 = (lane & 15) >> 2, pl = lane & 3;
    const int vb0 = (int)(uintptr_t)VR + (fq * 8 + q4) * (VR_STRIDE * 2) + (g * 128 + dh * 64 + pl * 4) * 2, vb1 = vb0 + 64 * VR_STRIDE * 2;
    bf16x8 X[4][4];
#define TRX(dst, base, off) asm volatile("ds_read_b64_tr_b16 %0, %1 offset:%2" : "=&v"(dst) : "v"(base), "i"(off) : "memory")
#pragma unroll
    for (int xb = 0; xb < 4; ++xb)
#pragma unroll
        for (int ks = 0; ks < 4; ++ks) { s16x4 lo, hi; constexpr int RB = VR_STRIDE * 2;
            if (ks < 2) { TRX(lo, vb0, xb * 32 + (ks & 1) * 32 * RB); TRX(hi, vb0, xb * 32 + (ks & 1) * 32 * RB + 4 * RB); }
            else        { TRX(lo, vb1, xb * 32 + (ks & 1) * 32 * RB); TRX(hi, vb1, xb * 32 + (ks & 1) * 32 * RB + 4 * RB); }
            asm volatile("s_waitcnt lgkmcnt(0)" ::: "memory");
            X[xb][ks] = (bf16x8){lo[0], lo[1], lo[2], lo[3], hi[0], hi[1], hi[2], hi[3]}; }
#undef TRX
    const bf16_t* W = p.sguW + ((size_t)l * 4 + g) * 128 * 128;
    const float* bias = p.sgu_b + ((size_t)l * 4 + g) * 128;
#pragma unroll 1
    for (int tp = 0; tp < 4; ++tp) {
        bf16x8 Y[2][4]; u32x2 uw[2][4]; float bs[2];
#pragma unroll
        for (int h2 = 0; h2 < 2; ++h2) { const int t = (tp * 2 + h2) * 16 + fr; bs[h2] = bias[t];
#pragma unroll
            for (int ks = 0; ks < 4; ++ks) Y[h2][ks] = *(const bf16x8*)(W + (size_t)t * 128 + ks * 32 + fq * 8);
#pragma unroll
            for (int xb = 0; xb < 4; ++xb) uw[h2][xb] = *(const u32x2*)(p.zmix + (size_t)(t0 + t) * NMIX + C_B + g * 128 + dh * 64 + xb * 16 + 4 * fq); }
#pragma unroll
        for (int h2 = 0; h2 < 2; ++h2) { const int t = (tp * 2 + h2) * 16 + fr;
            f32x4 acc[4];
#pragma unroll
            for (int xb = 0; xb < 4; ++xb) acc[xb] = (f32x4){0.f, 0.f, 0.f, 0.f};
#pragma unroll
            for (int ks = 0; ks < 4; ++ks)
#pragma unroll
                for (int xb = 0; xb < 4; ++xb) acc[xb] = mfma16(X[xb][ks], Y[h2][ks], acc[xb]);
#pragma unroll
            for (int xb = 0; xb < 4; ++xb) { const int c = g * 128 + dh * 64 + xb * 16 + 4 * fq; const u32x2 u_ = uw[h2][xb];
                const float u0 = gelu_t(bflo(u_.x)), u1 = gelu_t(bfhi(u_.x)), u2 = gelu_t(bflo(u_.y)), u3 = gelu_t(bfhi(u_.y));
                u32x2 o; o.x = pk2(u0 * (acc[xb][0] + bs[h2]), u1 * (acc[xb][1] + bs[h2])); o.y = pk2(u2 * (acc[xb][2] + bs[h2]), u3 * (acc[xb][3] + bs[h2]));
                *(u32x2*)(p.br + (size_t)(t0 + t) * DM + BWID + c) = o; } }
    }
}
template <int W>
__device__ __forceinline__ void pool_fill(const bf16_t* zmix, LAS bf16_t* PL, int t0, int th, int lane) {
    constexpr int G = (W == 2) ? 0 : (W == 4) ? 1 : (W == 8) ? 2 : 3;
    const int ccl = lane & 15, ts = lane >> 4, c = G * 128 + ccl * 8;
#pragma unroll 1
    for (int hp = 0; hp < 2; ++hp) {
        const int tl0 = th * 64 + ts * 16 + hp * 8, ta0 = t0 + tl0;
        u32x4 R[8 + W - 1];
#pragma unroll
        for (int k = 0; k < 8 + W - 1; ++k) { const int ta = ta0 - (W - 1) + k; R[k] = (u32x4){0u, 0u, 0u, 0u}; if (ta >= 0) R[k] = *(const u32x4*)(zmix + (size_t)ta * NMIX + C_C + c); }
        float s[8];
#pragma unroll
        for (int e = 0; e < 8; ++e) s[e] = 0.f;
#pragma unroll
        for (int k = 0; k < W - 1; ++k) { float f[8]; unpk8(R[k], f);
#pragma unroll
            for (int e = 0; e < 8; ++e) s[e] += f[e]; }
#pragma unroll
        for (int i = 0; i < 8; ++i) { float f[8], d[8]; unpk8(R[W - 1 + i], f); unpk8(R[i], d);
            const int ta = ta0 + i; const float inv = 1.f / (float)((ta + 1 < W) ? ta + 1 : W);
            float o[8];
#pragma unroll
            for (int e = 0; e < 8; ++e) { s[e] += f[e]; o[e] = s[e] * inv - f[e]; s[e] -= d[e]; }
            u32x4 w; w.x = pk2(o[0], o[1]); w.y = pk2(o[2], o[3]); w.z = pk2(o[4], o[5]); w.w = pk2(o[6], o[7]);
            *(LAS u32x4*)(PL + (tl0 + i) * PL_STRIDE + c) = w; }
    }
}
__device__ __forceinline__ void pool_item(const Params& p, int l, int t0, LAS unsigned char* lds) {
    const int tid = ltid(), wid = __builtin_amdgcn_readfirstlane(tid >> 6), lane = tid & 63, fr = lane & 15, fq = lane >> 4;
    LAS bf16_t* PL = (LAS bf16_t*)lds;
    const int g = wid >> 1, oh = wid & 1;
    const bf16_t* WT = p.poolWT + ((size_t)l * 4 + g) * 128 * 128;
    __syncthreads();
    {
        const int gg = wid & 3, th = wid >> 2;
        if (gg == 0) pool_fill<2>(p.zmix, PL, t0, th, lane); else if (gg == 1) pool_fill<4>(p.zmix, PL, t0, th, lane);
        else if (gg == 2) pool_fill<8>(p.zmix, PL, t0, th, lane); else pool_fill<16>(p.zmix, PL, t0, th, lane);
    }
    bf16x8 X[4][4];
#pragma unroll
    for (int xb = 0; xb < 4; ++xb)
#pragma unroll
        for (int ks = 0; ks < 4; ++ks) X[xb][ks] = *(const bf16x8*)(WT + (size_t)(oh * 64 + xb * 16 + fr) * 128 + ks * 32 + fq * 8);
    __syncthreads();
    const float* sc = p.pool_scale + (size_t)l * BWID + g * 128;
    f32x4 sv[4];
#pragma unroll
    for (int xb = 0; xb < 4; ++xb) sv[xb] = *(const f32x4*)(sc + oh * 64 + xb * 16 + 4 * fq);
#pragma unroll 2
    for (int tb = 0; tb < 8; ++tb) {
        f32x4 acc[4];
#pragma unroll
        for (int xb = 0; xb < 4; ++xb) acc[xb] = (f32x4){0.f, 0.f, 0.f, 0.f};
#pragma unroll
        for (int ks = 0; ks < 4; ++ks) { const bf16x8 Y = *(const LAS bf16x8*)(PL + (tb * 16 + fr) * PL_STRIDE + g * 128 + ks * 32 + fq * 8);
#pragma unroll
            for (int xb = 0; xb < 4; ++xb) acc[xb] = mfma16(X[xb][ks], Y, acc[xb]); }
        const int t = tb * 16 + fr;
#pragma unroll
        for (int xb = 0; xb < 4; ++xb) { const int o0 = oh * 64 + xb * 16 + 4 * fq;
            u32x2 o; o.x = pk2(acc[xb][0] * sv[xb][0], acc[xb][1] * sv[xb][1]); o.y = pk2(acc[xb][2] * sv[xb][2], acc[xb][3] * sv[xb][3]);
            *(u32x2*)(p.br + (size_t)(t0 + t) * DM + 2 * BWID + g * 128 + o0) = o; }
    }
}
}

template <bool FORGET>
__device__ __forceinline__ void norm_phase(const Params& p, int l, const float* hsrc, const bf16_t* po, const float* gain, int gw, int ngw, int lane) {
    f32x4 gv[8], wf[4][8];
#pragma unroll
    for (int j = 0; j < 8; ++j) { gv[j] = ((const f32x4*)gain)[lane + 64 * j];
        if (FORGET) {
#pragma unroll
            for (int g = 0; g < 4; ++g) wf[g][j] = ((const f32x4*)(p.wfg + ((size_t)l * 4 + g) * DM))[lane + 64 * j]; } }
    for (int t = gw; t < SEQ; t += ngw) {
        const f32x4* hr = (const f32x4*)(hsrc + (size_t)t * DM) + lane;
        f32x4 v[8]; float ss = 0.f;
#pragma unroll
        for (int j = 0; j < 8; ++j) v[j] = hr[64 * j];
        if (po) {
#pragma unroll
            for (int j = 0; j < 8; ++j) { const u32x2 w = ((const u32x2*)(po + (size_t)t * DM))[lane + 64 * j]; v[j][0] += bflo(w.x); v[j][1] += bfhi(w.x); v[j][2] += bflo(w.y); v[j][3] += bfhi(w.y); } }
#pragma unroll
        for (int j = 0; j < 8; ++j) ss += (v[j][0] * v[j][0] + v[j][1] * v[j][1]) + (v[j][2] * v[j][2] + v[j][3] * v[j][3]);
        const float rstd = __builtin_amdgcn_rsqf(wave_sum(ss) * (1.f / DM) + EPS);
        float fd[4] = {0.f, 0.f, 0.f, 0.f};
        u32x2* o8 = (u32x2*)(p.xn + (size_t)t * DM) + lane;
#pragma unroll
        for (int j = 0; j < 8; ++j) { const f32x4 y = v[j] * rstd * gv[j];
            u32x2 w; w.x = pk2(y[0], y[1]); w.y = pk2(y[2], y[3]); o8[64 * j] = w;
            if (!FORGET) { int f8 = __builtin_amdgcn_cvt_pk_fp8_f32(clamp8(y[0]), clamp8(y[1]), 0, false); f8 = __builtin_amdgcn_cvt_pk_fp8_f32(clamp8(y[2]), clamp8(y[3]), f8, true);
                ((unsigned*)(p.hn8 + (size_t)t * DM))[lane + 64 * j] = (unsigned)f8; }
            if (FORGET) {
#pragma unroll
                for (int g = 0; g < 4; ++g) fd[g] += (y[0] * wf[g][j][0] + y[1] * wf[g][j][1]) + (y[2] * wf[g][j][2] + y[3] * wf[g][j][3]); } }
        if (FORGET) {
#pragma unroll
            for (int g = 0; g < 4; ++g) { const float z = wave_sum(fd[g]) + p.forget_b[l * 4 + g];
                const float ls = fminf(z, 0.f) - log1pf(__expf(-fabsf(z)));
                if (lane == 0) p.flog[(size_t)t * 4 + g] = ls; } }
    }
}
__device__ __forceinline__ void final_norm_phase(const Params& p, int gw, int ngw, int lane) {
    for (int t = gw; t < SEQ; t += ngw) {
        const f32x4* hr = (const f32x4*)(p.h + (size_t)t * DM) + lane;
        f32x4 v[8]; float ss = 0.f;
#pragma unroll
        for (int j = 0; j < 8; ++j) { v[j] = hr[64 * j]; const u32x2 w = ((const u32x2*)(p.po + (size_t)t * DM))[lane + 64 * j];
            v[j][0] += bflo(w.x); v[j][1] += bfhi(w.x); v[j][2] += bflo(w.y); v[j][3] += bfhi(w.y);
            ss += (v[j][0] * v[j][0] + v[j][1] * v[j][1]) + (v[j][2] * v[j][2] + v[j][3] * v[j][3]); }
        const float rstd = __builtin_amdgcn_rsqf(wave_sum(ss) * (1.f / DM) + EPS);
        f32x4* o = (f32x4*)(p.out + (size_t)t * DM) + lane;
#pragma unroll
        for (int j = 0; j < 8; ++j) o[64 * j] = v[j] * rstd * ((const f32x4*)p.final_g)[lane + 64 * j];
    }
}
__device__ __forceinline__ void cumsum_head(const Params& p, int g, LAS unsigned char* lds) {
    LAS float* part = (LAS float*)lds;
    const int tid = ltid(), lane = tid & 63, wid = tid >> 6;
    float v[16]; float s = 0.f;
#pragma unroll
    for (int j = 0; j < 16; ++j) { v[j] = p.flog[(size_t)(tid * 16 + j) * 4 + g]; s += v[j]; }
    float x = s;
#pragma unroll
    for (int o = 1; o < 64; o <<= 1) { const float y = __shfl_up(x, o); if (lane >= o) x += y; }
    __syncthreads();
    if (lane == 63) part[wid] = x;
    __syncthreads();
    float pre = x - s;
    for (int w = 0; w < wid; ++w) pre += part[w];
#pragma unroll
    for (int j = 0; j < 16; ++j) { pre += v[j]; p.F[(size_t)g * SEQ + tid * 16 + j] = pre; }
    __syncthreads();
}
__device__ __forceinline__ void knorm_phase(const Params& p, int l, int gw, int ngw, int lane) {
    float mx = 0.f;
#pragma unroll 4
    for (int t = gw; t < SEQ; t += ngw) {
        const u32x4 w = *(const u32x4*)(p.zmix + (size_t)t * NMIX + C_K + lane * 8);
        float s = bflo(w.x) * bflo(w.x) + bfhi(w.x) * bfhi(w.x) + bflo(w.y) * bflo(w.y) + bfhi(w.y) * bfhi(w.y)
                + bflo(w.z) * bflo(w.z) + bfhi(w.z) * bfhi(w.z) + bflo(w.w) * bflo(w.w) + bfhi(w.w) * bfhi(w.w);
#pragma unroll
        for (int o = 1; o < 16; o <<= 1) s += __shfl_xor(s, o);
        mx = fmaxf(mx, s);
    }
    if ((lane & 15) == 0) atomicMax(p.ctl + CW_KN + l * 4 + (lane >> 4), __float_as_uint(mx));
}

namespace pro { __device__ __forceinline__ void conv_share(const Params& p, int L, int half, LAS unsigned char* lds); }
namespace peer {
constexpr int S_STRIDE = 129, TL_STRIDE = 17;
constexpr int OFF_TL = 256 * S_STRIDE * 4;
__device__ __forceinline__ float pack_f(float v, unsigned idx, unsigned mask) { return __uint_as_float((__float_as_uint(v) & ~mask) | idx); }
#define CEX_DESC(x, y) do { const float hi_ = fmaxf((x), (y)), lo_ = fminf((x), (y)); (x) = hi_; (y) = lo_; } while (0)
__device__ __forceinline__ void sort16_desc(float (&a)[16]) {
#pragma unroll
    for (int k = 2; k <= 16; k <<= 1)
#pragma unroll
        for (int j = k >> 1; j > 0; j >>= 1)
#pragma unroll
            for (int i = 0; i < 16; ++i) { const int l = i ^ j; if (l > i) { if ((i & k) == 0 || k == 16) { if (k == 16 || (i & k) == 0) CEX_DESC(a[i], a[l]); } else CEX_DESC(a[l], a[i]); } }
}
__device__ __forceinline__ void merge16_desc(float (&r)[16], const float (&c)[16]) {
#pragma unroll
    for (int i = 0; i < 16; ++i) r[i] = fmaxf(r[i], c[15 - i]);
#pragma unroll
    for (int j = 8; j > 0; j >>= 1)
#pragma unroll
        for (int i = 0; i < 16; ++i) { const int l = i ^ j; if (l > i) CEX_DESC(r[i], r[l]); }
}
__device__ __forceinline__ void topk_item(const Params& p, int l, int t0, int hd, LAS unsigned char* lds) {
    const int tid = ltid(), wid = __builtin_amdgcn_readfirstlane(tid >> 6), lane = tid & 63, fr = lane & 15, fq = lane >> 4;
    LAS float* Sc = (LAS float*)lds; LAS float* TL = (LAS float*)(lds + OFF_TL);
    __syncthreads();
    {
        const int pp = wid >> 2, nq = wid & 3;
        const bf16_t* kb = p.keysB + (((size_t)l * 8 + hd) * 2 + pp) * 128 * 128;
        const bf16_t* qb = p.q + (size_t)t0 * DM + hd * 256 + pp * 128;
        bf16x8 X[2][4];
#pragma unroll
        for (int xb = 0; xb < 2; ++xb)
#pragma unroll
            for (int ks = 0; ks < 4; ++ks) X[xb][ks] = *(const bf16x8*)(kb + (size_t)(nq * 32 + xb * 16 + fr) * 128 + ks * 32 + fq * 8);
        bf16x8 Yq[8][4];
#pragma unroll
        for (int tb = 0; tb < 8; ++tb)
#pragma unroll
            for (int ks = 0; ks < 4; ++ks) Yq[tb][ks] = *(const bf16x8*)(qb + (size_t)(tb * 16 + fr) * DM + ks * 32 + fq * 8);
#pragma unroll
        for (int tb = 0; tb < 8; ++tb) {
            f32x4 acc[2] = {(f32x4){0.f, 0.f, 0.f, 0.f}, (f32x4){0.f, 0.f, 0.f, 0.f}};
#pragma unroll
            for (int ks = 0; ks < 4; ++ks) { const bf16x8 Y = Yq[tb][ks];
                acc[0] = mfma16(X[0][ks], Y, acc[0]); acc[1] = mfma16(X[1][ks], Y, acc[1]); }
            LAS float* row = Sc + (pp * 128 + tb * 16 + fr) * S_STRIDE + nq * 32 + 4 * fq;
#pragma unroll
            for (int xb = 0; xb < 2; ++xb)
#pragma unroll
                for (int r = 0; r < 4; ++r) row[xb * 16 + r] = acc[xb][r];
        }
    }
    __syncthreads();
    if (tid < 256) {
        const LAS float* row = Sc + tid * S_STRIDE;
        float L[16];
#pragma unroll
        for (int i = 0; i < 16; ++i) L[i] = pack_f(row[i], (unsigned)i, 127u);
        sort16_desc(L);
#pragma unroll 1
        for (int ch = 1; ch < 8; ++ch) { float C[16];
#pragma unroll
            for (int i = 0; i < 16; ++i) C[i] = pack_f(row[ch * 16 + i], (unsigned)(ch * 16 + i), 127u);
            sort16_desc(C); merge16_desc(L, C); }
#pragma unroll
        for (int i = 0; i < 16; ++i) TL[tid * TL_STRIDE + i] = L[i];
    }
    __syncthreads();
    if (tid < 128) {
        const LAS float* A = TL + tid * TL_STRIDE; const LAS float* B = TL + (128 + tid) * TL_STRIDE;
        float av[16], bv[16];
#pragma unroll
        for (int i = 0; i < 16; ++i) { av[i] = __uint_as_float(__float_as_uint(A[i]) & ~127u); bv[i] = __uint_as_float(__float_as_uint(B[i]) & ~127u); }
        float L[16];
        {   float cand[64]; int nc = 0;
#pragma unroll
            for (int a = 0; a < 16; ++a)
#pragma unroll
                for (int b = 0; b < 16; ++b) if ((a + 1) * (b + 1) <= 16) { cand[nc] = pack_f(av[a] + bv[b], (unsigned)(a * 16 + b), 255u); ++nc; }
#pragma unroll
            for (int i = 50; i < 64; ++i) cand[i] = -__builtin_inff();
#pragma unroll
            for (int i = 0; i < 16; ++i) L[i] = cand[i];
            sort16_desc(L);
#pragma unroll
            for (int ch = 1; ch < 4; ++ch) { float C[16];
#pragma unroll
                for (int i = 0; i < 16; ++i) C[i] = cand[ch * 16 + i];
                sort16_desc(C); merge16_desc(L, C); }
        }
        float val[16]; int ex[16]; float mx = -__builtin_inff();
#pragma unroll
        for (int i = 0; i < 16; ++i) { const unsigned ab = __float_as_uint(L[i]) & 255u; const unsigned ua = __float_as_uint(A[ab >> 4]), ub = __float_as_uint(B[ab & 15]);
            val[i] = __uint_as_float(ua & ~127u) + __uint_as_float(ub & ~127u); ex[i] = (int)((ua & 127u) * 128u + (ub & 127u)); mx = fmaxf(mx, val[i]); }
        float sum = 0.f;
#pragma unroll
        for (int i = 0; i < 16; ++i) { val[i] = __expf(val[i] - mx); sum += val[i]; }
        const float inv = 1.f / sum;
        int* pi = p.pidx + (size_t)(t0 + tid) * 128 + hd * 16; float* pg = p.pgate + (size_t)(t0 + tid) * 128 + hd * 16;
#pragma unroll
        for (int i = 0; i < 16; ++i) { pi[i] = ex[i]; pg[i] = val[i] * inv; }
    }
}
__device__ __forceinline__ void vm_wait_le(int n) {
    if (n >= 19) asm volatile("s_waitcnt vmcnt(19)" ::: "memory");
    else if (n >= 16) asm volatile("s_waitcnt vmcnt(16)" ::: "memory");
    else if (n >= 15) asm volatile("s_waitcnt vmcnt(15)" ::: "memory");
    else if (n >= 12) asm volatile("s_waitcnt vmcnt(12)" ::: "memory");
    else if (n >= 8) asm volatile("s_waitcnt vmcnt(8)" ::: "memory");
    else if (n >= 4) asm volatile("s_waitcnt vmcnt(4)" ::: "memory");
    else asm volatile("s_waitcnt vmcnt(0)" ::: "memory");
}
__device__ __forceinline__ bool claim_item(unsigned* cnt, unsigned nchunk, volatile LAS unsigned* misc, int tid, int& q, int& chunk) {
    __syncthreads();
    if (tid < 64) {
        const unsigned x2 = (xb_xcc_id() & 7u) * 2u; unsigned res = 0xffffffffu;
        unsigned k = misc[1];
        for (int tries = 0; tries < 32; ++tries) {
            const unsigned qx = (x2 + k) & 15u;
            unsigned c = 0u;
            if (tid == 0) c = __hip_atomic_fetch_add(cnt + 64 * qx, 1u, __ATOMIC_RELAXED, __HIP_MEMORY_SCOPE_AGENT);
            c = __builtin_amdgcn_readfirstlane(c);
            if (c < nchunk) { res = (qx << 16) | c; break; }
            unsigned hv = 0xffffffffu;
            if (tid < 16) hv = __hip_atomic_load(cnt + 64 * ((x2 + (unsigned)tid) & 15u), __ATOMIC_RELAXED, __HIP_MEMORY_SCOPE_AGENT);
            const unsigned long long open = __ballot(hv < nchunk) & 0xffffull;
            if (open == 0ull) break;
            k = (unsigned)__builtin_ctzll(open);
        }
        if (tid == 0) { misc[0] = res; misc[1] = k; }
    }
    __syncthreads();
    const unsigned r = misc[0];
    if (r == 0xffffffffu) return false;
    q = (int)(r >> 16); chunk = (int)(r & 0xffffu); return true;
}
__device__ __forceinline__ void gather1_phase(const Params& p, int l, LAS unsigned char* lds, int rep = 0) {
    const int tid = ltid(), wid = __builtin_amdgcn_readfirstlane(tid >> 6), lane = tid & 63, r = lane & 15, c = lane >> 4;
    volatile LAS unsigned* misc = (volatile LAS unsigned*)(lds + LDS_MISC);
    unsigned* cnt = p.ctl + CW_QCNT + ((l * 2 + 0) * 2 + rep) * 16 * 64;
    if (tid == 0) misc[1] = 0u;
    LAS unsigned char* buf = lds + wid * 16384;
    LAS unsigned char* sm = lds + 131072 + wid * 2304;
    const int rowi = lane >> 3, j = lane & 7, fw = rowi >> 1, frd = (r >> 1) & 7;
    const int bk0 = (int)(uintptr_t)buf + r * 128 + ((c ^ frd) * 16), bk1 = (int)(uintptr_t)buf + r * 128 + (((4 + c) ^ frd) * 16);
    float mk[8];
#pragma unroll
    for (int g = 0; g < 8; ++g) mk[g] = ((r >> 1) == g) ? 1.f : 0.f;
    const bool odd = (r & 1) != 0;
    int q, chunk;
    const int cpos = (lbid() >> 3) % 5; bool cpend = (l + 1 < DEPTH) && rep == 0;
    bool dry = false;
    for (int ndone = 0;; ++ndone) {
        if (cpend && (dry || ndone == cpos)) { pro::conv_share(p, l + 1, 0, lds); cpend = false; }
        if (dry) break;
        if (!claim_item(cnt, (unsigned)(SEQ / (8 * TPW)), misc, tid, q, chunk)) { dry = true; if (!cpend) break; continue; }

        const int tw = chunk * (8 * TPW) + wid * TPW;
        float acc[TPW][2];
#pragma unroll
        for (int i = 0; i < TPW; ++i) { acc[i][0] = 0.f; acc[i][1] = 0.f; }
#define G1_DMAQ(Q, EN) do { _Pragma("unroll") for (int nn = 0; nn < 4; ++nn) { const int n = ((Q) & 1) * 4 + nn; const int e = (EN)[(Q) * 4 + nn]; \
                        const unsigned char* src = ub + (unsigned)((unsigned)e * 128u + (unsigned)((j ^ ((n & 1) * 4 + fw)) * 16)); \
                        __builtin_amdgcn_global_load_lds((const unsigned*)src, (LAS unsigned*)(buf + ((Q) >> 1) * 8192 + n * 1024), 16, 0, 0); } } while (0)
#define G1_CQ(Q, H0, H1, I) do { const int gga = ((Q) & 1) * 2, ga = ((Q) >> 1) * 4 + gga;     \
                        const i64x2 A0a = *(const LAS i64x2*)(uintptr_t)(bk0 + ((Q) >> 1) * 8192 + gga * 2048), A1a = *(const LAS i64x2*)(uintptr_t)(bk1 + ((Q) >> 1) * 8192 + gga * 2048); \
                        const i64x2 A0b = *(const LAS i64x2*)(uintptr_t)(bk0 + ((Q) >> 1) * 8192 + gga * 2048 + 2048), A1b = *(const LAS i64x2*)(uintptr_t)(bk1 + ((Q) >> 1) * 8192 + gga * 2048 + 2048); \
                        f32x4 Ca = __builtin_amdgcn_mfma_f32_16x16x32_fp8_fp8(A0a[0], (H0)[0], (f32x4){0.f, 0.f, 0.f, 0.f}, 0, 0, 0); \
                        f32x4 Cb = __builtin_amdgcn_mfma_f32_16x16x32_fp8_fp8(A0b[0], (H0)[0], (f32x4){0.f, 0.f, 0.f, 0.f}, 0, 0, 0); \
                        Ca = __builtin_amdgcn_mfma_f32_16x16x32_fp8_fp8(A0a[1], (H0)[1], Ca, 0, 0, 0); Cb = __builtin_amdgcn_mfma_f32_16x16x32_fp8_fp8(A0b[1], (H0)[1], Cb, 0, 0, 0); \
                        Ca = __builtin_amdgcn_mfma_f32_16x16x32_fp8_fp8(A1a[0], (H1)[0], Ca, 0, 0, 0); Cb = __builtin_amdgcn_mfma_f32_16x16x32_fp8_fp8(A1b[0], (H1)[0], Cb, 0, 0, 0); \
                        Ca = __builtin_amdgcn_mfma_f32_16x16x32_fp8_fp8(A1a[1], (H1)[1], Ca, 0, 0, 0); Cb = __builtin_amdgcn_mfma_f32_16x16x32_fp8_fp8(A1b[1], (H1)[1], Cb, 0, 0, 0); \
                        acc[I][0] = fmaf(mk[ga], odd ? Ca[2] : Ca[0], acc[I][0]); acc[I][1] = fmaf(mk[ga], odd ? Ca[3] : Ca[1], acc[I][1]); \
                        acc[I][0] = fmaf(mk[ga + 1], odd ? Cb[2] : Cb[0], acc[I][0]); acc[I][1] = fmaf(mk[ga + 1], odd ? Cb[3] : Cb[1], acc[I][1]); \
                        asm volatile("s_waitcnt lgkmcnt(0)" ::: "memory"); } while (0)
#define G1_SMALLD(SLOT, TI) do { const int* ip_ = p.pidx + (size_t)(tw + (TI)) * 128 + lane; \
                        __builtin_amdgcn_global_load_lds((const unsigned*)ip_, (LAS unsigned*)(sm + (SLOT) * 768), 4, 0, 0); \
                        __builtin_amdgcn_global_load_lds((const unsigned*)(ip_ + 64), (LAS unsigned*)(sm + (SLOT) * 768 + 256), 4, 0, 0); \
                        __builtin_amdgcn_global_load_lds((const unsigned*)(hs0 + (size_t)(TI) * DM), (LAS unsigned*)(sm + (SLOT) * 768 + 512), 4, 0, 0); } while (0)
#define G1_RDIX(SLOT, EN) do { _Pragma("unroll") for (int m = 0; m < 16; ++m) (EN)[m] = *(const LAS int*)(sm + (SLOT) * 768 + (m * 8 + rowi) * 4); } while (0)
#define G1_RDHY(SLOT, H0, H1) do { H0 = *(const LAS i64x2*)(sm + (SLOT) * 768 + 512 + c * 16); H1 = *(const LAS i64x2*)(sm + (SLOT) * 768 + 512 + 64 + c * 16); } while (0)
        {
            const int s = q;
            const unsigned char* ub = p.uS8 + ((size_t)(l * 16 + s) * PEER_N) * 128;
            const unsigned char* hs0 = p.hn8 + (size_t)tw * DM + s * 128 + (lane & 31) * 4;
            int en[16]; i64x2 hyc0, hyc1;
            G1_SMALLD(0, 0); G1_SMALLD(1, 1);
            asm volatile("s_waitcnt vmcnt(0)" ::: "memory"); __builtin_amdgcn_sched_barrier(0);
            G1_RDIX(0, en);
            G1_DMAQ(0, en); G1_DMAQ(1, en); G1_DMAQ(2, en); G1_DMAQ(3, en);
            __builtin_amdgcn_sched_barrier(0);
#pragma unroll
            for (int i = 0; i < TPW; ++i) {
#pragma unroll
                for (int qq = 0; qq < 4; ++qq) {
                    const int nyoung = 4 * ((3 - qq) + ((i + 1 < TPW) ? qq : 0)) + ((qq > 0 && i + 2 < TPW) ? 3 : 0);
                    vm_wait_le(nyoung); __builtin_amdgcn_sched_barrier(0);
                    if (qq == 0) {
                        G1_RDHY(i % 3, hyc0, hyc1);
                        if (i + 1 < TPW) G1_RDIX((i + 1) % 3, en);
                        if (i + 2 < TPW) G1_SMALLD((i + 2) % 3, i + 2);
                        __builtin_amdgcn_sched_barrier(0); }
                    G1_CQ(qq, hyc0, hyc1, i);
                    if (i + 1 < TPW) G1_DMAQ(qq, en);
                    __builtin_amdgcn_sched_barrier(0);
                }
            }
        }
#undef G1_SMALLD
#undef G1_RDIX
#undef G1_RDHY
#undef G1_DMAQ
#undef G1_CQ
        const int j0 = 16 * (r >> 1) + 4 * c + 2 * (r & 1);
#pragma unroll
        for (int i = 0; i < TPW; ++i) *(unsigned*)((bf16_t*)p.pq + ((size_t)q * SEQ + tw + i) * 128 + j0) = cvtpk(acc[i][0], acc[i][1]);
    }
}
__device__ __forceinline__ void gather_reduce_phase(const Params& p, const float* rs2, size_t gtid, size_t ngt) {
    for (size_t i = gtid; i < (size_t)SEQ * 128 / 4; i += ngt) {
        f32x4 sum = (f32x4){0.f, 0.f, 0.f, 0.f};
#pragma unroll
        for (int q = 0; q < 16; ++q) { const u32x2 w = ((const u32x2*)((const bf16_t*)p.pq + (size_t)q * SEQ * 128))[i]; sum[0] += bflo(w.x); sum[1] += bfhi(w.x); sum[2] += bflo(w.y); sum[3] += bfhi(w.y); }
        sum *= (1.0f / U_SCALE) * rs2[i >> 5];
        const f32x4 g = ((const f32x4*)p.pgate)[i];
        int w = __builtin_amdgcn_cvt_pk_fp8_f32(clamp8(A_SCALE * g[0] * gelu_t(sum[0])), clamp8(A_SCALE * g[1] * gelu_t(sum[1])), 0, false);
        w = __builtin_amdgcn_cvt_pk_fp8_f32(clamp8(A_SCALE * g[2] * gelu_t(sum[2])), clamp8(A_SCALE * g[3] * gelu_t(sum[3])), w, true);
        ((unsigned*)p.aB8)[i] = (unsigned)w;
    }
}
__device__ __forceinline__ void gather2_phase(const Params& p, int l, LAS unsigned char* lds, int rep = 0) {
    bf16_t* podst = p.po + (rep ? (size_t)SEQ * DM : (size_t)0);
    const int tid = ltid(), wid = __builtin_amdgcn_readfirstlane(tid >> 6), lane = tid & 63, r = lane & 15, c = lane >> 4;
    volatile LAS unsigned* misc = (volatile LAS unsigned*)(lds + LDS_MISC);
    unsigned* cnt = p.ctl + CW_QCNT + ((l * 2 + 1) * 2 + rep) * 16 * 64;
    if (tid == 0) misc[1] = 0u;
    LAS unsigned char* buf = lds + wid * 16384;
    LAS unsigned char* sm = lds + 131072 + wid * 2304;
    const int rowi = lane >> 3, j = lane & 7;
    const int fsw = (rowi >> 1) & 3;
    const int tr_r = (lane & 15) >> 1, tr_h = lane & 1;
    int bnb[4];
#pragma unroll
    for (int nb = 0; nb < 4; ++nb) bnb[nb] = (int)(uintptr_t)buf + (c * 8 + tr_r) * 128 + ((nb ^ ((tr_r >> 1) & 3)) * 16) + tr_h * 8;
    int q, chunk;
    const int cpos = (lbid() >> 3) % 5; bool cpend = (l + 1 < DEPTH) && rep == 0;
    bool dry = false;
    for (int ndone = 0;; ++ndone) {
        if (cpend && (dry || ndone == cpos)) { pro::conv_share(p, l + 1, 1, lds); cpend = false; }
        if (dry) break;
        if (!claim_item(cnt, (unsigned)(SEQ / (8 * TPW)), misc, tid, q, chunk)) { dry = true; if (!cpend) break; continue; }

        const int tw = chunk * (8 * TPW) + wid * TPW;
#define TRR(dst, base, off) asm volatile("ds_read_b64_tr_b8 %0, %1 offset:%2" : "=&v"(dst) : "v"(base), "i"(off) : "memory")
#define EV4(w0, w1) __builtin_amdgcn_perm((w1), (w0), 0x06040200u)
#define OD4(w0, w1) __builtin_amdgcn_perm((w1), (w0), 0x07050301u)
#define G2_CQ(Q, AFQ) do { u32x2 ev[4], od[4]; \
                        TRR(ev[0], bnb[0], ((Q) >> 1) * 8192 + ((Q) & 1) * 4096); TRR(od[0], bnb[0], ((Q) >> 1) * 8192 + ((Q) & 1) * 4096 + 64); \
                        TRR(ev[1], bnb[1], ((Q) >> 1) * 8192 + ((Q) & 1) * 4096); TRR(od[1], bnb[1], ((Q) >> 1) * 8192 + ((Q) & 1) * 4096 + 64); \
                        TRR(ev[2], bnb[2], ((Q) >> 1) * 8192 + ((Q) & 1) * 4096); TRR(od[2], bnb[2], ((Q) >> 1) * 8192 + ((Q) & 1) * 4096 + 64); \
                        TRR(ev[3], bnb[3], ((Q) >> 1) * 8192 + ((Q) & 1) * 4096); TRR(od[3], bnb[3], ((Q) >> 1) * 8192 + ((Q) & 1) * 4096 + 64); \
                        asm volatile("s_waitcnt lgkmcnt(0)" ::: "memory"); __builtin_amdgcn_sched_barrier(0); \
                        _Pragma("unroll") for (int nb = 0; nb < 4; ++nb) { \
                            const long E = (long)(((unsigned long long)ev[nb].y << 32) | ev[nb].x), O = (long)(((unsigned long long)od[nb].y << 32) | od[nb].x); \
                            De[nb] = __builtin_amdgcn_mfma_f32_16x16x32_fp8_fp8((AFQ), E, De[nb], 0, 0, 0); Do[nb] = __builtin_amdgcn_mfma_f32_16x16x32_fp8_fp8((AFQ), O, Do[nb], 0, 0, 0); } } while (0)
#define G2_DMAQ(Q, EN) do { _Pragma("unroll") for (int nn = 0; nn < 4; ++nn) { const int n = ((Q) & 1) * 4 + nn; const int e = (EN)[(Q) * 4 + nn]; \
                        const unsigned char* src = vb + (unsigned)((unsigned)e * 128u + (unsigned)((j ^ fsw) * 16)); \
                        __builtin_amdgcn_global_load_lds((const unsigned*)src, (LAS unsigned*)(buf + ((Q) >> 1) * 8192 + n * 1024), 16, 0, 0); } } while (0)
#define G2_SMALLD(SLOT, TI) do { const int* ip_ = p.pidx + (size_t)(tw + (TI)) * 128 + lane; \
                        __builtin_amdgcn_global_load_lds((const unsigned*)ip_, (LAS unsigned*)(sm + (SLOT) * 768), 4, 0, 0); \
                        __builtin_amdgcn_global_load_lds((const unsigned*)(ip_ + 64), (LAS unsigned*)(sm + (SLOT) * 768 + 256), 4, 0, 0); \
                        __builtin_amdgcn_global_load_lds((const unsigned*)(as0 + (size_t)(TI) * 128), (LAS unsigned*)(sm + (SLOT) * 768 + 512), 4, 0, 0); } while (0)
#define G2_RDIX(SLOT, EN) do { _Pragma("unroll") for (int m = 0; m < 16; ++m) (EN)[m] = *(const LAS int*)(sm + (SLOT) * 768 + (m * 8 + rowi) * 4); } while (0)
#define G2_RDAF(SLOT, AF) do { _Pragma("unroll") for (int ks = 0; ks < 4; ++ks) (AF)[ks] = *(const LAS long*)(sm + (SLOT) * 768 + 512 + ks * 32 + c * 8); } while (0)
        {
            const int s = q;
            const unsigned char* vb = p.vS8 + ((size_t)(l * 16 + s) * PEER_N) * 128;
            const unsigned char* as0 = p.aB8 + (size_t)tw * 128 + (lane & 31) * 4;
            int en[16]; long af[4]; unsigned pend[4];
#pragma unroll
            for (int k = 0; k < 4; ++k) pend[k] = 0u;
            G2_SMALLD(0, 0); G2_SMALLD(1, 1);
            asm volatile("s_waitcnt vmcnt(0)" ::: "memory"); __builtin_amdgcn_sched_barrier(0);
            G2_RDIX(0, en);
            G2_DMAQ(0, en); G2_DMAQ(1, en); G2_DMAQ(2, en); G2_DMAQ(3, en);
            __builtin_amdgcn_sched_barrier(0);
            int sc = 0, sn = 1, s2 = 2;
#pragma unroll 1
            for (int i = 0; i < TPW; ++i) {
                const int t = tw + i;
                f32x4 De[4], Do[4];
#pragma unroll
                for (int nb = 0; nb < 4; ++nb) { De[nb] = (f32x4){0.f, 0.f, 0.f, 0.f}; Do[nb] = (f32x4){0.f, 0.f, 0.f, 0.f}; }
#pragma unroll
                for (int qq = 0; qq < 4; ++qq) {
                    if (qq == 0) vm_wait_le(12);
                    else if (i == TPW - 1) vm_wait_le(4 * (3 - qq) + 4);
                    else if (i >= 1 && i <= TPW - 3) vm_wait_le(19);
                    else vm_wait_le(15);
                    __builtin_amdgcn_sched_barrier(0);
                    if (qq == 0) {
                        G2_RDAF(sc, af);
                        if (i + 1 < TPW) G2_RDIX(sn, en);
                        if (i + 2 < TPW) G2_SMALLD(s2, i + 2);
                        if (i > 0 && c == 0) {
#pragma unroll
                            for (int nb = 0; nb < 4; ++nb) *(unsigned*)(podst + (size_t)(t - 1) * DM + s * 128 + nb * 32 + 2 * r) = pend[nb]; }
                        asm volatile("" ::: "memory"); __builtin_amdgcn_sched_barrier(0); }
                    G2_CQ(qq, af[qq]);
                    if (i + 1 < TPW) G2_DMAQ(qq, en);
                    __builtin_amdgcn_sched_barrier(0);
                }
#pragma unroll
                for (int nb = 0; nb < 4; ++nb) pend[nb] = cvtpk(De[nb][0] * (1.0f / (V_SCALE * A_SCALE)), Do[nb][0] * (1.0f / (V_SCALE * A_SCALE)));
                { const int tmp = sc; sc = sn; sn = s2; s2 = tmp; }
            }
            if (c == 0) {
#pragma unroll
                for (int nb = 0; nb < 4; ++nb) *(unsigned*)(podst + (size_t)(tw + TPW - 1) * DM + s * 128 + nb * 32 + 2 * r) = pend[nb]; }
        }
#undef G2_CQ
#undef G2_DMAQ
#undef G2_SMALLD
#undef G2_RDIX
#undef G2_RDAF
#undef EV4
#undef OD4
#undef TRR
    }
}
}

namespace pro {
__device__ __forceinline__ void tr_item(const float* W, int ldw, int K, bf16_t* WT, int nblk, int item, LAS float* scr, int lane) {
    const int kb = item / nblk, nb = item % nblk, k0 = 64 * kb, n0 = 32 * nb;
    const int kr = lane >> 3, nq = (lane & 7) * 4;
    f32x4 v[8];
#pragma unroll
    for (int i = 0; i < 8; ++i) v[i] = *(const f32x4*)(W + (size_t)(k0 + 8 * i + kr) * ldw + n0 + nq);
#pragma unroll
    for (int i = 0; i < 8; ++i) { LAS float* d = scr + (8 * i + kr) * 33 + nq; d[0] = v[i][0]; d[1] = v[i][1]; d[2] = v[i][2]; d[3] = v[i][3]; }
    asm volatile("s_waitcnt lgkmcnt(0)" ::: "memory");
    const int c = lane & 7;
#pragma unroll
    for (int j = 0; j < 4; ++j) { const int n = (lane >> 3) + 8 * j; const LAS float* s = scr + (8 * c) * 33 + n;
        u32x4 o; o.x = pk2(s[0 * 33], s[1 * 33]); o.y = pk2(s[2 * 33], s[3 * 33]); o.z = pk2(s[4 * 33], s[5 * 33]); o.w = pk2(s[6 * 33], s[7 * 33]);
        *(u32x4*)(WT + (size_t)(n0 + n) * K + k0 + 8 * c) = o; }
    asm volatile("s_waitcnt lgkmcnt(0)" ::: "memory");
}
__device__ __forceinline__ void tr_item2(const float* W, int ldw, int K, bf16_t* WT, int nblk2, int item, LAS float* scr, int lane) {
    const int kb = item / nblk2, nb = item % nblk2, k0 = 64 * kb, n0 = 64 * nb;
    const int kr = lane >> 3, nq = (lane & 7) * 4, c = lane & 7;
    f32x4 v[2][8];
#pragma unroll
    for (int h = 0; h < 2; ++h)
#pragma unroll
        for (int i = 0; i < 8; ++i) v[h][i] = *(const f32x4*)(W + (size_t)(k0 + 8 * i + kr) * ldw + n0 + 32 * h + nq);
#pragma unroll
    for (int h = 0; h < 2; ++h) {
#pragma unroll
        for (int i = 0; i < 8; ++i) { LAS float* d = scr + (8 * i + kr) * 33 + nq; d[0] = v[h][i][0]; d[1] = v[h][i][1]; d[2] = v[h][i][2]; d[3] = v[h][i][3]; }
        asm volatile("s_waitcnt lgkmcnt(0)" ::: "memory");
#pragma unroll
        for (int j = 0; j < 4; ++j) { const int n = (lane >> 3) + 8 * j; const LAS float* sp = scr + (8 * c) * 33 + n;
            u32x4 o; o.x = pk2(sp[0 * 33], sp[1 * 33]); o.y = pk2(sp[2 * 33], sp[3 * 33]); o.z = pk2(sp[4 * 33], sp[5 * 33]); o.w = pk2(sp[6 * 33], sp[7 * 33]);
            *(u32x4*)(WT + (size_t)(n0 + 32 * h + n) * K + k0 + 8 * c) = o; }
        asm volatile("s_waitcnt lgkmcnt(0)" ::: "memory");
    }
}
__device__ __forceinline__ void cvt_stream(const float* src, bf16_t* dst, size_t n8, size_t gtid, size_t ngt) {
    for (size_t i = gtid; i < n8; i += ngt) { const f32x4 a = ((const f32x4*)src)[2 * i], b = ((const f32x4*)src)[2 * i + 1];
        u32x4 o; o.x = pk2(a[0], a[1]); o.y = pk2(a[2], a[3]); o.z = pk2(b[0], b[1]); o.w = pk2(b[2], b[3]); ((u32x4*)dst)[i] = o; }
}
__device__ __forceinline__ void cvt_sliced(const float* src, bf16_t* dst, size_t gtid, size_t ngt) {
    for (size_t i = gtid; i < (size_t)DEPTH * PEER_N * DM / 8; i += ngt) { const f32x4 a = ((const f32x4*)src)[2 * i], b = ((const f32x4*)src)[2 * i + 1];
        const size_t k8 = i & 255, le = i >> 8, e = le & (PEER_N - 1), l = le >> 14;
        u32x4 o; o.x = pk2(a[0], a[1]); o.y = pk2(a[2], a[3]); o.z = pk2(b[0], b[1]); o.w = pk2(b[2], b[3]);
        *(u32x4*)(dst + (((l * 32 + (k8 >> 3)) * PEER_N + e) * 64 + (k8 & 7) * 8)) = o; }
}
__device__ __forceinline__ void cvt_sliced_fp8(const float* src, unsigned char* dst, float scale, size_t gtid, size_t ngt) {
    const size_t n4 = (size_t)DEPTH * PEER_N * DM / 4;
    for (size_t i0 = gtid; i0 < n4; i0 += 4 * ngt) {
        f32x4 v[4];
#pragma unroll
        for (int u = 0; u < 4; ++u) { const size_t i = i0 + u * ngt; if (i < n4) v[u] = ((const f32x4*)src)[i]; }
#pragma unroll
        for (int u = 0; u < 4; ++u) { const size_t i = i0 + u * ngt; if (i < n4) {
            const size_t k4 = i & 511, le = i >> 9, e = le & (PEER_N - 1), l = le >> 14;
            int w = __builtin_amdgcn_cvt_pk_fp8_f32(clamp8(v[u][0] * scale), clamp8(v[u][1] * scale), 0, false); w = __builtin_amdgcn_cvt_pk_fp8_f32(clamp8(v[u][2] * scale), clamp8(v[u][3] * scale), w, true);
            *(unsigned*)(dst + (((l * 16 + (k4 >> 5)) * PEER_N + e) * 128 + (k4 & 31) * 4)) = (unsigned)w; } }
    }
}
constexpr int I_MIX = 32 * 72, I_GATE = 32 * 128, I_BR = 8 * 32, I_SQ = 32 * 32, I_PW = 2 * 2;
constexpr int I_LAYER = I_MIX + I_GATE + 4 * I_BR + 2 * I_SQ + 4 * I_PW;
constexpr int CVT_CHUNKS = 4096;
constexpr int NTW = I_LAYER + 2 * CVT_CHUNKS;
constexpr int NWG_ITEMS = (NTW + 15) / 16;
template <bool VPERM>
__device__ __forceinline__ void cvt_chunk_fp8(const float* src, unsigned char* dst, float scale, size_t g0, int lane) {
    f32x4 v[2][8];
#pragma unroll
    for (int u = 0; u < 8; ++u) v[0][u] = ((const f32x4*)src)[g0 + u * 64 + lane];
#pragma unroll
    for (int b = 0; b < 4; ++b) {
        if (b + 1 < 4) {
#pragma unroll
            for (int u = 0; u < 8; ++u) v[(b + 1) & 1][u] = ((const f32x4*)src)[g0 + (b + 1) * 512 + u * 64 + lane]; }
#pragma unroll
        for (int u = 0; u < 8; ++u) { const size_t i = g0 + b * 512 + u * 64 + lane; const f32x4 x = v[b & 1][u];
            const size_t k4 = i & 511, le = i >> 9, e = le & (PEER_N - 1), l = le >> 14;
            int w = __builtin_amdgcn_cvt_pk_fp8_f32(clamp8(x[0] * scale), clamp8(x[1] * scale), 0, false); w = __builtin_amdgcn_cvt_pk_fp8_f32(clamp8(x[2] * scale), clamp8(x[3] * scale), w, true);
            if (VPERM) {
                const unsigned pw = (unsigned)__shfl_xor(w, 1); const bool oddl = (lane & 1) != 0;
                const unsigned o = oddl ? __builtin_amdgcn_perm((unsigned)w, pw, 0x07050301u) : __builtin_amdgcn_perm(pw, (unsigned)w, 0x06040200u);
                *(unsigned*)(dst + (((l * 16 + (k4 >> 5)) * PEER_N + e) * 128 + (oddl ? 64 : 0) + ((k4 & 31) >> 1) * 4)) = o; }
            else *(unsigned*)(dst + (((l * 16 + (k4 >> 5)) * PEER_N + e) * 128 + (k4 & 31) * 4)) = (unsigned)w; }
    }
}
__device__ __forceinline__ void conv_wave_item(const Params& p, int l, int w, LAS float* scr, int lane) {
    if (w >= NTW) return;
    if (w >= I_LAYER) { const int c = w - I_LAYER, tbl = c / CVT_CHUNKS, chunk = c % CVT_CHUNKS;
        const size_t g0 = (size_t)l * PEER_N * DM / 4 + (size_t)chunk * 2048;
        if (tbl == 0) cvt_chunk_fp8<false>(p.peer_u, p.uS8, U_SCALE, g0, lane); else cvt_chunk_fp8<true>(p.peer_v, p.vS8, V_SCALE, g0, lane);
        return; }
    int r = w;
    const float* win = p.w_in + (size_t)l * DM * INCOLS; bf16_t* wint = p.WinT + (size_t)l * NIN * DM;
    if (r < I_MIX) { tr_item2(win, INCOLS, DM, wint, 72, r, scr, lane); return; } r -= I_MIX;
    if (r < I_GATE) { tr_item2(win + NMIX + 4, INCOLS, DM, wint + (size_t)NMIX * DM, 128, r, scr, lane); return; } r -= I_GATE;
    if (r < 4 * I_BR) { const int n = r / I_BR; tr_item2(p.w_branch + ((size_t)l * 4 + n) * BWID * DM, DM, BWID, p.WbT + ((size_t)l * 4 + n) * DM * BWID, 32, r % I_BR, scr, lane); return; } r -= 4 * I_BR;
    if (r < I_SQ) { tr_item2(p.w_out + (size_t)l * DM * DM, DM, DM, p.WoT + (size_t)l * DM * DM, 32, r, scr, lane); return; } r -= I_SQ;
    if (r < I_SQ) { tr_item2(p.peer_wq + (size_t)l * DM * DM, DM, DM, p.WqT + (size_t)l * DM * DM, 32, r, scr, lane); return; } r -= I_SQ;
    { const int g = r / I_PW; tr_item2(p.pool_w + ((size_t)l * 4 + g) * 128 * 128, 128, 128, p.poolWT + ((size_t)l * 4 + g) * 128 * 128, 2, r % I_PW, scr, lane); }
}
__device__ __forceinline__ void conv_share(const Params& p, int L, int half, LAS unsigned char* lds) {
    const int tid = ltid(), wid = __builtin_amdgcn_readfirstlane(tid >> 6), lane = tid & 63;
    const int ngw = (int)gridDim.x * NWAVES, gw = lbid() * NWAVES + wid;
    LAS float* scr = (LAS float*)(lds + wid * 16384);
#pragma unroll 1
    for (int w = gw + half * ngw; w < NTW; w += 2 * ngw) conv_wave_item(p, L, w, scr, lane);
}
__device__ __forceinline__ void prologue(const Params& p, int vb, int nvb, LAS unsigned char* lds) {
    const int tid = ltid(), wid = __builtin_amdgcn_readfirstlane(tid >> 6), lane = tid & 63;
    const int gw = vb * NWAVES + wid, ngw = nvb * NWAVES;
    LAS float* scr = (LAS float*)(lds + wid * 16384);
    for (int w = gw; w < NTW; w += ngw) conv_wave_item(p, 0, w, scr, lane);
    const size_t gtid = (size_t)vb * NTHREADS + tid, ngt = (size_t)nvb * NTHREADS;
    cvt_stream(p.peer_keys, p.keysB, (size_t)DEPTH * 8 * 2 * 128 * 128 / 8, gtid, ngt);
    for (size_t i = gtid; i < (size_t)DEPTH * 4 * 128 * 128; i += ngt) { const int s = (int)(i & 127), t = (int)((i >> 7) & 127); p.sguW[i] = (bf16_t)(s <= t ? f2bf(p.sgu_w[i]) : 0u); }
    for (size_t i = gtid; i < (size_t)DEPTH * 4 * DM; i += ngt) { const int k = (int)(i % DM), g = (int)((i / DM) & 3), l = (int)(i / (4 * DM)); p.wfg[i] = p.w_in[((size_t)l * DM + k) * INCOLS + NMIX + g]; }
}
}

#define XB_CW_BAR   4096
#define XB_TMO      128
#define XB_XCNT(j)  (256  + 64 * (j))
#define XB_XSUB(j)  (1280 + 64 * (j))
#define XB_XGEN(j)  (2304 + 64 * (j))
#define XB_TOP      3328
#define XB_TOPGEN   3392
#define XCD_BAR_WORDS 3456
#define XB_SPIN_CAP (1u << 18)
__device__ __forceinline__ unsigned xb_ld(unsigned* p)              { return __hip_atomic_load(p, __ATOMIC_RELAXED, __HIP_MEMORY_SCOPE_AGENT); }
__device__ __forceinline__ unsigned xb_add(unsigned* p, unsigned v) { return __hip_atomic_fetch_add(p, v, __ATOMIC_RELAXED, __HIP_MEMORY_SCOPE_AGENT); }
#define XB_SPIN(cond, bar) do { unsigned _sp = 0; while (cond) { __builtin_amdgcn_s_sleep(1); \
    if ((++_sp & 255u) == 0u) { if (xb_ld(&(bar)[XB_TMO])) break; if (_sp > XB_SPIN_CAP) { atomicAdd(&(bar)[XB_TMO], 1u); break; } } } } while (0)
struct XcdBarrier { unsigned* bar; unsigned x; volatile LAS unsigned* st; };
__device__ __forceinline__ XcdBarrier xcd_barrier_post(unsigned* bar, volatile LAS unsigned* st) {
    XcdBarrier b; b.bar = bar; b.x = xb_xcc_id(); b.st = st;
    if (threadIdx.x == 0) (void)xb_add(&bar[XB_XCNT(b.x)], 1u);
    return b;
}
__device__ __forceinline__ void xcd_barrier_complete(unsigned* bar, unsigned x, unsigned& nloc, unsigned& nx) {
    const unsigned G = gridDim.x * gridDim.y * gridDim.z;
    unsigned sum, cnt, mine, sp = 0u;
    for (;;) {
        sum = 0u; cnt = 0u; mine = 0u;
#pragma unroll
        for (unsigned j = 0; j < 16; ++j) { const unsigned c = xb_ld(&bar[XB_XCNT(j)]); sum += c; cnt += (c > 0u) ? 1u : 0u; mine = (j == x) ? c : mine; }
        if (sum == G) break;
        __builtin_amdgcn_s_sleep(1);
        if ((++sp & 255u) == 0u) { if (xb_ld(&bar[XB_TMO])) break; if (sp > XB_SPIN_CAP) { atomicAdd(&bar[XB_TMO], 1u); break; } }
    }
    nloc = mine > 0u ? mine : 1u; nx = cnt > 0u ? cnt : 1u;
}
__device__ __forceinline__ void xcd_barrier(const XcdBarrier& b) {
    asm volatile("s_waitcnt vmcnt(0)" ::: "memory");
    __syncthreads();
    if (threadIdx.x == 0) {
        const unsigned long long wsv = ((const LAS unsigned long long*)((LAS unsigned char*)b.st - LDS_BARW + LDS_PTAB))[19];
        const unsigned wlo = __builtin_amdgcn_readfirstlane((unsigned)wsv), whi = __builtin_amdgcn_readfirstlane((unsigned)(wsv >> 32));
        unsigned* bar = (unsigned*)(GAS unsigned*)((((unsigned long long)whi << 32) | wlo) + WS_CTL + (size_t)XB_CW_BAR * 4);
        __builtin_amdgcn_s_waitcnt(0);
        unsigned nloc = b.st[0], nx = b.st[1];
        if (nloc == 0u) { xcd_barrier_complete(bar, b.x, nloc, nx); b.st[0] = nloc; b.st[1] = nx; }
        const unsigned old = xb_add(&bar[XB_XSUB(b.x)], 1u);
        const unsigned gen = old / nloc;
        if (old + 1u == (gen + 1u) * nloc) {
            __builtin_amdgcn_fence(__ATOMIC_RELEASE, "agent");
            asm volatile("s_waitcnt vmcnt(0)" ::: "memory");
            const unsigned og = xb_add(&bar[XB_TOP], 1u);
            const unsigned tg = og / nx;
            if (og + 1u == (tg + 1u) * nx) xb_add(&bar[XB_TOPGEN], 1u);
            else XB_SPIN(xb_ld(&bar[XB_TOPGEN]) == tg, bar);
            __builtin_amdgcn_fence(__ATOMIC_ACQUIRE, "agent");
            xb_add(&bar[XB_XGEN(b.x)], 1u);
            asm volatile("s_waitcnt vmcnt(0)" ::: "memory");
        } else {
            XB_SPIN(xb_ld(&bar[XB_XGEN(b.x)]) == gen, bar);
            __builtin_amdgcn_fence(__ATOMIC_ACQUIRE, "agent");
            asm volatile("s_waitcnt vmcnt(0)" ::: "memory");
        }
    }
    __syncthreads();
}

constexpr int NPH_LAYER = 9, NPHASES = 2 + DEPTH * NPH_LAYER;
constexpr int CW_BAR = XB_CW_BAR;


template <class T> __device__ __forceinline__ T* ldptr(const LAS unsigned long long* ptab, int i) {
    const unsigned long long v = ptab[i];
    const unsigned lo = __builtin_amdgcn_readfirstlane((unsigned)v), hi = __builtin_amdgcn_readfirstlane((unsigned)(v >> 32));
    return (T*)(GAS T*)(((unsigned long long)hi << 32) | lo);
}
__device__ __forceinline__ Params mkparams(const LAS unsigned long long* ptab) {
    Params p;
    p.x = ldptr<const float>(ptab, 0); p.norm1_g = ldptr<const float>(ptab, 1); p.w_in = ldptr<const float>(ptab, 2); p.conv_w = ldptr<const float>(ptab, 3);
    p.sgu_norm_g = ldptr<const float>(ptab, 4); p.sgu_w = ldptr<const float>(ptab, 5); p.sgu_b = ldptr<const float>(ptab, 6); p.pool_w = ldptr<const float>(ptab, 7);
    p.pool_scale = ldptr<const float>(ptab, 8); p.forget_b = ldptr<const float>(ptab, 9); p.w_branch = ldptr<const float>(ptab, 10); p.w_out = ldptr<const float>(ptab, 11);
    p.norm2_g = ldptr<const float>(ptab, 12); p.peer_wq = ldptr<const float>(ptab, 13); p.peer_keys = ldptr<const float>(ptab, 14); p.peer_u = ldptr<const float>(ptab, 15);
    p.peer_v = ldptr<const float>(ptab, 16); p.final_g = ldptr<const float>(ptab, 17); p.out = ldptr<float>(ptab, 18);
    unsigned char* ws = ldptr<unsigned char>(ptab, 19);
    p.WinT = (bf16_t*)(ws + WS_WIN); p.WbT = (bf16_t*)(ws + WS_WB); p.WoT = (bf16_t*)(ws + WS_WO); p.WqT = (bf16_t*)(ws + WS_WQ); p.keysB = (bf16_t*)(ws + WS_KEYS);
    p.uS = (bf16_t*)(ws + WS_U); p.vS = (bf16_t*)(ws + WS_V); p.sguW = (bf16_t*)(ws + WS_SGUW); p.poolWT = (bf16_t*)(ws + WS_POOLW);
    p.wfg = (float*)(ws + WS_WFG); p.h = (float*)(ws + WS_H); p.macc = (float*)(ws + WS_MACC); p.flog = (float*)(ws + WS_FLOG); p.F = (float*)(ws + WS_F); p.pgate = (float*)(ws + WS_PGATE);
    p.xn = (bf16_t*)(ws + WS_XN); p.zmix = (bf16_t*)(ws + WS_ZMIX); p.zgate = (unsigned char*)(ws + WS_ZGATE); p.po = (bf16_t*)(ws + WS_MACC); p.br = (bf16_t*)(ws + WS_BR); p.merged = (bf16_t*)(ws + WS_MERGED); p.q = (bf16_t*)(ws + WS_Q);
    p.pidx = (int*)(ws + WS_PIDX); p.ctl = (unsigned*)(ws + WS_CTL); p.pq = (float*)(ws + WS_PQ); p.aB = (bf16_t*)(ws + WS_AB); p.uS8 = (unsigned char*)(ws + WS_U); p.vS8 = (unsigned char*)(ws + WS_V); p.hn8 = (unsigned char*)(ws + WS_HN8); p.aB8 = (unsigned char*)(ws + WS_AB); p.ssqp = (float*)(ws + WS_SSQP); p.rs2 = (float*)(ws + WS_RS2);
    return p;
}

__global__ void __launch_bounds__(NTHREADS, 2) mega(Args a) {
    extern __shared__ __attribute__((aligned(16))) unsigned char lds_raw[];
    LAS unsigned char* lds = (LAS unsigned char*)lds_raw;
    const int tid = threadIdx.x;
    LAS unsigned long long* ptab = (LAS unsigned long long*)(lds + LDS_PTAB);
    if (tid == 0) {
#pragma unroll
        for (int i = 0; i < 18; ++i) ptab[i] = (unsigned long long)a.in[i];
        ptab[18] = (unsigned long long)a.out; ptab[19] = (unsigned long long)a.ws;
    }
    const int G = gridDim.x;
    const int lo = a.ph_lo, hi = a.ph_hi;
    volatile LAS unsigned* barw = (volatile LAS unsigned*)(lds + LDS_BARW);
    if (tid == 0) { barw[0] = 0u; barw[1] = 0u; barw[2] = 0u; barw[3] = 0u; }
    __syncthreads();
    XcdBarrier bar; bar.bar = (unsigned*)(a.ws + WS_CTL) + CW_BAR; bar.x = 0; bar.st = barw;
    if (hi - lo > 1) bar = xcd_barrier_post((unsigned*)(a.ws + WS_CTL) + CW_BAR, barw);
#define PP const Params p = mkparams(ptab); const int tid_ = ltid(), vb = lbid(), wid = __builtin_amdgcn_readfirstlane(tid_ >> 6), lane = tid_ & 63, gw = vb * NWAVES + wid, ngw = G * NWAVES; (void)lane; (void)gw; (void)ngw
#ifndef KMASK
#define KMASK 0xFFFF
#endif
#define KON(b) (((KMASK) >> (b)) & 1)
#ifndef REPEAT_KIND
#define REPEAT_KIND -1
#endif
#define REPS(k) (((REPEAT_KIND) == (k) || ((k) == 3 && ((REPEAT_KIND) >= 13 && (REPEAT_KIND) <= 17))) ? 2 : 1)
#define REPLOOP(k) for (int rep = 0; rep < REPS(k); ++rep, (rep < REPS(k) ? xcd_barrier(bar) : (void)0))
#define IN(k) (lo <= (k) && (k) < hi)
#define SEAM(k) do { if (IN(k) && IN((k) + 1)) xcd_barrier(bar); } while (0)

    if (KON(0) && IN(0)) REPLOOP(0) { PP; pro::prologue(p, vb, G, lds); }
    SEAM(0);
#pragma unroll 1
    for (int l = 0; l < DEPTH; ++l) {
        const int base = 1 + NPH_LAYER * l;
        if (KON(1) && IN(base + 0)) REPLOOP(1) { PP; norm_phase<true>(p, l, l == 0 ? p.x : p.h, l == 0 ? (const bf16_t*)nullptr : p.po, p.norm1_g + (size_t)l * DM, gw, ngw, lane); }
        SEAM(base + 0);
        if (KON(2) && IN(base + 1)) REPLOOP(2) { PP;
            if (vb >= G - 4) cumsum_head(p, vb - (G - 4), lds);
            pg8::Gemm g{p.xn, p.WinT + (size_t)l * NIN * DM, SEQ, NIN, DM, DM, DM}; pg8::StaticOrder S; S.init(SEQ, NIN, G, vb);
            if (G == 256) S.imax = 6;
            pg8::EpiInproj E{p.zmix, p.zgate, p.ctl + CW_KN + l * 16};
            pg8::gemm_phase<pg8::EpiInproj, pg8::StaticOrder>(lds, g, S, E);
        }
        SEAM(base + 1);
        if (IN(base + 2)) REPLOOP(3) { PP;
            volatile LAS unsigned* misc = (volatile LAS unsigned*)(lds + LDS_MISC);
            unsigned* head = p.ctl + CW_MIXQ + (l * 2 + rep) * 64;
            for (;;) {
                __syncthreads();
                if (tid_ == 0) misc[0] = __hip_atomic_fetch_add(head, 1u, __ATOMIC_RELAXED, __HIP_MEMORY_SCOPE_AGENT);
                __syncthreads();
                int it = (int)misc[0];
                const int nleft = (G == 256) ? 64 : 0;
                if (it >= nleft + 128 + 192) break;
                if (it < nleft) { if (KON(2) && rep == 0) {
                    pg8::Gemm g{p.xn, p.WinT + (size_t)l * NIN * DM, SEQ, NIN, DM, DM, DM}; pg8::StaticOrder S; S.init(SEQ, NIN, G, it); S.i0 = 6; S.imax = 7;
                    pg8::EpiInproj E{p.zmix, p.zgate, p.ctl + CW_KN + l * 16};
                    pg8::gemm_phase<pg8::EpiInproj, pg8::StaticOrder>(lds, g, S, E); }
                    continue; }
                it -= nleft;
                if (it < 128) { if (KON(3) && (rep == 0 || (REPEAT_KIND) != 14)) { const int qb = 31 - (it >> 2), g = it & 3;
                    fa::attn_unit(p.zmix, p.F + (size_t)g * SEQ, p.br, g, qb, (__uint_as_float(__hip_atomic_load(p.ctl + CW_KN + l * 16 + g * 4 + 0, __ATOMIC_RELAXED, __HIP_MEMORY_SCOPE_AGENT)) + __uint_as_float(__hip_atomic_load(p.ctl + CW_KN + l * 16 + g * 4 + 1, __ATOMIC_RELAXED, __HIP_MEMORY_SCOPE_AGENT)) + __uint_as_float(__hip_atomic_load(p.ctl + CW_KN + l * 16 + g * 4 + 2, __ATOMIC_RELAXED, __HIP_MEMORY_SCOPE_AGENT)) + __uint_as_float(__hip_atomic_load(p.ctl + CW_KN + l * 16 + g * 4 + 3, __ATOMIC_RELAXED, __HIP_MEMORY_SCOPE_AGENT))), (LAS char*)lds); } }
                else if (KON(4) && (rep == 0 || (REPEAT_KIND) != 13)) { const int k = it - 128, t0 = (k & 63) * 128;
                    if (k < 64) { if (rep == 0 || (REPEAT_KIND) == 14 || (REPEAT_KIND) == 15) mix::sgu_item(p, l, t0, lds); }
                    else if (k < 128) { if (rep == 0 || (REPEAT_KIND) == 14 || (REPEAT_KIND) == 16) mix::pool_item(p, l, t0, lds); }
                    else { if (rep == 0 || (REPEAT_KIND) == 14 || (REPEAT_KIND) == 17) mix::conv_item(p, l, t0); } }
            }
            __syncthreads();
        }
        SEAM(base + 2);
        if (KON(5) && IN(base + 3)) REPLOOP(5) { PP;
            pg8::Gemm g{p.br, p.WbT + (size_t)l * 4 * DM * BWID, SEQ, DM, BWID, DM, BWID}; pg8::MergeOrder S; S.so.init(SEQ, DM, G, vb);
            pg8::EpiMerge E{p.zgate, p.merged};
            pg8::gemm_phase<pg8::EpiMerge, pg8::MergeOrder>(lds, g, S, E);
        }
        SEAM(base + 3);
        if (KON(6) && IN(base + 4)) { PP;
            pg8::Gemm g{p.merged, p.WoT + (size_t)l * DM * DM, SEQ, DM, DM, DM, DM}; pg8::StaticOrder S; S.init(SEQ, DM, G, vb);
            pg8::EpiResNorm E{l == 0 ? p.x : p.h, l == 0 ? (const bf16_t*)nullptr : p.po, p.h, p.norm2_g + (size_t)l * DM, p.xn, p.hn8, p.ssqp};
            pg8::gemm_phase<pg8::EpiResNorm, pg8::StaticOrder>(lds, g, S, E);
        }
        SEAM(base + 4);
        if (KON(8) && IN(base + 5)) REPLOOP(8) { PP;
            pg8::Gemm g{p.xn, p.WqT + (size_t)l * DM * DM, SEQ, DM, DM, DM, DM}; pg8::StaticOrder S; S.init(SEQ, DM, G, vb);
            pg8::Unit u0; int tab_pm = -1;
            LAS float* rstab = (LAS float*)(lds + LDS_RSTAB);
            if (S.next(0, u0)) { tab_pm = u0.pm; const int rr = tid_ >> 1, hf = tid_ & 1, r = u0.pm * 256 + rr;
                const f32x4* pp = (const f32x4*)(p.ssqp + (size_t)r * 32 + hf * 16); float sm = 0.f;
#pragma unroll
                for (int k = 0; k < 4; ++k) { const f32x4 v = pp[k]; sm += v[0]; sm += v[1]; sm += v[2]; sm += v[3]; }
                const float so = __shfl_xor(sm, 1); const float tot = hf ? (so + sm) : (sm + so);
                const float rs = __builtin_amdgcn_rsqf(tot * (1.f / DM) + EPS);
                if (hf == 0) { rstab[rr] = rs; if (u0.pn == 0) p.rs2[r] = rs; } }
            __syncthreads();
            pg8::EpiScaleBf16 E{p.q, DM, p.ssqp, rstab, tab_pm};
            pg8::gemm_phase<pg8::EpiScaleBf16, pg8::StaticOrder>(lds, g, S, E);
            pg8::Unit u;
            for (int ui = 0; S.next(ui, u); ++ui) { __syncthreads(); peer::topk_item(p, l, u.pm * 256, u.pn, lds); peer::topk_item(p, l, u.pm * 256 + 128, u.pn, lds); }
            __syncthreads();
        }
        SEAM(base + 5);
        if (KON(10) && IN(base + 6)) REPLOOP(10) { PP; peer::gather1_phase(p, l, lds, rep); }
        SEAM(base + 6);
        if (KON(10) && IN(base + 7)) REPLOOP(12) { PP; peer::gather_reduce_phase(p, p.rs2, (size_t)vb * NTHREADS + tid_, (size_t)G * NTHREADS); }
        SEAM(base + 7);
        if (KON(10) && IN(base + 8)) REPLOOP(11) { PP; peer::gather2_phase(p, l, lds, rep); }
        SEAM(base + 8);
    }
    if (KON(11) && IN(NPHASES - 1)) { PP; final_norm_phase(p, gw, ngw, lane); }
#undef IN
#undef SEAM
}

extern "C" void kernel_launch(void* const* d_in, const int* in_sizes, int n_in, void* d_out, int out_size, void* d_ws, size_t ws_size, hipStream_t stream) {
    static int grid = 0;
    if (grid == 0) {
        if (n_in != 18 || out_size != SEQ * DM || ws_size < WS_END) { fprintf(stderr, "kernel_launch: unexpected shapes (n_in %d, out %d, ws %zu < %zu)\n", n_in, out_size, ws_size, (size_t)WS_END); grid = -1; return; }
        int dev = 0, cus = 0;
        if (hipGetDevice(&dev) != hipSuccess || hipDeviceGetAttribute(&cus, hipDeviceAttributeMultiprocessorCount, dev) != hipSuccess) { grid = -1; return; }
        if (hipFuncSetAttribute((const void*)mega, hipFuncAttributeMaxDynamicSharedMemorySize, LDS_BYTES) != hipSuccess) { fprintf(stderr, "kernel_launch: hipFuncSetAttribute failed\n"); grid = -1; return; }
        int per_cu = 0;
        if (hipOccupancyMaxActiveBlocksPerMultiprocessor(&per_cu, (const void*)mega, NTHREADS, LDS_BYTES) != hipSuccess || per_cu < 1) fprintf(stderr, "kernel_launch: occupancy query reports %d\n", per_cu);
        (void)hipGetLastError();
        grid = cus;
    }
    if (grid < 0) return;
    unsigned char* ws = (unsigned char*)d_ws;
    (void)hipMemsetAsync(ws + WS_CTL, 0, CTL_BYTES, stream);
    Args a{};
    for (int i = 0; i < 18; ++i) a.in[i] = (const float*)d_in[i];
    a.out = (float*)d_out; a.ws = ws;
#if N_LAUNCH_MODE == 1
    a.ph_lo = 0; a.ph_hi = NPHASES;
    hipLaunchKernelGGL(mega, dim3(grid), dim3(NTHREADS), LDS_BYTES, stream, a);
#else
    for (int ph = 0; ph < NPHASES; ++ph) { a.ph_lo = ph; a.ph_hi = ph + 1; hipLaunchKernelGGL(mega, dim3(grid), dim3(NTHREADS), LDS_BYTES, stream, a); }
#endif
}
```

```cpp
#include <hip/hip_runtime.h>
#include <cstdio>
#include <cstdint>

#define LAS __attribute__((address_space(3)))
#define GAS __attribute__((address_space(1)))
typedef unsigned short bf16_t;
typedef short bf16x8 __attribute__((ext_vector_type(8)));
typedef short s16x4 __attribute__((ext_vector_type(4)));
typedef float f32x2 __attribute__((ext_vector_type(2)));
typedef float f32x4 __attribute__((ext_vector_type(4)));
typedef float f32x16 __attribute__((ext_vector_type(16)));
typedef unsigned u32x2 __attribute__((ext_vector_type(2)));
typedef unsigned u32x4 __attribute__((ext_vector_type(4)));
typedef long i64x2 __attribute__((ext_vector_type(2)));
typedef int i32x4 __attribute__((ext_vector_type(4)));
typedef int i32x8 __attribute__((ext_vector_type(8)));

#ifndef N_LAUNCH_MODE
#define N_LAUNCH_MODE 1
#endif

constexpr int SEQ = 8192, DM = 2048, DEPTH = 4, BWID = 512;
constexpr int NMIX = 4608, NGATE = 8192, NIN = 12800, INCOLS = 12804;
constexpr int PEER_N = 16384;
constexpr float A_SCALE = 64.f;
constexpr float V_SCALE = 16.f;
constexpr float W8_SCALE = 64.f;
constexpr float X8_SCALE = 8.f;
constexpr float U_SCALE = 64.f;
constexpr int C_A = 0, C_B = 1536, C_C = 2560, C_Q = 3072, C_K = 3584, C_V = 4096;
constexpr float EPS = 1e-6f;
constexpr int NTHREADS = 512, NWAVES = 8;

constexpr size_t al256(size_t x) { return (x + 255) & ~(size_t)255; }
constexpr size_t WS_CTL = 0, CTL_BYTES = 1u << 20;
constexpr size_t WS_WIN = WS_CTL + CTL_BYTES;
constexpr size_t WS_WB = WS_WIN + (size_t)DEPTH * NIN * DM * 2;
constexpr size_t WS_WO = WS_WB + (size_t)DEPTH * 4 * DM * BWID * 2;
constexpr size_t WS_WQ = WS_WO + (size_t)DEPTH * DM * DM * 2;
constexpr size_t WS_KEYS = WS_WQ + (size_t)DEPTH * DM * DM * 2;
constexpr size_t WS_U = WS_KEYS + (size_t)DEPTH * 8 * 2 * 128 * 128 * 2;
constexpr size_t WS_V = WS_U + (size_t)DEPTH * PEER_N * DM * 2;
constexpr size_t WS_SGUW = WS_V + (size_t)DEPTH * PEER_N * DM * 2;
constexpr size_t WS_POOLW = WS_SGUW + (size_t)DEPTH * 4 * 128 * 128 * 2;
constexpr size_t WS_WFG = WS_POOLW + (size_t)DEPTH * 4 * 128 * 128 * 2;
constexpr size_t WS_H = WS_WFG + (size_t)DEPTH * 4 * DM * 4;
constexpr size_t WS_MACC = WS_H + (size_t)SEQ * DM * 4;
constexpr size_t WS_XN = WS_MACC + (size_t)SEQ * DM * 4;
constexpr size_t WS_ZMIX = WS_XN + (size_t)SEQ * DM * 2;
constexpr size_t WS_ZGATE = WS_ZMIX + (size_t)SEQ * NMIX * 2;
constexpr size_t WS_BR = WS_ZGATE + (size_t)SEQ * NGATE * 2;
constexpr size_t WS_MERGED = WS_BR + (size_t)SEQ * DM * 2;
constexpr size_t WS_Q = WS_MERGED + (size_t)SEQ * DM * 2;
constexpr size_t WS_FLOG = WS_Q + (size_t)SEQ * DM * 2;
constexpr size_t WS_F = WS_FLOG + (size_t)SEQ * 4 * 4;
constexpr size_t WS_PIDX = WS_F + (size_t)SEQ * 4 * 4;
constexpr size_t WS_PGATE = WS_PIDX + (size_t)SEQ * 128 * 4;
constexpr size_t WS_PQ = WS_PGATE + (size_t)SEQ * 128 * 4;
constexpr size_t WS_AB = WS_PQ + (size_t)8 * SEQ * 128 * 4;
constexpr size_t WS_HN8 = WS_AB + (size_t)SEQ * 128 * 2;
constexpr size_t WS_SSQP = WS_HN8 + (size_t)SEQ * DM;
constexpr size_t WS_RS2 = WS_SSQP + (size_t)SEQ * 32 * 4;
constexpr size_t WS_END = WS_RS2 + (size_t)SEQ * 4;
static_assert(WS_WB % 256 == 0 && WS_U % 256 == 0 && WS_H % 256 == 0 && WS_ZMIX % 256 == 0 && WS_F % 256 == 0, "ws alignment");

constexpr int LDS_BYTES = 155648;
constexpr int LDS_BARW = LDS_BYTES - 64;

struct Params {
    const float *x, *norm1_g, *w_in, *conv_w, *sgu_norm_g, *sgu_w, *sgu_b, *pool_w, *pool_scale, *forget_b, *w_branch, *w_out, *norm2_g, *peer_wq, *peer_keys, *peer_u, *peer_v, *final_g;
    float* out;
    bf16_t *WinT, *WbT, *WoT, *WqT, *keysB, *uS, *vS, *sguW, *poolWT;
    float *wfg, *h, *macc, *flog, *F, *pgate, *pq;
    bf16_t* aB;
    unsigned char *uS8, *vS8, *hn8, *aB8;
    float *ssqp, *rs2;
    bf16_t *xn, *zmix, *br, *merged, *q;
    bf16_t* po;
    unsigned char* zgate;
    int* pidx;
    unsigned* ctl;
};
struct Args { const float* in[18]; float* out; unsigned char* ws; int ph_lo, ph_hi; };
constexpr int TPW = 16;
constexpr int LDS_PTAB = LDS_BYTES - 256;
constexpr int LDS_RSTAB = 135168;
constexpr int LDS_MISC = LDS_BYTES - 512;
constexpr int CW_MIXQ = 8192;
constexpr int CW_KN = 12288;
constexpr int CW_QCNT = 16384;

__device__ __forceinline__ unsigned f2bf(float f) { unsigned u = __float_as_uint(f); return (u + 0x7fffu + ((u >> 16) & 1u)) >> 16; }
__device__ __forceinline__ unsigned pk2(float lo, float hi) { return f2bf(lo) | (f2bf(hi) << 16); }
__device__ __forceinline__ float bflo(unsigned w) { return __uint_as_float(w << 16); }
__device__ __forceinline__ float bfhi(unsigned w) { return __uint_as_float(w & 0xffff0000u); }
__device__ __forceinline__ float bf1(bf16_t v) { return __uint_as_float((unsigned)v << 16); }
__device__ __forceinline__ unsigned cvtpk(float lo, float hi) { unsigned r; asm volatile("v_cvt_pk_bf16_f32 %0, %1, %2" : "=v"(r) : "v"(lo), "v"(hi)); return r; }
__device__ __forceinline__ float clamp8(float x) { return fminf(fmaxf(x, -448.f), 448.f); }
__device__ __forceinline__ float gelu_t(float x) {
    const float u = x + 0.044715f * x * x * x;
    const float e = __builtin_amdgcn_exp2f(-2.3022081985f * u);
    return x * __builtin_amdgcn_rcpf(1.0f + e);
}
__device__ __forceinline__ float sigmoid_f(float x) { return __builtin_amdgcn_rcpf(1.0f + __builtin_amdgcn_exp2f(-1.4426950409f * x)); }
__device__ __forceinline__ float wave_sum(float v) {
#pragma unroll
    for (int o = 1; o < 64; o <<= 1) v += __shfl_xor(v, o);
    return v;
}
__device__ __forceinline__ unsigned xb_xcc_id() { return (unsigned)__builtin_amdgcn_s_getreg((3 << 11) | 20) & 0xFu; }
__device__ __forceinline__ int ltid() { int t = threadIdx.x; asm volatile("" : "+v"(t)); return t; }
__device__ __forceinline__ int lbid() { int b = blockIdx.x; asm volatile("" : "+s"(b)); return b; }
__device__ __forceinline__ f32x4 mfma16(bf16x8 x, bf16x8 y, f32x4 c) { return __builtin_amdgcn_mfma_f32_16x16x32_bf16(x, y, c, 0, 0, 0); }

namespace pg8 {
constexpr int BM = 256, BK = 64, HALF = 128, HTB = HALF * BK * 2, STAGE_BYTES = 8 * HTB, NXCD = 8, WGM = 8;
__host__ __device__ __forceinline__ int lds_byte(int r, int c) { const int st = (r >> 4) * 2 + (c >> 5), rr = r & 15, cc = c & 31, ob = rr * 64 + cc * 2; return st * 1024 + (ob ^ (((ob >> 9) & 1) << 5)); }
__host__ __device__ __forceinline__ void stage_rc(int b, int& R, int& C) { const int st = b / 1024, sb = b % 1024, swz = sb ^ (((sb >> 9) & 1) << 5); R = (st >> 1) * 16 + swz / 64; C = (st & 1) * 32 + (swz % 64) / 2; }
__host__ __device__ __forceinline__ int perm32(int rho) { const int n = rho >> 4, i = rho & 15; return 8 * (i >> 2) + 4 * n + (i & 3); }

struct Unit { int pm, pn, aco, bro; };
struct Gemm { const bf16_t* A; const bf16_t* Bt; int M, N, K, lda, ldb; };

struct StaticOrder {
    int nM, nN, nwg, G, c, i0, imax;
    __host__ __device__ __forceinline__ void init(int M, int N, int G_, int c_) { nM = M / BM; nN = N / BM; nwg = nM * nN; G = G_; c = c_; i0 = 0; imax = 1 << 30; }
    __host__ __device__ __forceinline__ bool next(int i_, Unit& u) const {
        const int i = i_ + i0; if (i >= imax) return false;
        const long L = (long)i * G + c; if (L >= nwg) return false;
        int wgid = (int)L; { const int q = nwg / NXCD, r = nwg % NXCD, xcd = wgid % NXCD, off = wgid / NXCD; wgid = (xcd < r ? xcd * (q + 1) : r * (q + 1) + (xcd - r) * q) + off; }
        const int nig = WGM * nN, gid = wgid / nig, fm = gid * WGM, gsz = (nM - fm) < WGM ? (nM - fm) : WGM;
        u.pm = fm + ((wgid % nig) % gsz); u.pn = (wgid % nig) / gsz; u.aco = 0; u.bro = 0; return true;
    }
};
struct MergeOrder {
    StaticOrder so;
    __host__ __device__ __forceinline__ bool next(int i, Unit& u) const { if (!so.next(i >> 2, u)) return false; const int n = i & 3; u.aco = n * BWID; u.bro = n * DM; return true; }
};

template <class Epi, class Sched, bool F8 = false>
__device__ __forceinline__ void gemm_phase(LAS unsigned char* lds, const Gemm g, const Sched& S, const Epi& E) {
    const int tid = ltid(), wid = __builtin_amdgcn_readfirstlane(tid >> 6), lane = tid & 63, wr = wid >> 2, wc = wid & 3, fr = lane & 15, fq = lane >> 4;
    const int K = g.K, nt = K / BK;
    const int sc1_ = 0x7f7f7f7f; (void)sc1_;
    unsigned voffA[2], voffB[2];
#pragma unroll
    for (int i = 0; i < 2; ++i) { int R, C; stage_rc(tid * 16 + i * 8192, R, C); const int Rb = Epi::PERM ? ((R & ~31) + perm32(R & 31)) : R;
        voffA[i] = (unsigned)(R * g.lda + C) * 2u; voffB[i] = (unsigned)(Rb * g.ldb + C) * 2u; }
    const size_t kstep = (size_t)(BK * 2);
    const size_t hstepA = (size_t)HALF * g.lda * 2, hstepB = (size_t)HALF * g.ldb * 2;
    const unsigned ldsw = (unsigned)wid * 1024u;
    const int aoff = lds_byte(wr * 64 + fr, fq * 8), boff = lds_byte(wc * 32 + fr, fq * 8);
#define PG8_UA(u) ((const char*)g.A + ((size_t)(u).pm * BM * g.lda + (size_t)(u).aco) * 2)
#define PG8_UB(u) ((const char*)g.Bt + ((size_t)((u).pn * BM + (u).bro) * g.ldb) * 2)
#define PG8_SA(b, h) (((b) * 2 + (h)) * HTB)
#define PG8_SB(b, h) ((4 + (b) * 2 + (h)) * HTB)
#define PG8_STAGE(bufoff, gbase, voff) do { _Pragma("unroll") for (int _i = 0; _i < 2; ++_i) \
        __builtin_amdgcn_global_load_lds((const unsigned*)((const char*)(gbase) + (voff)[_i]), (LAS unsigned*)(lds + (bufoff) + ldsw + _i * 8192), 16, 0, 0); } while (0)
#define PG8_LDA(dst, b, h) do { _Pragma("unroll") for (int m = 0; m < 4; ++m) _Pragma("unroll") for (int k = 0; k < 2; ++k) dst[m][k] = *(const LAS bf16x8*)(lds + PG8_SA(b, h) + aoff + m * 2048 + k * 1024); } while (0)
#define PG8_LDB(dst, b, h) do { _Pragma("unroll") for (int n = 0; n < 2; ++n) _Pragma("unroll") for (int k = 0; k < 2; ++k) dst[n][k] = *(const LAS bf16x8*)(lds + PG8_SB(b, h) + boff + n * 2048 + k * 1024); } while (0)
#define PG8_V8(x) __builtin_shufflevector(__builtin_bit_cast(i32x4, (x)[0]), __builtin_bit_cast(i32x4, (x)[1]), 0, 1, 2, 3, 4, 5, 6, 7)
#define PG8_MMA(ai, bj, At, Bt) do { __builtin_amdgcn_s_setprio(1); _Pragma("unroll") for (int m = 0; m < 4; ++m) _Pragma("unroll") for (int n = 0; n < 2; ++n) { \
        if constexpr (F8) { const i32x8 b8_ = PG8_V8(Bt[n]), a8_ = PG8_V8(At[m]);     \
            asm volatile("v_mfma_scale_f32_16x16x128_f8f6f4 %0, %1, %2, %0, %3, %3 op_sel_hi:[0,0,0]" : "+v"(acc[ai][bj][m][n]) : "v"(b8_), "v"(a8_), "v"(sc1_)); } \
        else { _Pragma("unroll") for (int k = 0; k < 2; ++k) acc[ai][bj][m][n] = __builtin_amdgcn_mfma_f32_16x16x32_bf16(Bt[n][k], At[m][k], acc[ai][bj][m][n], 0, 0, 0); } } \
        __builtin_amdgcn_s_setprio(0); } while (0)
#define PG8_WAIT_V(n) asm volatile("s_waitcnt vmcnt(" #n ")" ::: "memory")
#define PG8_WAIT_L(n) asm volatile("s_waitcnt lgkmcnt(" #n ")" ::: "memory")
#define PG8_BAR __builtin_amdgcn_s_barrier()
#define PG8_SCHED __builtin_amdgcn_sched_barrier(0)
    Unit cur, nxt; int ui = 0;
    if (!S.next(0, cur)) return;
    f32x4 acc[2][2][4][2];
#pragma unroll
    for (int a = 0; a < 2; ++a)
#pragma unroll
        for (int b = 0; b < 2; ++b)
#pragma unroll
            for (int m = 0; m < 4; ++m)
#pragma unroll
                for (int n = 0; n < 2; ++n) acc[a][b][m][n] = (f32x4){0.f, 0.f, 0.f, 0.f};
    bf16x8 At[4][2], B0[2][2], B1[2][2];
    const char* cA = PG8_UA(cur); const char* cB = PG8_UB(cur);
    PG8_STAGE(PG8_SB(0, 0), cB, voffB); PG8_STAGE(PG8_SB(0, 1), cB + hstepB, voffB); PG8_STAGE(PG8_SA(0, 0), cA, voffA); PG8_STAGE(PG8_SA(0, 1), cA + hstepA, voffA);
    if (wr == 1) PG8_BAR;
    PG8_WAIT_V(2); PG8_BAR;
    PG8_STAGE(PG8_SB(1, 0), cB + kstep, voffB); PG8_STAGE(PG8_SA(1, 0), cA + kstep, voffA); PG8_STAGE(PG8_SB(1, 1), cB + hstepB + kstep, voffB);
    PG8_WAIT_V(6); PG8_BAR;
    for (;;) {
        const bool has_next = S.next(ui + 1, nxt);
        const char* nA = has_next ? PG8_UA(nxt) : cA; const char* nB = has_next ? PG8_UB(nxt) : cB;
        for (int t = 0; t < nt; t += 2) {
            const bool last = (t == nt - 2);
            const char* a1 = cA + (size_t)(t + 1) * kstep;
            const char* a2 = last ? nA : cA + (size_t)(t + 2) * kstep; const char* b2 = last ? nB : cB + (size_t)(t + 2) * kstep;
            const char* a3 = a2 + kstep; const char* b3 = b2 + kstep;
            PG8_LDB(B0, 0, 0); PG8_LDB(B1, 0, 1); PG8_SCHED; PG8_LDA(At, 0, 0); PG8_STAGE(PG8_SA(1, 1), a1 + hstepA, voffA);
            PG8_WAIT_V(8); PG8_WAIT_L(0); PG8_BAR; PG8_MMA(0, 0, At, B0); PG8_MMA(0, 1, At, B1); PG8_BAR; PG8_SCHED;
            PG8_LDA(At, 0, 1); PG8_STAGE(PG8_SB(0, 0), b2, voffB); PG8_STAGE(PG8_SB(0, 1), b2 + hstepB, voffB); PG8_STAGE(PG8_SA(0, 0), a2, voffA);
            PG8_WAIT_V(8); PG8_WAIT_L(0); PG8_BAR; PG8_MMA(1, 0, At, B0); PG8_MMA(1, 1, At, B1); PG8_BAR; PG8_SCHED;
            PG8_LDB(B0, 1, 0); PG8_LDB(B1, 1, 1); PG8_SCHED; PG8_LDA(At, 1, 0); PG8_STAGE(PG8_SA(0, 1), a2 + hstepA, voffA);
            PG8_WAIT_V(8); PG8_WAIT_L(0); PG8_BAR; PG8_MMA(0, 0, At, B0); PG8_MMA(0, 1, At, B1); PG8_BAR; PG8_SCHED;
            PG8_LDA(At, 1, 1); PG8_STAGE(PG8_SB(1, 0), b3, voffB); PG8_STAGE(PG8_SB(1, 1), b3 + hstepB, voffB); PG8_STAGE(PG8_SA(1, 0), a3, voffA);
            PG8_WAIT_V(8); PG8_WAIT_L(0); PG8_BAR; PG8_MMA(1, 0, At, B0); PG8_MMA(1, 1, At, B1); PG8_BAR; PG8_SCHED;
        }
        if (wr == 0) PG8_BAR;
        if constexpr (F8) asm volatile("s_nop 15\n\ts_nop 15" ::: "memory");
        bool keep = false;
        if constexpr (Epi::HORNER) keep = E.scale(acc, cur, wr, wc, fr, fq); else E(acc, cur, wr, wc, fr, fq);
        if (!has_next) break;
        if (!keep) {
#pragma unroll
        for (int a = 0; a < 2; ++a)
#pragma unroll
            for (int b = 0; b < 2; ++b)
#pragma unroll
                for (int m = 0; m < 4; ++m)
#pragma unroll
                    for (int n = 0; n < 2; ++n) acc[a][b][m][n] = (f32x4){0.f, 0.f, 0.f, 0.f};
        }
        cur = nxt; cA = nA; cB = nB; ++ui;
        if (wr == 1) PG8_BAR;
    }
    PG8_WAIT_V(0);
    PG8_BAR;
#undef PG8_UA
#undef PG8_UB
#undef PG8_SA
#undef PG8_SB
#undef PG8_STAGE
#undef PG8_LDA
#undef PG8_LDB
#undef PG8_MMA
#undef PG8_V8
#undef PG8_WAIT_V
#undef PG8_WAIT_L
#undef PG8_BAR
#undef PG8_SCHED
}

__device__ __forceinline__ size_t gate_off(int row, int gcol) { return ((size_t)(row >> 4) * (NGATE / 32) + (size_t)(gcol >> 5)) * 512 + (size_t)((row & 15) * 32 + (gcol & 31)); }
struct EpiInproj {
    static constexpr bool PERM = true; static constexpr bool HORNER = false;
    int pn0; float zs;
    bf16_t* zmix; unsigned char* zgate; unsigned* kn;
    __device__ __forceinline__ void operator()(const f32x4 (&acc)[2][2][4][2], const Unit& u, int wr, int wc, int fr, int fq) const {
        const int pnt = u.pn + pn0;
        if (pnt == C_K / BM || pnt == C_K / BM + 1) {
#pragma unroll
            for (int bj = 0; bj < 2; ++bj) { float mx = 0.f;
#pragma unroll
                for (int ai = 0; ai < 2; ++ai)
#pragma unroll
                    for (int m = 0; m < 4; ++m) { const f32x4 a = acc[ai][bj][m][0], b = acc[ai][bj][m][1];
                        float q2 = (a[0] * a[0] + a[1] * a[1]) + (a[2] * a[2] + a[3] * a[3]) + (b[0] * b[0] + b[1] * b[1]) + (b[2] * b[2] + b[3] * b[3]);
                        q2 += __shfl_xor(q2, 16); q2 += __shfl_xor(q2, 32); mx = fmaxf(mx, q2); }
#pragma unroll
                for (int o = 1; o < 16; o <<= 1) mx = fmaxf(mx, __shfl_xor(mx, o));
                if ((threadIdx.x & 63) == 0) atomicMax(kn + ((pnt - C_K / BM) * 2 + bj) * 4 + wc, __float_as_uint(mx)); }
        }
        const int row0 = u.pm * BM + wr * 64 + fr; int colt = pnt * BM; const bool gate = colt >= NMIX;
        if (gate) {
            const int col0 = colt - NMIX + wc * 32 + 8 * fq;
#pragma unroll
            for (int ai = 0; ai < 2; ++ai)
#pragma unroll
                for (int m = 0; m < 4; ++m) { const int grow = row0 + ai * HALF + m * 16;
#pragma unroll
                    for (int bj = 0; bj < 2; ++bj) { const f32x4 v0 = acc[ai][bj][m][0], v1 = acc[ai][bj][m][1]; unsigned w0 = 0u, w1 = 0u;
#pragma unroll
                        for (int e = 0; e < 4; ++e) { w0 = __builtin_amdgcn_cvt_pk_u8_f32(__builtin_truncf(sigmoid_f(v0[e] * zs) * 255.f + 0.5f), e, w0);
                                                      w1 = __builtin_amdgcn_cvt_pk_u8_f32(__builtin_truncf(sigmoid_f(v1[e] * zs) * 255.f + 0.5f), e, w1); }
                        *(u32x2*)(zgate + gate_off(grow, col0 + bj * HALF)) = (u32x2){w0, w1}; } }
            return;
        }
        bf16_t* base = zmix; const int ldc = NMIX;
        const int col0 = colt + wc * 32 + 8 * fq;
#pragma unroll
        for (int ai = 0; ai < 2; ++ai)
#pragma unroll
            for (int m = 0; m < 4; ++m) { bf16_t* rowp = base + (size_t)(row0 + ai * HALF + m * 16) * ldc + col0;
#pragma unroll
                for (int bj = 0; bj < 2; ++bj) { const f32x4 v0 = acc[ai][bj][m][0], v1 = acc[ai][bj][m][1];
                    u32x4 w; w.x = cvtpk(v0[0], v0[1]); w.y = cvtpk(v0[2], v0[3]); w.z = cvtpk(v1[0], v1[1]); w.w = cvtpk(v1[2], v1[3]);
                    *(u32x4*)(rowp + bj * HALF) = w; } }
    }
};
struct EpiBf16 {
    static constexpr bool PERM = true; static constexpr bool HORNER = false;
    bf16_t* O; int ldc;
    __device__ __forceinline__ void operator()(const f32x4 (&acc)[2][2][4][2], const Unit& u, int wr, int wc, int fr, int fq) const {
        const int row0 = u.pm * BM + wr * 64 + fr; const int col0 = u.pn * BM + wc * 32 + 8 * fq;
#pragma unroll
        for (int ai = 0; ai < 2; ++ai)
#pragma unroll
            for (int m = 0; m < 4; ++m) { bf16_t* rowp = O + (size_t)(row0 + ai * HALF + m * 16) * ldc + col0;
#pragma unroll
                for (int bj = 0; bj < 2; ++bj) { const f32x4 v0 = acc[ai][bj][m][0], v1 = acc[ai][bj][m][1];
                    u32x4 w; w.x = cvtpk(v0[0], v0[1]); w.y = cvtpk(v0[2], v0[3]); w.z = cvtpk(v1[0], v1[1]); w.w = cvtpk(v1[2], v1[3]);
                    *(u32x4*)(rowp + bj * HALF) = w; } }
    }
};
struct EpiMerge {
    static constexpr bool PERM = true; static constexpr bool HORNER = true;
    const unsigned char* G; bf16_t* merged;
    __device__ __forceinline__ bool scale(f32x4 (&acc)[2][2][4][2], const Unit& u, int wr, int wc, int fr, int fq) const {
        const int n = u.aco >> 9; const int col0 = u.pn * BM + wc * 32 + 8 * fq; const bool last = (n == 3);
#pragma unroll
        for (int ai = 0; ai < 2; ++ai) {
            u32x2 gw[4][2], gx[4][2];
#pragma unroll
            for (int m = 0; m < 4; ++m) { const int r = u.pm * BM + ai * HALF + wr * 64 + m * 16 + fr;
#pragma unroll
                for (int bj = 0; bj < 2; ++bj) { const int c = col0 + bj * HALF;
                    gw[m][bj] = *(const u32x2*)(G + gate_off(r, n * DM + c));
                    gx[m][bj] = last ? gw[m][bj] : *(const u32x2*)(G + gate_off(r, (n + 1) * DM + c)); } }
#pragma unroll
            for (int m = 0; m < 4; ++m) { const int r = u.pm * BM + ai * HALF + wr * 64 + m * 16 + fr;
#pragma unroll
                for (int bj = 0; bj < 2; ++bj) { const int c = col0 + bj * HALF; const u32x2 g = gw[m][bj], x = gx[m][bj];
                    f32x4 v0 = acc[ai][bj][m][0], v1 = acc[ai][bj][m][1];
#pragma unroll
                    for (int e = 0; e < 4; ++e) {
                        const float k0 = fmaxf((float)((g.x >> (8 * e)) & 0xffu), 1.f), k1 = fmaxf((float)((g.y >> (8 * e)) & 0xffu), 1.f);
                        const float d0 = last ? (1.f / 255.f) : __builtin_amdgcn_rcpf(fmaxf((float)((x.x >> (8 * e)) & 0xffu), 1.f));
                        const float d1 = last ? (1.f / 255.f) : __builtin_amdgcn_rcpf(fmaxf((float)((x.y >> (8 * e)) & 0xffu), 1.f));
                        v0[e] *= k0 * d0; v1[e] *= k1 * d1; }
                    if (last) { u32x4 w; w.x = cvtpk(v0[0], v0[1]); w.y = cvtpk(v0[2], v0[3]); w.z = cvtpk(v1[0], v1[1]); w.w = cvtpk(v1[2], v1[3]);
                        *(u32x4*)(merged + (size_t)r * DM + c) = w; }
                    else { acc[ai][bj][m][0] = v0; acc[ai][bj][m][1] = v1; } } }
        }
        return !last;
    }
};
struct EpiResNorm {
    static constexpr bool PERM = true; static constexpr bool HORNER = false;
    const float* base; const bf16_t* po; float* h; const float* gain; bf16_t* xn; unsigned char* hn8; float* part;
    __device__ __forceinline__ void operator()(const f32x4 (&acc)[2][2][4][2], const Unit& u, int wr, int wc, int fr, int fq) const {
        const int col0 = u.pn * BM + wc * 32 + 8 * fq;
        f32x4 gv[2][2];
#pragma unroll
        for (int bj = 0; bj < 2; ++bj) { gv[bj][0] = *(const f32x4*)(gain + col0 + bj * HALF); gv[bj][1] = *(const f32x4*)(gain + col0 + bj * HALF + 4); }
#pragma unroll
        for (int ai = 0; ai < 2; ++ai)
#pragma unroll
            for (int mp2 = 0; mp2 < 2; ++mp2) {
                f32x4 bv[2][2][2]; u32x4 pv[2][2];
#pragma unroll
                for (int mm = 0; mm < 2; ++mm) { const int r = u.pm * BM + ai * HALF + wr * 64 + (mp2 * 2 + mm) * 16 + fr;
#pragma unroll
                    for (int bj = 0; bj < 2; ++bj) { const f32x4* bp = (const f32x4*)(base + (size_t)r * DM + col0 + bj * HALF); bv[mm][bj][0] = bp[0]; bv[mm][bj][1] = bp[1];
                        pv[mm][bj] = (u32x4){0u, 0u, 0u, 0u}; if (po) pv[mm][bj] = *(const u32x4*)(po + (size_t)r * DM + col0 + bj * HALF); } }
#pragma unroll
                for (int mm = 0; mm < 2; ++mm) { const int m = mp2 * 2 + mm; const int r = u.pm * BM + ai * HALF + wr * 64 + m * 16 + fr; float q2 = 0.f;
#pragma unroll
                    for (int bj = 0; bj < 2; ++bj) { const size_t off = (size_t)r * DM + col0 + bj * HALF; const u32x4 pw_ = pv[mm][bj];
                        const f32x4 v0 = bv[mm][bj][0] + acc[ai][bj][m][0] + (f32x4){bflo(pw_.x), bfhi(pw_.x), bflo(pw_.y), bfhi(pw_.y)}, v1 = bv[mm][bj][1] + acc[ai][bj][m][1] + (f32x4){bflo(pw_.z), bfhi(pw_.z), bflo(pw_.w), bfhi(pw_.w)};
                        f32x4* hp = (f32x4*)(h + off); hp[0] = v0; hp[1] = v1;
                        q2 += (v0[0] * v0[0] + v0[1] * v0[1]) + (v0[2] * v0[2] + v0[3] * v0[3]) + (v1[0] * v1[0] + v1[1] * v1[1]) + (v1[2] * v1[2] + v1[3] * v1[3]);
                        const f32x4 y0 = v0 * gv[bj][0], y1 = v1 * gv[bj][1];
                        int f0 = __builtin_amdgcn_cvt_pk_fp8_f32(clamp8(y0[0]), clamp8(y0[1]), 0, false); f0 = __builtin_amdgcn_cvt_pk_fp8_f32(clamp8(y0[2]), clamp8(y0[3]), f0, true);
                        int f1 = __builtin_amdgcn_cvt_pk_fp8_f32(clamp8(y1[0]), clamp8(y1[1]), 0, false); f1 = __builtin_amdgcn_cvt_pk_fp8_f32(clamp8(y1[2]), clamp8(y1[3]), f1, true);
                        *(u32x2*)(hn8 + off) = (u32x2){(unsigned)f0, (unsigned)f1}; }
                    q2 += __shfl_xor(q2, 16); q2 += __shfl_xor(q2, 32);
                    if (fq == 0) part[(size_t)r * 32 + u.pn * 4 + wc] = q2; }
            }
    }
};
__device__ __forceinline__ float row_rs(const float* part, int r) {
    const f32x4* pp = (const f32x4*)(part + (size_t)r * 32); float s = 0.f;
#pragma unroll
    for (int k = 0; k < 8; ++k) { const f32x4 v = pp[k]; s += v[0]; s += v[1]; s += v[2]; s += v[3]; }
    return __builtin_amdgcn_rsqf(s * (1.f / DM) + EPS);
}
struct EpiScaleBf16 {
    static constexpr bool PERM = true; static constexpr bool HORNER = false;
    bf16_t* O; int ldc; const float* part; const LAS float* rstab; int tab_pm; float osc;
    __device__ __forceinline__ void operator()(const f32x4 (&acc)[2][2][4][2], const Unit& u, int wr, int wc, int fr, int fq) const {
        const int row0 = u.pm * BM + wr * 64 + fr; const int col0 = u.pn * BM + wc * 32 + 8 * fq;
#pragma unroll
        for (int ai = 0; ai < 2; ++ai)
#pragma unroll
            for (int m = 0; m < 4; ++m) { const int r = row0 + ai * HALF + m * 16; bf16_t* rowp = O + (size_t)r * ldc + col0;
                const float rs = ((u.pm == tab_pm) ? rstab[r - u.pm * BM] : row_rs(part, r)) * osc;
#pragma unroll
                for (int bj = 0; bj < 2; ++bj) { const f32x4 v0 = acc[ai][bj][m][0] * rs, v1 = acc[ai][bj][m][1] * rs;
                    u32x4 w; w.x = cvtpk(v0[0], v0[1]); w.y = cvtpk(v0[2], v0[3]); w.z = cvtpk(v1[0], v1[1]); w.w = cvtpk(v1[2], v1[3]);
                    *(u32x4*)(rowp + bj * HALF) = w; } }
    }
};
}

namespace fa {
constexpr float SCALE = 0.08838834764831845f, INV_SCALE = 11.313708498984761f, THR = 8.f;
constexpr int QBLK = 32, KVBLK = 64, QB = 256;
constexpr int SHM_V = KVBLK * 128 * 2, SHM_K = KVBLK * 128 * 2;
constexpr int OFF_V = 0, OFF_K = 2 * SHM_V, OFF_FK = OFF_K + 2 * SHM_K, OFF_WS = OFF_FK + 2 * 64 * 4;
#define KSWZ(row, colB) ((row) * 256 + ((colB) ^ (((row) & 7) << 4)))
#define SBAR() __builtin_amdgcn_sched_barrier(0)
__device__ __forceinline__ int v_st(int k, int c) { const int kk = (k & ~0xC) | ((k & 4) << 1) | ((k & 8) >> 1); return ((kk >> 3) * 4 + (c >> 5)) * 512 + ((kk & 7) * 32 + (c & 31)) * 2; }
__device__ __forceinline__ int v_rd_base(int lane) { return ((lane & 3) << 3) | (((lane >> 2) & 3) << 6) | (((lane >> 4) & 1) << 5) | (((lane >> 5) & 1) << 8); }
constexpr int v_rd_off(int d0, int ks, int half) { return d0 * 512 + ks * 4096 + half * 2048; }
__device__ __forceinline__ int crow(int r, int hi) { return (r & 3) + 8 * (r >> 2) + 4 * hi; }
__device__ __forceinline__ void mask_tile(f32x16& p0, f32x16& p1, int dq) {
    const float NEG = -__builtin_inff();
#pragma unroll
    for (int r = 0; r < 16; ++r) {
        const int c = (r & 3) + 8 * (r >> 2);
        if (dq - c < 0) p0[r] = NEG;
        if (dq - c - 32 < 0) p1[r] = NEG;
    }
}
__device__ __forceinline__ void partialSM(f32x16& p0, f32x16& p1, float& m_reg, float& mn, float& alpha) {
    float pmax = p0[0];
#pragma unroll
    for (int r = 1; r < 16; ++r) pmax = fmaxf(pmax, p0[r]);
#pragma unroll
    for (int r = 0; r < 16; ++r) pmax = fmaxf(pmax, p1[r]);
    { auto rr = __builtin_amdgcn_permlane32_swap(__float_as_uint(pmax), __float_as_uint(pmax), false, false);
      pmax = fmaxf(__uint_as_float(rr[0]), __uint_as_float(rr[1])); }
    constexpr float C2 = 1.4426950408889634f * SCALE;
    if (__builtin_expect(__all((pmax - m_reg) * SCALE <= THR), 1)) { mn = m_reg; alpha = 1.f; }
    else { mn = fmaxf(m_reg, pmax); alpha = __builtin_amdgcn_exp2f((m_reg - mn) * C2); m_reg = mn; }
    const float mnL = -mn * C2;
#pragma unroll
    for (int r = 0; r < 16; ++r) p0[r] = fmaf(p0[r], C2, mnL);
#pragma unroll
    for (int r = 0; r < 16; ++r) p1[r] = fmaf(p1[r], C2, mnL);
#pragma unroll
    for (int r = 0; r < 16; ++r) p0[r] = __builtin_amdgcn_exp2f(p0[r]);
}
__device__ __forceinline__ void finishSM(f32x16& p0, f32x16& p1, float alpha, float& l_reg, bf16x8& pa0, bf16x8& pa1, bf16x8& pa2, bf16x8& pa3) {
#pragma unroll
    for (int r = 0; r < 16; ++r) p1[r] = __builtin_amdgcn_exp2f(p1[r]);
    float ps = 0;
#pragma unroll
    for (int r = 0; r < 16; ++r) ps += p0[r];
#pragma unroll
    for (int r = 0; r < 16; ++r) ps += p1[r];
    { auto rr = __builtin_amdgcn_permlane32_swap(__float_as_uint(ps), __float_as_uint(ps), false, false);
      ps = __uint_as_float(rr[0]) + __uint_as_float(rr[1]); }
    l_reg = l_reg * alpha + ps;
#define PK4(P, B_, OUT) do { unsigned a0 = cvtpk(P[B_+0], P[B_+1]), a1 = cvtpk(P[B_+2], P[B_+3]);                          \
        unsigned b0 = cvtpk(P[B_+4], P[B_+5]), b1 = cvtpk(P[B_+6], P[B_+7]);                                             \
        auto r0 = __builtin_amdgcn_permlane32_swap(a0, b0, false, false); auto r1 = __builtin_amdgcn_permlane32_swap(a1, b1, false, false); \
        u32x4 w = {r0[0], r1[0], r0[1], r1[1]}; OUT = *reinterpret_cast<bf16x8*>(&w); } while (0)
    PK4(p0, 0, pa0); PK4(p0, 8, pa1); PK4(p1, 0, pa2); PK4(p1, 8, pa3);
#undef PK4
}
__device__ __forceinline__ void qkt(f32x16& p0, f32x16& p1, const LAS char* kbuf, const LAS float* fk, float Fq, int r32, int hi, const bf16x8* qr) {
#pragma unroll
    for (int a = 0; a < 4; ++a) { const f32x4 f0 = *(const LAS f32x4*)(fk + 8 * a + 4 * hi), f1 = *(const LAS f32x4*)(fk + 32 + 8 * a + 4 * hi);
#pragma unroll
        for (int b = 0; b < 4; ++b) { p0[4 * a + b] = (Fq - f0[b]) * INV_SCALE; p1[4 * a + b] = (Fq - f1[b]) * INV_SCALE; } }
    const LAS char* kb[4];
#pragma unroll
    for (int dd = 0; dd < 4; ++dd) kb[dd] = kbuf + KSWZ(r32, (dd * 16 + hi * 8) * 2);
#pragma unroll
    for (int d0 = 0; d0 < 8; ++d0) { const LAS char* a = kb[d0 & 3] + (d0 >> 2) * 128;
        bf16x8 b0 = *reinterpret_cast<const LAS bf16x8*>(a);
        bf16x8 b1 = *reinterpret_cast<const LAS bf16x8*>(a + 32 * 256);
        p0 = __builtin_amdgcn_mfma_f32_32x32x16_bf16(b0, qr[d0], p0, 0, 0, 0);
        p1 = __builtin_amdgcn_mfma_f32_32x32x16_bf16(b1, qr[d0], p1, 0, 0, 0); }
}
__device__ __forceinline__ void pv_tile(f32x16* o, int vb0, bf16x8 pa0, bf16x8 pa1, bf16x8 pa2, bf16x8 pa3) {
#define TRRD(dst, off) asm volatile("ds_read_b64_tr_b16 %0, %1 offset:%2" : "=&v"(dst) : "v"(vb0), "i"(off) : "memory")
#define PV_D0(d0) do { s16x4 l0, l1, l2, l3, h0, h1, h2, h3; constexpr int b_ = v_rd_off(d0, 0, 0); \
        TRRD(l0, b_); TRRD(h0, b_ + 2048); TRRD(l1, b_ + 4096); TRRD(h1, b_ + 6144); TRRD(l2, b_ + 8192); TRRD(h2, b_ + 10240); TRRD(l3, b_ + 12288); TRRD(h3, b_ + 14336); \
        asm volatile("s_waitcnt lgkmcnt(0)" ::: "memory"); SBAR();   \
        o[d0] = __builtin_amdgcn_mfma_f32_32x32x16_bf16(pa0, (bf16x8){l0[0], l0[1], l0[2], l0[3], h0[0], h0[1], h0[2], h0[3]}, o[d0], 0, 0, 0);   \
        o[d0] = __builtin_amdgcn_mfma_f32_32x32x16_bf16(pa1, (bf16x8){l1[0], l1[1], l1[2], l1[3], h1[0], h1[1], h1[2], h1[3]}, o[d0], 0, 0, 0);   \
        o[d0] = __builtin_amdgcn_mfma_f32_32x32x16_bf16(pa2, (bf16x8){l2[0], l2[1], l2[2], l2[3], h2[0], h2[1], h2[2], h2[3]}, o[d0], 0, 0, 0);   \
        o[d0] = __builtin_amdgcn_mfma_f32_32x32x16_bf16(pa3, (bf16x8){l3[0], l3[1], l3[2], l3[3], h3[0], h3[1], h3[2], h3[3]}, o[d0], 0, 0, 0); } while (0)
    PV_D0(0); PV_D0(1); PV_D0(2); PV_D0(3);
#undef PV_D0
#undef TRRD
}
__device__ __forceinline__ void attn_unit(const bf16_t* __restrict__ zmix, const float* __restrict__ Fh, bf16_t* __restrict__ br, int g, int qb, float kn2, LAS char* lds) {
    const int tid = ltid(), wid = __builtin_amdgcn_readfirstlane(tid >> 6), lane = tid & 63, r32 = lane & 31, hi = lane >> 5;
    const bf16_t* Zq = zmix + C_Q + g * 128; const bf16_t* Zk = zmix + C_K + g * 128; const bf16_t* Zv = zmix + C_V + g * 128;
    const int P0 = qb * QB, j_hi = (P0 + QB) / KVBLK;
    const int qlo = P0 + wid * QBLK, qm = qlo + r32 - 4 * hi;
    LAS char* V_lds = lds + OFF_V; LAS char* K_lds = lds + OFF_K; LAS float* FK_lds = (LAS float*)(lds + OFF_FK);
    LAS float* wsf = (LAS float*)(lds + OFF_WS) + wid * 64; LAS float* li_l = wsf; LAS float* al_l = wsf + 32;
    bf16x8 qr[8];
#pragma unroll
    for (int d0 = 0; d0 < 8; ++d0) qr[d0] = *(const bf16x8*)(Zq + (size_t)(qlo + r32) * NMIX + d0 * 16 + hi * 8);
    const float Fq = Fh[qlo + r32];
    int j_lo; float qrow2;
    {
        float qs = 0.f;
#pragma unroll
        for (int d0 = 0; d0 < 8; ++d0)
#pragma unroll
            for (int e = 0; e < 8; ++e) { const float v = bf1((bf16_t)qr[d0][e]); qs = fmaf(v, v, qs); }
        { auto rr = __builtin_amdgcn_permlane32_swap(__float_as_uint(qs), __float_as_uint(qs), false, false); qs = __uint_as_float(rr[0]) + __uint_as_float(rr[1]); }
        qrow2 = qs;
#pragma unroll
        for (int o_ = 1; o_ < 32; o_ <<= 1) qs = fmaxf(qs, __shfl_xor(qs, o_));
        LAS float* red = (LAS float*)(lds + OFF_WS);
        __syncthreads();
        if (lane == 0) red[wid] = qs;
        __syncthreads();
        float qn2 = red[0];
#pragma unroll
        for (int w = 1; w < 8; ++w) qn2 = fmaxf(qn2, red[w]);
        const float B2 = 2.f * sqrtf(qn2 * kn2) * SCALE * 1.01f + 0.5f;
        const float thr = -18.f - B2 - Fh[P0];
        const int ndiag0 = P0 / KVBLK;
        int cntskip = 0;
        if (tid < 128) { const bool sk = (tid < ndiag0) && (-Fh[tid * KVBLK + KVBLK - 1] < thr); const unsigned long long bal = __ballot(sk); cntskip = __popcll(bal); }
        __syncthreads();
        if (tid == 0 || tid == 64) red[8 + (tid >> 6)] = (float)cntskip;
        __syncthreads();
        j_lo = (int)(red[8] + red[9]);
        __syncthreads();
    }
    float m_reg = -1e30f, l_reg = 0.f; f32x16 o[4];
#pragma unroll
    for (int d = 0; d < 4; ++d)
#pragma unroll
        for (int r = 0; r < 16; ++r) o[d][r] = 0.f;
    const int sr = tid >> 4, sc = (tid & 15) * 8, vst0 = v_st(sr, sc), vst1 = v_st(32 + sr, sc), kws = KSWZ(sr, sc * 2);
    const int vbase = (int)(uintptr_t)V_lds + v_rd_base(lane);
    bf16x8 st_k0, st_k1, st_v0, st_v1; float st_f = 0.f;
#define SLOAD(kb) do { st_k0 = *(const bf16x8*)(Zk + (size_t)((kb) + sr) * NMIX + sc); st_k1 = *(const bf16x8*)(Zk + (size_t)((kb) + 32 + sr) * NMIX + sc); \
                       st_v0 = *(const bf16x8*)(Zv + (size_t)((kb) + sr) * NMIX + sc); st_v1 = *(const bf16x8*)(Zv + (size_t)((kb) + 32 + sr) * NMIX + sc); \
                       if (tid < 64) st_f = Fh[(kb) + tid]; } while (0)
#define SWRITE(bf) do { *(LAS bf16x8*)(K_lds + (bf) * SHM_K + kws) = st_k0; *(LAS bf16x8*)(K_lds + (bf) * SHM_K + kws + 32 * 256) = st_k1; \
                        *(LAS bf16x8*)(V_lds + (bf) * SHM_V + vst0) = st_v0; *(LAS bf16x8*)(V_lds + (bf) * SHM_V + vst1) = st_v1; \
                        if (tid < 64) FK_lds[(bf) * 64 + tid] = st_f; } while (0)
    const float cbase = -(sqrtf(qrow2 * kn2) * SCALE * 1.01f + 0.25f) - Fq;
    LAS float* stopm = (LAS float*)(lds + OFF_WS + 2048);
    __syncthreads();
    int j = j_hi - 1;
    SLOAD(j * KVBLK); SWRITE(0);
    __syncthreads();
    f32x16 p0, p1; float mn, alpha; bf16x8 pa0, pa1, pa2, pa3;
    for (int t = 0;; ++t) {
        const int buf = t & 1, kb = j * KVBLK; const bool has_next = j > j_lo;
        if (has_next) SLOAD(kb - KVBLK);
        if (kb <= qlo + QBLK - 1) {
            qkt(p0, p1, K_lds + buf * SHM_K, FK_lds + buf * 64, Fq, r32, hi, qr);
            if (kb + KVBLK - 1 > qlo) mask_tile(p0, p1, qm - kb);
            partialSM(p0, p1, m_reg, mn, alpha);
            if (__any(alpha < 1.f)) { if (hi == 0) al_l[r32] = alpha; asm volatile("s_waitcnt lgkmcnt(0)" ::: "memory");
#pragma unroll
                for (int d_ = 0; d_ < 4; ++d_)
#pragma unroll
                    for (int r = 0; r < 16; ++r) o[d_][r] *= al_l[crow(r, hi)]; }
            finishSM(p0, p1, alpha, l_reg, pa0, pa1, pa2, pa3);
            pv_tile(o, vbase + buf * SHM_V, pa0, pa1, pa2, pa3);
        }
        float cm = fmaf(m_reg, SCALE, cbase);
#pragma unroll
        for (int o_ = 1; o_ < 32; o_ <<= 1) cm = fminf(cm, __shfl_xor(cm, o_));
        if (lane == 0) stopm[buf * 8 + wid] = cm;
        if (has_next) SWRITE(buf ^ 1);
        __syncthreads();
        if (!has_next) break;
        float cmin = stopm[buf * 8];
#pragma unroll
        for (int w = 1; w < 8; ++w) cmin = fminf(cmin, stopm[buf * 8 + w]);
        if (cmin >= 18.f - FK_lds[(buf ^ 1) * 64 + 63]) break;
        --j;
    }
#undef SLOAD
#undef SWRITE
    if (hi == 0) li_l[r32] = l_reg; asm volatile("s_waitcnt lgkmcnt(0)" ::: "memory");
    float rli[16];
#pragma unroll
    for (int r = 0; r < 16; ++r) rli[r] = __builtin_amdgcn_rcpf(li_l[crow(r, hi)]);
    bf16_t* Ow = br + (size_t)qlo * DM + 3 * BWID + g * 128;
#pragma unroll
    for (int r = 0; r < 16; ++r) { const int orow = crow(r, hi);
#pragma unroll
        for (int d0 = 0; d0 < 4; ++d0) { const float v = o[d0][r] * rli[r]; const float vn = __shfl_xor(v, 1);
            if ((r32 & 1) == 0) *(unsigned*)(Ow + (size_t)orow * DM + d0 * 32 + r32) = cvtpk(v, vn); } }
}
}

namespace mix {
constexpr int VR_STRIDE = 520;
constexpr int PL_STRIDE = 520;
__device__ __forceinline__ void unpk8(const u32x4 w, float (&f)[8]) { f[0] = bflo(w.x); f[1] = bfhi(w.x); f[2] = bflo(w.y); f[3] = bfhi(w.y); f[4] = bflo(w.z); f[5] = bfhi(w.z); f[6] = bflo(w.w); f[7] = bfhi(w.w); }
__device__ __forceinline__ void conv_item(const Params& p, int l, int t0) {
    const int tid = ltid(), cc = tid & 63, tg = tid >> 6, c = cc * 8, tf = t0 + tg * 16;
    const float* cw = p.conv_w + (size_t)l * 3 * BWID + c;
    float w[3][8];
#pragma unroll
    for (int j = 0; j < 3; ++j) { const f32x4 a = *(const f32x4*)(cw + j * BWID), b = *(const f32x4*)(cw + j * BWID + 4);
        w[j][0] = a[0]; w[j][1] = a[1]; w[j][2] = a[2]; w[j][3] = a[3]; w[j][4] = b[0]; w[j][5] = b[1]; w[j][6] = b[2]; w[j][7] = b[3]; }
    const bf16_t* zb = p.zmix + C_A + c; const bf16_t* zc = zb + BWID; const bf16_t* zh = zb + 2 * BWID;
    float z2[8], z1[8];
    { u32x4 c2 = {0u, 0u, 0u, 0u}, h2 = c2, c1 = c2, h1 = c2;
      if (tf >= 2) { c2 = *(const u32x4*)(zc + (size_t)(tf - 2) * NMIX); h2 = *(const u32x4*)(zh + (size_t)(tf - 2) * NMIX); }
      if (tf >= 1) { c1 = *(const u32x4*)(zc + (size_t)(tf - 1) * NMIX); h1 = *(const u32x4*)(zh + (size_t)(tf - 1) * NMIX); }
      float a[8], b[8]; unpk8(c2, a); unpk8(h2, b);
#pragma unroll
      for (int e = 0; e < 8; ++e) z2[e] = a[e] * b[e];
      unpk8(c1, a); unpk8(h1, b);
#pragma unroll
      for (int e = 0; e < 8; ++e) z1[e] = a[e] * b[e]; }
#pragma unroll 1
    for (int hb = 0; hb < 2; ++hb) {
        u32x4 cv[8], hv[8], bv[8];
#pragma unroll
        for (int i = 0; i < 8; ++i) { const size_t ro = (size_t)(tf + hb * 8 + i) * NMIX; cv[i] = *(const u32x4*)(zc + ro); hv[i] = *(const u32x4*)(zh + ro); bv[i] = *(const u32x4*)(zb + ro); }
#pragma unroll
        for (int i = 0; i < 8; ++i) { float a[8], b[8], g[8], y[8]; unpk8(cv[i], a); unpk8(hv[i], b); unpk8(bv[i], g);
#pragma unroll
            for (int e = 0; e < 8; ++e) { const float z0 = a[e] * b[e]; y[e] = g[e] * (w[0][e] * z2[e] + w[1][e] * z1[e] + w[2][e] * z0); z2[e] = z1[e]; z1[e] = z0; }
            u32x4 o; o.x = pk2(y[0], y[1]); o.y = pk2(y[2], y[3]); o.z = pk2(y[4], y[5]); o.w = pk2(y[6], y[7]);
            *(u32x4*)(p.br + (size_t)(tf + hb * 8 + i) * DM + c) = o; }
    }
}
__device__ __forceinline__ void sgu_item(const Params& p, int l, int t0, LAS unsigned char* lds) {
    const int tid = ltid(), wid = __builtin_amdgcn_readfirstlane(tid >> 6), lane = tid & 63, fr = lane & 15, fq = lane >> 4;
    LAS bf16_t* VR = (LAS bf16_t*)lds;
    __syncthreads();
    {
        const float* ngp = p.sgu_norm_g + (size_t)l * BWID + 8 * lane; const f32x4 n0 = *(const f32x4*)ngp, n1 = *(const f32x4*)(ngp + 4);
        const float ng[8] = {n0[0], n0[1], n0[2], n0[3], n1[0], n1[1], n1[2], n1[3]};
        u32x4 zr[16];
#pragma unroll
        for (int i = 0; i < 16; ++i) zr[i] = *(const u32x4*)(p.zmix + (size_t)(t0 + wid * 16 + i) * NMIX + C_B + BWID + 8 * lane);
#pragma unroll
        for (int i = 0; i < 16; ++i) { float v[8]; unpk8(zr[i], v); float ss = 0.f;
#pragma unroll
            for (int e = 0; e < 8; ++e) { v[e] = gelu_t(v[e]); ss += v[e] * v[e]; }
            const float rstd = __builtin_amdgcn_rsqf(wave_sum(ss) * (1.f / BWID) + EPS);
            u32x4 o; o.x = pk2(v[0] * rstd * ng[0], v[1] * rstd * ng[1]); o.y = pk2(v[2] * rstd * ng[2], v[3] * rstd * ng[3]);
            o.z = pk2(v[4] * rstd * ng[4], v[5] * rstd * ng[5]); o.w = pk2(v[6] * rstd * ng[6], v[7] * rstd * ng[7]);
            *(LAS u32x4*)(VR + (wid * 16 + i) * VR_STRIDE + 8 * lane) = o; }
    }
    __syncthreads();
    const int g = wid >> 1, dh = wid & 1;
    const int q4 = (lane & 15) >> 2, pl = lane & 3;
    const int vb0 = (int)(uintptr_t)VR + (fq * 8 + q4) * (VR_STRIDE * 2) + (g * 128 + dh * 64 + pl * 4) * 2, vb1 = vb0 + 64 * VR_STRIDE * 2;
    bf16x8 X[4][4];
#define TRX(dst, base, off) asm volatile("ds_read_b64_tr_b16 %0, %1 offset:%2" : "=&v"(dst) : "v"(base), "i"(off) : "memory")
#pragma unroll
    for (int xb = 0; xb < 4; ++xb)
#pragma unroll
        for (int ks = 0; ks < 4; ++ks) { s16x4 lo, hi; constexpr int RB = VR_STRIDE * 2;
            if (ks < 2) { TRX(lo, vb0, xb * 32 + (ks & 1) * 32 * RB); TRX(hi, vb0, xb * 32 + (ks & 1) * 32 * RB + 4 * RB); }
            else        { TRX(lo, vb1, xb * 32 + (ks & 1) * 32 * RB); TRX(hi, vb1, xb * 32 + (ks & 1) * 32 * RB + 4 * RB); }
            asm volatile("s_waitcnt lgkmcnt(0)" ::: "memory");
            X[xb][ks] = (bf16x8){lo[0], lo[1], lo[2], lo[3], hi[0], hi[1], hi[2], hi[3]}; }
#undef TRX
    const bf16_t* W = p.sguW + ((size_t)l * 4 + g) * 128 * 128;
    const float* bias = p.sgu_b + ((size_t)l * 4 + g) * 128;
#pragma unroll 1
    for (int tp = 0; tp < 4; ++tp) {
        bf16x8 Y[2][4]; u32x2 uw[2][4]; float bs[2];
#pragma unroll
        for (int h2 = 0; h2 < 2; ++h2) { const int t = (tp * 2 + h2) * 16 + fr; bs[h2] = bias[t];
#pragma unroll
            for (int ks = 0; ks < 4; ++ks) Y[h2][ks] = *(const bf16x8*)(W + (size_t)t * 128 + ks * 32 + fq * 8);
#pragma unroll
            for (int xb = 0; xb < 4; ++xb) uw[h2][xb] = *(const u32x2*)(p.zmix + (size_t)(t0 + t) * NMIX + C_B + g * 128 + dh * 64 + xb * 16 + 4 * fq); }
#pragma unroll
        for (int h2 = 0; h2 < 2; ++h2) { const int t = (tp * 2 + h2) * 16 + fr;
            f32x4 acc[4];
#pragma unroll
            for (int xb = 0; xb < 4; ++xb) acc[xb] = (f32x4){0.f, 0.f, 0.f, 0.f};
#pragma unroll
            for (int ks = 0; ks < 4; ++ks)
#pragma unroll
                for (int xb = 0; xb < 4; ++xb) acc[xb] = mfma16(X[xb][ks], Y[h2][ks], acc[xb]);
#pragma unroll
            for (int xb = 0; xb < 4; ++xb) { const int c = g * 128 + dh * 64 + xb * 16 + 4 * fq; const u32x2 u_ = uw[h2][xb];
                const float u0 = gelu_t(bflo(u_.x)), u1 = gelu_t(bfhi(u_.x)), u2 = gelu_t(bflo(u_.y)), u3 = gelu_t(bfhi(u_.y));
                u32x2 o; o.x = pk2(u0 * (acc[xb][0] + bs[h2]), u1 * (acc[xb][1] + bs[h2])); o.y = pk2(u2 * (acc[xb][2] + bs[h2]), u3 * (acc[xb][3] + bs[h2]));
                *(u32x2*)(p.br + (size_t)(t0 + t) * DM + BWID + c) = o; } }
    }
}
template <int W>
__device__ __forceinline__ void pool_fill(const bf16_t* zmix, LAS bf16_t* PL, int t0, int th, int lane) {
    constexpr int G = (W == 2) ? 0 : (W == 4) ? 1 : (W == 8) ? 2 : 3;
    const int ccl = lane & 15, ts = lane >> 4, c = G * 128 + ccl * 8;
#pragma unroll 1
    for (int hp = 0; hp < 2; ++hp) {
        const int tl0 = th * 64 + ts * 16 + hp * 8, ta0 = t0 + tl0;
        u32x4 R[8 + W - 1];
#pragma unroll
        for (int k = 0; k < 8 + W - 1; ++k) { const int ta = ta0 - (W - 1) + k; R[k] = (u32x4){0u, 0u, 0u, 0u}; if (ta >= 0) R[k] = *(const u32x4*)(zmix + (size_t)ta * NMIX + C_C + c); }
        float s[8];
#pragma unroll
        for (int e = 0; e < 8; ++e) s[e] = 0.f;
#pragma unroll
        for (int k = 0; k < W - 1; ++k) { float f[8]; unpk8(R[k], f);
#pragma unroll
            for (int e = 0; e < 8; ++e) s[e] += f[e]; }
#pragma unroll
        for (int i = 0; i < 8; ++i) { float f[8], d[8]; unpk8(R[W - 1 + i], f); unpk8(R[i], d);
            const int ta = ta0 + i; const float inv = 1.f / (float)((ta + 1 < W) ? ta + 1 : W);
            float o[8];
#pragma unroll
            for (int e = 0; e < 8; ++e) { s[e] += f[e]; o[e] = s[e] * inv - f[e]; s[e] -= d[e]; }
            u32x4 w; w.x = pk2(o[0], o[1]); w.y = pk2(o[2], o[3]); w.z = pk2(o[4], o[5]); w.w = pk2(o[6], o[7]);
            *(LAS u32x4*)(PL + (tl0 + i) * PL_STRIDE + c) = w; }
    }
}
__device__ __forceinline__ void pool_item(const Params& p, int l, int t0, LAS unsigned char* lds) {
    const int tid = ltid(), wid = __builtin_amdgcn_readfirstlane(tid >> 6), lane = tid & 63, fr = lane & 15, fq = lane >> 4;
    LAS bf16_t* PL = (LAS bf16_t*)lds;
    const int g = wid >> 1, oh = wid & 1;
    const bf16_t* WT = p.poolWT + ((size_t)l * 4 + g) * 128 * 128;
    __syncthreads();
    {
        const int gg = wid & 3, th = wid >> 2;
        if (gg == 0) pool_fill<2>(p.zmix, PL, t0, th, lane); else if (gg == 1) pool_fill<4>(p.zmix, PL, t0, th, lane);
        else if (gg == 2) pool_fill<8>(p.zmix, PL, t0, th, lane); else pool_fill<16>(p.zmix, PL, t0, th, lane);
    }
    bf16x8 X[4][4];
#pragma unroll
    for (int xb = 0; xb < 4; ++xb)
#pragma unroll
        for (int ks = 0; ks < 4; ++ks) X[xb][ks] = *(const bf16x8*)(WT + (size_t)(oh * 64 + xb * 16 + fr) * 128 + ks * 32 + fq * 8);
    __syncthreads();
    const float* sc = p.pool_scale + (size_t)l * BWID + g * 128;
    f32x4 sv[4];
#pragma unroll
    for (int xb = 0; xb < 4; ++xb) sv[xb] = *(const f32x4*)(sc + oh * 64 + xb * 16 + 4 * fq);
#pragma unroll 2
    for (int tb = 0; tb < 8; ++tb) {
        f32x4 acc[4];
#pragma unroll
        for (int xb = 0; xb < 4; ++xb) acc[xb] = (f32x4){0.f, 0.f, 0.f, 0.f};
#pragma unroll
        for (int ks = 0; ks < 4; ++ks) { const bf16x8 Y = *(const LAS bf16x8*)(PL + (tb * 16 + fr) * PL_STRIDE + g * 128 + ks * 32 + fq * 8);
#pragma unroll
            for (int xb = 0; xb < 4; ++xb) acc[xb] = mfma16(X[xb][ks], Y, acc[xb]); }
        const int t = tb * 16 + fr;
#pragma unroll
        for (int xb = 0; xb < 4; ++xb) { const int o0 = oh * 64 + xb * 16 + 4 * fq;
            u32x2 o; o.x = pk2(acc[xb][0] * sv[xb][0], acc[xb][1] * sv[xb][1]); o.y = pk2(acc[xb][2] * sv[xb][2], acc[xb][3] * sv[xb][3]);
            *(u32x2*)(p.br + (size_t)(t0 + t) * DM + 2 * BWID + g * 128 + o0) = o; }
    }
}
}

template <bool FORGET>
__device__ __forceinline__ void norm_phase(const Params& p, int l, const float* hsrc, const bf16_t* po, const float* gain, int gw, int ngw, int lane) {
    f32x4 gv[8], wf[4][8];
#pragma unroll
    for (int j = 0; j < 8; ++j) { gv[j] = ((const f32x4*)gain)[lane + 64 * j];
        if (FORGET) {
#pragma unroll
            for (int g = 0; g < 4; ++g) wf[g][j] = ((const f32x4*)(p.wfg + ((size_t)l * 4 + g) * DM))[lane + 64 * j]; } }
    for (int t = gw; t < SEQ; t += ngw) {
        const f32x4* hr = (const f32x4*)(hsrc + (size_t)t * DM) + lane;
        f32x4 v[8]; float ss = 0.f;
#pragma unroll
        for (int j = 0; j < 8; ++j) v[j] = hr[64 * j];
        if (po) {
#pragma unroll
            for (int j = 0; j < 8; ++j) { const u32x2 w = ((const u32x2*)(po + (size_t)t * DM))[lane + 64 * j]; v[j][0] += bflo(w.x); v[j][1] += bfhi(w.x); v[j][2] += bflo(w.y); v[j][3] += bfhi(w.y); } }
#pragma unroll
        for (int j = 0; j < 8; ++j) ss += (v[j][0] * v[j][0] + v[j][1] * v[j][1]) + (v[j][2] * v[j][2] + v[j][3] * v[j][3]);
        const float rstd = __builtin_amdgcn_rsqf(wave_sum(ss) * (1.f / DM) + EPS);
        float fd[4] = {0.f, 0.f, 0.f, 0.f};
        u32x2* o8 = (u32x2*)(p.xn + (size_t)t * DM) + lane;
#pragma unroll
        for (int j = 0; j < 8; ++j) { const f32x4 y = v[j] * rstd * gv[j];
            u32x2 w; w.x = pk2(y[0], y[1]); w.y = pk2(y[2], y[3]); o8[64 * j] = w;
            if (!FORGET) { int f8 = __builtin_amdgcn_cvt_pk_fp8_f32(clamp8(y[0]), clamp8(y[1]), 0, false); f8 = __builtin_amdgcn_cvt_pk_fp8_f32(clamp8(y[2]), clamp8(y[3]), f8, true);
                ((unsigned*)(p.hn8 + (size_t)t * DM))[lane + 64 * j] = (unsigned)f8; }
            if (FORGET) { int f8 = __builtin_amdgcn_cvt_pk_fp8_f32(clamp8(y[0] * X8_SCALE), clamp8(y[1] * X8_SCALE), 0, false); f8 = __builtin_amdgcn_cvt_pk_fp8_f32(clamp8(y[2] * X8_SCALE), clamp8(y[3] * X8_SCALE), f8, true);
                ((unsigned*)(p.hn8 + (size_t)t * DM))[lane + 64 * j] = (unsigned)f8; }
            if (FORGET) {
#pragma unroll
                for (int g = 0; g < 4; ++g) fd[g] += (y[0] * wf[g][j][0] + y[1] * wf[g][j][1]) + (y[2] * wf[g][j][2] + y[3] * wf[g][j][3]); } }
        if (FORGET) {
#pragma unroll
            for (int g = 0; g < 4; ++g) { const float z = wave_sum(fd[g]) + p.forget_b[l * 4 + g];
                const float ls = fminf(z, 0.f) - log1pf(__expf(-fabsf(z)));
                if (lane == 0) p.flog[(size_t)t * 4 + g] = ls; } }
    }
}
__device__ __forceinline__ void final_norm_phase(const Params& p, int gw, int ngw, int lane) {
    for (int t = gw; t < SEQ; t += ngw) {
        const f32x4* hr = (const f32x4*)(p.h + (size_t)t * DM) + lane;
        f32x4 v[8]; float ss = 0.f;
#pragma unroll
        for (int j = 0; j < 8; ++j) { v[j] = hr[64 * j]; const u32x2 w = ((const u32x2*)(p.po + (size_t)t * DM))[lane + 64 * j];
            v[j][0] += bflo(w.x); v[j][1] += bfhi(w.x); v[j][2] += bflo(w.y); v[j][3] += bfhi(w.y);
            ss += (v[j][0] * v[j][0] + v[j][1] * v[j][1]) + (v[j][2] * v[j][2] + v[j][3] * v[j][3]); }
        const float rstd = __builtin_amdgcn_rsqf(wave_sum(ss) * (1.f / DM) + EPS);
        f32x4* o = (f32x4*)(p.out + (size_t)t * DM) + lane;
#pragma unroll
        for (int j = 0; j < 8; ++j) o[64 * j] = v[j] * rstd * ((const f32x4*)p.final_g)[lane + 64 * j];
    }
}
__device__ __forceinline__ void cumsum_head(const Params& p, int g, LAS unsigned char* lds) {
    LAS float* part = (LAS float*)lds;
    const int tid = ltid(), lane = tid & 63, wid = tid >> 6;
    float v[16]; float s = 0.f;
#pragma unroll
    for (int j = 0; j < 16; ++j) { v[j] = p.flog[(size_t)(tid * 16 + j) * 4 + g]; s += v[j]; }
    float x = s;
#pragma unroll
    for (int o = 1; o < 64; o <<= 1) { const float y = __shfl_up(x, o); if (lane >= o) x += y; }
    __syncthreads();
    if (lane == 63) part[wid] = x;
    __syncthreads();
    float pre = x - s;
    for (int w = 0; w < wid; ++w) pre += part[w];
#pragma unroll
    for (int j = 0; j < 16; ++j) { pre += v[j]; p.F[(size_t)g * SEQ + tid * 16 + j] = pre; }
    __syncthreads();
}
__device__ __forceinline__ void knorm_phase(const Params& p, int l, int gw, int ngw, int lane) {
    float mx = 0.f;
#pragma unroll 4
    for (int t = gw; t < SEQ; t += ngw) {
        const u32x4 w = *(const u32x4*)(p.zmix + (size_t)t * NMIX + C_K + lane * 8);
        float s = bflo(w.x) * bflo(w.x) + bfhi(w.x) * bfhi(w.x) + bflo(w.y) * bflo(w.y) + bfhi(w.y) * bfhi(w.y)
                + bflo(w.z) * bflo(w.z) + bfhi(w.z) * bfhi(w.z) + bflo(w.w) * bflo(w.w) + bfhi(w.w) * bfhi(w.w);
#pragma unroll
        for (int o = 1; o < 16; o <<= 1) s += __shfl_xor(s, o);
        mx = fmaxf(mx, s);
    }
    if ((lane & 15) == 0) atomicMax(p.ctl + CW_KN + l * 4 + (lane >> 4), __float_as_uint(mx));
}

namespace pro { __device__ __forceinline__ void conv_share(const Params& p, int L, int half, LAS unsigned char* lds); }
namespace peer {
constexpr int S_STRIDE = 129, TL_STRIDE = 17;
constexpr int OFF_TL = 256 * S_STRIDE * 4;
__device__ __forceinline__ float pack_f(float v, unsigned idx, unsigned mask) { return __uint_as_float((__float_as_uint(v) & ~mask) | idx); }
#define CEX_DESC(x, y) do { const float hi_ = fmaxf((x), (y)), lo_ = fminf((x), (y)); (x) = hi_; (y) = lo_; } while (0)
__device__ __forceinline__ void sort16_desc(float (&a)[16]) {
#pragma unroll
    for (int k = 2; k <= 16; k <<= 1)
#pragma unroll
        for (int j = k >> 1; j > 0; j >>= 1)
#pragma unroll
            for (int i = 0; i < 16; ++i) { const int l = i ^ j; if (l > i) { if ((i & k) == 0 || k == 16) { if (k == 16 || (i & k) == 0) CEX_DESC(a[i], a[l]); } else CEX_DESC(a[l], a[i]); } }
}
__device__ __forceinline__ void merge16_desc(float (&r)[16], const float (&c)[16]) {
#pragma unroll
    for (int i = 0; i < 16; ++i) r[i] = fmaxf(r[i], c[15 - i]);
#pragma unroll
    for (int j = 8; j > 0; j >>= 1)
#pragma unroll
        for (int i = 0; i < 16; ++i) { const int l = i ^ j; if (l > i) CEX_DESC(r[i], r[l]); }
}
__device__ __forceinline__ void topk_item(const Params& p, int l, int t0, int hd, LAS unsigned char* lds) {
    const int tid = ltid(), wid = __builtin_amdgcn_readfirstlane(tid >> 6), lane = tid & 63, fr = lane & 15, fq = lane >> 4;
    LAS float* Sc = (LAS float*)lds; LAS float* TL = (LAS float*)(lds + OFF_TL);
    __syncthreads();
    {
        const int pp = wid >> 2, nq = wid & 3;
        const bf16_t* kb = p.keysB + (((size_t)l * 8 + hd) * 2 + pp) * 128 * 128;
        const bf16_t* qb = p.q + (size_t)t0 * DM + hd * 256 + pp * 128;
        bf16x8 X[2][4];
#pragma unroll
        for (int xb = 0; xb < 2; ++xb)
#pragma unroll
            for (int ks = 0; ks < 4; ++ks) X[xb][ks] = *(const bf16x8*)(kb + (size_t)(nq * 32 + xb * 16 + fr) * 128 + ks * 32 + fq * 8);
        bf16x8 Yq[8][4];
#pragma unroll
        for (int tb = 0; tb < 8; ++tb)
#pragma unroll
            for (int ks = 0; ks < 4; ++ks) Yq[tb][ks] = *(const bf16x8*)(qb + (size_t)(tb * 16 + fr) * DM + ks * 32 + fq * 8);
#pragma unroll
        for (int tb = 0; tb < 8; ++tb) {
            f32x4 acc[2] = {(f32x4){0.f, 0.f, 0.f, 0.f}, (f32x4){0.f, 0.f, 0.f, 0.f}};
#pragma unroll
            for (int ks = 0; ks < 4; ++ks) { const bf16x8 Y = Yq[tb][ks];
                acc[0] = mfma16(X[0][ks], Y, acc[0]); acc[1] = mfma16(X[1][ks], Y, acc[1]); }
            LAS float* row = Sc + (pp * 128 + tb * 16 + fr) * S_STRIDE + nq * 32 + 4 * fq;
#pragma unroll
            for (int xb = 0; xb < 2; ++xb)
#pragma unroll
                for (int r = 0; r < 4; ++r) row[xb * 16 + r] = acc[xb][r];
        }
    }
    __syncthreads();
    if (tid < 256) {
        const LAS float* row = Sc + tid * S_STRIDE;
        float L[16];
#pragma unroll
        for (int i = 0; i < 16; ++i) L[i] = pack_f(row[i], (unsigned)i, 127u);
        sort16_desc(L);
#pragma unroll 1
        for (int ch = 1; ch < 8; ++ch) { float C[16];
#pragma unroll
            for (int i = 0; i < 16; ++i) C[i] = pack_f(row[ch * 16 + i], (unsigned)(ch * 16 + i), 127u);
            sort16_desc(C); merge16_desc(L, C); }
#pragma unroll
        for (int i = 0; i < 16; ++i) TL[tid * TL_STRIDE + i] = L[i];
    }
    __syncthreads();
    if (tid < 128) {
        const LAS float* A = TL + tid * TL_STRIDE; const LAS float* B = TL + (128 + tid) * TL_STRIDE;
        float av[16], bv[16];
#pragma unroll
        for (int i = 0; i < 16; ++i) { av[i] = __uint_as_float(__float_as_uint(A[i]) & ~127u); bv[i] = __uint_as_float(__float_as_uint(B[i]) & ~127u); }
        float L[16];
        {   float cand[64]; int nc = 0;
#pragma unroll
            for (int a = 0; a < 16; ++a)
#pragma unroll
                for (int b = 0; b < 16; ++b) if ((a + 1) * (b + 1) <= 16) { cand[nc] = pack_f(av[a] + bv[b], (unsigned)(a * 16 + b), 255u); ++nc; }
#pragma unroll
            for (int i = 50; i < 64; ++i) cand[i] = -__builtin_inff();
#pragma unroll
            for (int i = 0; i < 16; ++i) L[i] = cand[i];
            sort16_desc(L);
#pragma unroll
            for (int ch = 1; ch < 4; ++ch) { float C[16];
#pragma unroll
                for (int i = 0; i < 16; ++i) C[i] = cand[ch * 16 + i];
                sort16_desc(C); merge16_desc(L, C); }
        }
        float val[16]; int ex[16]; float mx = -__builtin_inff();
#pragma unroll
        for (int i = 0; i < 16; ++i) { const unsigned ab = __float_as_uint(L[i]) & 255u; const unsigned ua = __float_as_uint(A[ab >> 4]), ub = __float_as_uint(B[ab & 15]);
            val[i] = __uint_as_float(ua & ~127u) + __uint_as_float(ub & ~127u); ex[i] = (int)((ua & 127u) * 128u + (ub & 127u)); mx = fmaxf(mx, val[i]); }
        float sum = 0.f;
#pragma unroll
        for (int i = 0; i < 16; ++i) { val[i] = __expf(val[i] - mx); sum += val[i]; }
        const float inv = 1.f / sum;
        int* pi = p.pidx + (size_t)(t0 + tid) * 128 + hd * 16; float* pg = p.pgate + (size_t)(t0 + tid) * 128 + hd * 16;
#pragma unroll
        for (int i = 0; i < 16; ++i) { pi[i] = ex[i]; pg[i] = val[i] * inv; }
    }
}
__device__ __forceinline__ void vm_wait_le(int n) {
    if (n >= 19) asm volatile("s_waitcnt vmcnt(19)" ::: "memory");
    else if (n >= 16) asm volatile("s_waitcnt vmcnt(16)" ::: "memory");
    else if (n >= 15) asm volatile("s_waitcnt vmcnt(15)" ::: "memory");
    else if (n >= 12) asm volatile("s_waitcnt vmcnt(12)" ::: "memory");
    else if (n >= 8) asm volatile("s_waitcnt vmcnt(8)" ::: "memory");
    else if (n >= 4) asm volatile("s_waitcnt vmcnt(4)" ::: "memory");
    else asm volatile("s_waitcnt vmcnt(0)" ::: "memory");
}
__device__ __forceinline__ bool claim_item(unsigned* cnt, unsigned nchunk, volatile LAS unsigned* misc, int tid, int& q, int& chunk) {
    __syncthreads();
    if (tid < 64) {
        const unsigned x2 = (xb_xcc_id() & 7u) * 2u; unsigned res = 0xffffffffu;
        unsigned k = misc[1];
        for (int tries = 0; tries < 32; ++tries) {
            const unsigned qx = (x2 + k) & 15u;
            unsigned c = 0u;
            if (tid == 0) c = __hip_atomic_fetch_add(cnt + 64 * qx, 1u, __ATOMIC_RELAXED, __HIP_MEMORY_SCOPE_AGENT);
            c = __builtin_amdgcn_readfirstlane(c);
            if (c < nchunk) { res = (qx << 16) | c; break; }
            unsigned hv = 0xffffffffu;
            if (tid < 16) hv = __hip_atomic_load(cnt + 64 * ((x2 + (unsigned)tid) & 15u), __ATOMIC_RELAXED, __HIP_MEMORY_SCOPE_AGENT);
            const unsigned long long open = __ballot(hv < nchunk) & 0xffffull;
            if (open == 0ull) break;
            k = (unsigned)__builtin_ctzll(open);
        }
        if (tid == 0) { misc[0] = res; misc[1] = k; }
    }
    __syncthreads();
    const unsigned r = misc[0];
    if (r == 0xffffffffu) return false;
    q = (int)(r >> 16); chunk = (int)(r & 0xffffu); return true;
}
__device__ __forceinline__ void gather1_phase(const Params& p, int l, LAS unsigned char* lds, int rep = 0) {
    const int tid = ltid(), wid = __builtin_amdgcn_readfirstlane(tid >> 6), lane = tid & 63, r = lane & 15, c = lane >> 4;
    volatile LAS unsigned* misc = (volatile LAS unsigned*)(lds + LDS_MISC);
    unsigned* cnt = p.ctl + CW_QCNT + ((l * 2 + 0) * 2 + rep) * 16 * 64;
    if (tid == 0) misc[1] = 0u;
    LAS unsigned char* buf = lds + wid * 16384;
    LAS unsigned char* sm = lds + 131072 + wid * 2304;
    const int rowi = lane >> 3, j = lane & 7, fw = rowi >> 1, frd = (r >> 1) & 7;
    const int bk0 = (int)(uintptr_t)buf + r * 128 + ((c ^ frd) * 16), bk1 = (int)(uintptr_t)buf + r * 128 + (((4 + c) ^ frd) * 16);
    float mk[8];
#pragma unroll
    for (int g = 0; g < 8; ++g) mk[g] = ((r >> 1) == g) ? 1.f : 0.f;
    const bool odd = (r & 1) != 0;
    int q, chunk;
    const int cpos = (lbid() & 1) * 4; bool cpend = (l + 1 < DEPTH) && rep == 0;
    bool dry = false; const bool sdeal = (gridDim.x == 256u); int sit = 0;
    for (int ndone = 0;; ++ndone) {
        if (cpend && (dry || ndone == cpos)) { pro::conv_share(p, l + 1, 0, lds); cpend = false; }
        if (dry) break;
        bool got;
        if (sdeal) { got = sit < 4;
            if (got) { q = (lbid() & 7) * 2 + (sit >> 1); chunk = (lbid() >> 3) * 2 + (sit & 1); ++sit; } }
        else got = claim_item(cnt, (unsigned)(SEQ / (8 * TPW)), misc, tid, q, chunk);
        if (!got) { dry = true; if (!cpend) break; continue; }

        const int tw = chunk * (8 * TPW) + wid * TPW;
        float acc[TPW][2];
#pragma unroll
        for (int i = 0; i < TPW; ++i) { acc[i][0] = 0.f; acc[i][1] = 0.f; }
#define G1_DMAQ(Q, EN) do { _Pragma("unroll") for (int nn = 0; nn < 4; ++nn) { const int n = ((Q) & 1) * 4 + nn; const int e = (EN)[(Q) * 4 + nn]; \
                        const unsigned char* src = ub + (unsigned)((unsigned)e * 128u + (unsigned)((j ^ ((n & 1) * 4 + fw)) * 16)); \
                        __builtin_amdgcn_global_load_lds((const unsigned*)src, (LAS unsigned*)(buf + ((Q) >> 1) * 8192 + n * 1024), 16, 0, 0); } } while (0)
#define G1_V8(x0, x1) __builtin_shufflevector(__builtin_bit_cast(i32x4, (x0)), __builtin_bit_cast(i32x4, (x1)), 0, 1, 2, 3, 4, 5, 6, 7)
#define G1_CQ(Q, H0, H1, I) do { const int gga = ((Q) & 1) * 2, ga = ((Q) >> 1) * 4 + gga;     \
                        const i64x2 A0a = *(const LAS i64x2*)(uintptr_t)(bk0 + ((Q) >> 1) * 8192 + gga * 2048), A1a = *(const LAS i64x2*)(uintptr_t)(bk1 + ((Q) >> 1) * 8192 + gga * 2048); \
                        const i64x2 A0b = *(const LAS i64x2*)(uintptr_t)(bk0 + ((Q) >> 1) * 8192 + gga * 2048 + 2048), A1b = *(const LAS i64x2*)(uintptr_t)(bk1 + ((Q) >> 1) * 8192 + gga * 2048 + 2048); \
                        const i32x8 hv_ = G1_V8(H0, H1); \
                        const f32x4 Ca = __builtin_amdgcn_mfma_scale_f32_16x16x128_f8f6f4(G1_V8(A0a, A1a), hv_, (f32x4){0.f, 0.f, 0.f, 0.f}, 0, 0, 0, 0x7f7f7f7f, 0, 0x7f7f7f7f); \
                        const f32x4 Cb = __builtin_amdgcn_mfma_scale_f32_16x16x128_f8f6f4(G1_V8(A0b, A1b), hv_, (f32x4){0.f, 0.f, 0.f, 0.f}, 0, 0, 0, 0x7f7f7f7f, 0, 0x7f7f7f7f); \
                        acc[I][0] = fmaf(mk[ga], odd ? Ca[2] : Ca[0], acc[I][0]); acc[I][1] = fmaf(mk[ga], odd ? Ca[3] : Ca[1], acc[I][1]); \
                        acc[I][0] = fmaf(mk[ga + 1], odd ? Cb[2] : Cb[0], acc[I][0]); acc[I][1] = fmaf(mk[ga + 1], odd ? Cb[3] : Cb[1], acc[I][1]); \
                        asm volatile("s_waitcnt lgkmcnt(0)" ::: "memory"); } while (0)
#define G1_SMALLD(SLOT, TI) do { const int* ip_ = p.pidx + (size_t)(tw + (TI)) * 128 + lane; \
                        __builtin_amdgcn_global_load_lds((const unsigned*)ip_, (LAS unsigned*)(sm + (SLOT) * 768), 4, 0, 0); \
                        __builtin_amdgcn_global_load_lds((const unsigned*)(ip_ + 64), (LAS unsigned*)(sm + (SLOT) * 768 + 256), 4, 0, 0); \
                        __builtin_amdgcn_global_load_lds((const unsigned*)(hs0 + (size_t)(TI) * DM), (LAS unsigned*)(sm + (SLOT) * 768 + 512), 4, 0, 0); } while (0)
#define G1_RDIX(SLOT, EN) do { _Pragma("unroll") for (int m = 0; m < 16; ++m) (EN)[m] = *(const LAS int*)(sm + (SLOT) * 768 + (m * 8 + rowi) * 4); } while (0)
#define G1_RDHY(SLOT, H0, H1) do { H0 = *(const LAS i64x2*)(sm + (SLOT) * 768 + 512 + c * 16); H1 = *(const LAS i64x2*)(sm + (SLOT) * 768 + 512 + 64 + c * 16); } while (0)
        {
            const int s = q;
            const unsigned char* ub = p.uS8 + ((size_t)(l * 16 + s) * PEER_N) * 128;
            const unsigned char* hs0 = p.hn8 + (size_t)tw * DM + s * 128 + (lane & 31) * 4;
            int en[16]; i64x2 hyc0, hyc1;
            G1_SMALLD(0, 0); G1_SMALLD(1, 1);
            asm volatile("s_waitcnt vmcnt(0)" ::: "memory"); __builtin_amdgcn_sched_barrier(0);
            G1_RDIX(0, en);
            G1_DMAQ(0, en); G1_DMAQ(1, en); G1_DMAQ(2, en); G1_DMAQ(3, en);
            __builtin_amdgcn_sched_barrier(0);
#pragma unroll
            for (int i = 0; i < TPW; ++i) {
#pragma unroll
                for (int qq = 0; qq < 4; ++qq) {
                    const int nyoung = 4 * ((3 - qq) + ((i + 1 < TPW) ? qq : 0)) + ((qq > 0 && i + 2 < TPW) ? 3 : 0);
                    vm_wait_le(nyoung); __builtin_amdgcn_sched_barrier(0);
                    if (qq == 0) {
                        G1_RDHY(i % 3, hyc0, hyc1);
                        if (i + 1 < TPW) G1_RDIX((i + 1) % 3, en);
                        if (i + 2 < TPW) G1_SMALLD((i + 2) % 3, i + 2);
                        __builtin_amdgcn_sched_barrier(0); }
                    G1_CQ(qq, hyc0, hyc1, i);
                    if (i + 1 < TPW) G1_DMAQ(qq, en);
                    __builtin_amdgcn_sched_barrier(0);
                }
            }
        }
#undef G1_SMALLD
#undef G1_RDIX
#undef G1_RDHY
#undef G1_DMAQ
#undef G1_CQ
#undef G1_V8
        const int j0 = 16 * (r >> 1) + 4 * c + 2 * (r & 1);
#pragma unroll
        for (int i = 0; i < TPW; ++i) *(unsigned*)((bf16_t*)p.pq + ((size_t)q * SEQ + tw + i) * 128 + j0) = cvtpk(acc[i][0], acc[i][1]);
    }
}
__device__ __forceinline__ void gather_reduce_phase(const Params& p, const float* rs2, size_t gtid, size_t ngt) {
    for (size_t i = gtid; i < (size_t)SEQ * 128 / 4; i += ngt) {
        f32x4 sum = (f32x4){0.f, 0.f, 0.f, 0.f};
#pragma unroll
        for (int q = 0; q < 16; ++q) { const u32x2 w = ((const u32x2*)((const bf16_t*)p.pq + (size_t)q * SEQ * 128))[i]; sum[0] += bflo(w.x); sum[1] += bfhi(w.x); sum[2] += bflo(w.y); sum[3] += bfhi(w.y); }
        sum *= (1.0f / U_SCALE) * rs2[i >> 5];
        const f32x4 g = ((const f32x4*)p.pgate)[i];
        int w = __builtin_amdgcn_cvt_pk_fp8_f32(clamp8(A_SCALE * g[0] * gelu_t(sum[0])), clamp8(A_SCALE * g[1] * gelu_t(sum[1])), 0, false);
        w = __builtin_amdgcn_cvt_pk_fp8_f32(clamp8(A_SCALE * g[2] * gelu_t(sum[2])), clamp8(A_SCALE * g[3] * gelu_t(sum[3])), w, true);
        ((unsigned*)p.aB8)[i] = (unsigned)w;
    }
}
__device__ __forceinline__ void gather2_phase(const Params& p, int l, LAS unsigned char* lds, int rep = 0) {
    bf16_t* podst = p.po + (rep ? (size_t)SEQ * DM : (size_t)0);
    const int tid = ltid(), wid = __builtin_amdgcn_readfirstlane(tid >> 6), lane = tid & 63, r = lane & 15, c = lane >> 4;
    volatile LAS unsigned* misc = (volatile LAS unsigned*)(lds + LDS_MISC);
    unsigned* cnt = p.ctl + CW_QCNT + ((l * 2 + 1) * 2 + rep) * 16 * 64;
    if (tid == 0) misc[1] = 0u;
    LAS unsigned char* buf = lds + wid * 16384;
    LAS unsigned char* sm = lds + 131072 + wid * 2304;
    const int rowi = lane >> 3, j = lane & 7;
    const int fsw = (rowi >> 1) & 3;
    const int tr_r = (lane & 15) >> 1, tr_h = lane & 1;
    int bnb[4];
#pragma unroll
    for (int nb = 0; nb < 4; ++nb) bnb[nb] = (int)(uintptr_t)buf + (c * 8 + tr_r) * 128 + ((nb ^ ((tr_r >> 1) & 3)) * 16) + tr_h * 8;
    int q, chunk;
    const int cpos = (lbid() & 1) * 4; bool cpend = (l + 1 < DEPTH) && rep == 0;
    bool dry = false; const bool sdeal = (gridDim.x == 256u); int sit = 0;
    for (int ndone = 0;; ++ndone) {
        if (cpend && (dry || ndone == cpos)) { pro::conv_share(p, l + 1, 1, lds); cpend = false; }
        if (dry) break;
        bool got;
        if (sdeal) { got = sit < 4;
            if (got) { q = (lbid() & 7) * 2 + (sit >> 1); chunk = (lbid() >> 3) * 2 + (sit & 1); ++sit; } }
        else got = claim_item(cnt, (unsigned)(SEQ / (8 * TPW)), misc, tid, q, chunk);
        if (!got) { dry = true; if (!cpend) break; continue; }

        const int tw = chunk * (8 * TPW) + wid * TPW;
#define TRR(dst, base, off) asm volatile("ds_read_b64_tr_b8 %0, %1 offset:%2" : "=&v"(dst) : "v"(base), "i"(off) : "memory")
#define EV4(w0, w1) __builtin_amdgcn_perm((w1), (w0), 0x06040200u)
#define OD4(w0, w1) __builtin_amdgcn_perm((w1), (w0), 0x07050301u)
#define G2_CQ(Q) do {   \
                        TRR(evq[Q][0], bnb[0], ((Q) >> 1) * 8192 + ((Q) & 1) * 4096); TRR(odq[Q][0], bnb[0], ((Q) >> 1) * 8192 + ((Q) & 1) * 4096 + 64); \
                        TRR(evq[Q][1], bnb[1], ((Q) >> 1) * 8192 + ((Q) & 1) * 4096); TRR(odq[Q][1], bnb[1], ((Q) >> 1) * 8192 + ((Q) & 1) * 4096 + 64); \
                        TRR(evq[Q][2], bnb[2], ((Q) >> 1) * 8192 + ((Q) & 1) * 4096); TRR(odq[Q][2], bnb[2], ((Q) >> 1) * 8192 + ((Q) & 1) * 4096 + 64); \
                        TRR(evq[Q][3], bnb[3], ((Q) >> 1) * 8192 + ((Q) & 1) * 4096); TRR(odq[Q][3], bnb[3], ((Q) >> 1) * 8192 + ((Q) & 1) * 4096 + 64); \
                        asm volatile("s_waitcnt lgkmcnt(0)" ::: "memory"); __builtin_amdgcn_sched_barrier(0); } while (0)
#define G2_V8(x0, x1, x2, x3) ((i32x8){(int)(x0).x, (int)(x0).y, (int)(x1).x, (int)(x1).y, (int)(x2).x, (int)(x2).y, (int)(x3).x, (int)(x3).y})
#define G2_DMAQ(Q, EN) do { _Pragma("unroll") for (int nn = 0; nn < 4; ++nn) { const int n = ((Q) & 1) * 4 + nn; const int e = (EN)[(Q) * 4 + nn]; \
                        const unsigned char* src = vb + (unsigned)((unsigned)e * 128u + (unsigned)((j ^ fsw) * 16)); \
                        __builtin_amdgcn_global_load_lds((const unsigned*)src, (LAS unsigned*)(buf + ((Q) >> 1) * 8192 + n * 1024), 16, 0, 0); } } while (0)
#define G2_SMALLD(SLOT, TI) do { const int* ip_ = p.pidx + (size_t)(tw + (TI)) * 128 + lane; \
                        __builtin_amdgcn_global_load_lds((const unsigned*)ip_, (LAS unsigned*)(sm + (SLOT) * 768), 4, 0, 0); \
                        __builtin_amdgcn_global_load_lds((const unsigned*)(ip_ + 64), (LAS unsigned*)(sm + (SLOT) * 768 + 256), 4, 0, 0); \
                        __builtin_amdgcn_global_load_lds((const unsigned*)(as0 + (size_t)(TI) * 128), (LAS unsigned*)(sm + (SLOT) * 768 + 512), 4, 0, 0); } while (0)
#define G2_RDIX(SLOT, EN) do { _Pragma("unroll") for (int m = 0; m < 16; ++m) (EN)[m] = *(const LAS int*)(sm + (SLOT) * 768 + (m * 8 + rowi) * 4); } while (0)
#define G2_RDAF(SLOT, AF) do { _Pragma("unroll") for (int ks = 0; ks < 4; ++ks) (AF)[ks] = *(const LAS long*)(sm + (SLOT) * 768 + 512 + ks * 32 + c * 8); } while (0)
        {
            const int s = q;
            const unsigned char* vb = p.vS8 + ((size_t)(l * 16 + s) * PEER_N) * 128;
            const unsigned char* as0 = p.aB8 + (size_t)tw * 128 + (lane & 31) * 4;
            int en[16]; long af[4]; unsigned pend[4];
#pragma unroll
            for (int k = 0; k < 4; ++k) pend[k] = 0u;
            G2_SMALLD(0, 0); G2_SMALLD(1, 1);
            asm volatile("s_waitcnt vmcnt(0)" ::: "memory"); __builtin_amdgcn_sched_barrier(0);
            G2_RDIX(0, en);
            G2_DMAQ(0, en); G2_DMAQ(1, en); G2_DMAQ(2, en); G2_DMAQ(3, en);
            __builtin_amdgcn_sched_barrier(0);
            int sc = 0, sn = 1, s2 = 2;
#pragma unroll 1
            for (int i = 0; i < TPW; ++i) {
                const int t = tw + i;
                u32x2 evq[4][4], odq[4][4];
#pragma unroll
                for (int qq = 0; qq < 4; ++qq) {
                    if (qq == 0) vm_wait_le(12);
                    else if (i == TPW - 1) vm_wait_le(4 * (3 - qq) + 4);
                    else if (i >= 1 && i <= TPW - 3) vm_wait_le(19);
                    else vm_wait_le(15);
                    __builtin_amdgcn_sched_barrier(0);
                    if (qq == 0) {
                        G2_RDAF(sc, af);
                        if (i + 1 < TPW) G2_RDIX(sn, en);
                        if (i + 2 < TPW) G2_SMALLD(s2, i + 2);
                        if (i > 0 && c == 0) {
#pragma unroll
                            for (int nb = 0; nb < 4; ++nb) *(unsigned*)(podst + (size_t)(t - 1) * DM + s * 128 + nb * 32 + 2 * r) = pend[nb]; }
                        asm volatile("" ::: "memory"); __builtin_amdgcn_sched_barrier(0); }
                    G2_CQ(qq);
                    if (i + 1 < TPW) G2_DMAQ(qq, en);
                    __builtin_amdgcn_sched_barrier(0);
                }
                {
                    const u32x2 a0 = __builtin_bit_cast(u32x2, af[0]), a1 = __builtin_bit_cast(u32x2, af[1]), a2 = __builtin_bit_cast(u32x2, af[2]), a3 = __builtin_bit_cast(u32x2, af[3]);
                    const i32x8 a8 = G2_V8(a0, a1, a2, a3);
#pragma unroll
                    for (int nb = 0; nb < 4; ++nb) {
                        const f32x4 De = __builtin_amdgcn_mfma_scale_f32_16x16x128_f8f6f4(a8, G2_V8(evq[0][nb], evq[1][nb], evq[2][nb], evq[3][nb]), (f32x4){0.f, 0.f, 0.f, 0.f}, 0, 0, 0, 0x7f7f7f7f, 0, 0x7f7f7f7f);
                        const f32x4 Do = __builtin_amdgcn_mfma_scale_f32_16x16x128_f8f6f4(a8, G2_V8(odq[0][nb], odq[1][nb], odq[2][nb], odq[3][nb]), (f32x4){0.f, 0.f, 0.f, 0.f}, 0, 0, 0, 0x7f7f7f7f, 0, 0x7f7f7f7f);
                        pend[nb] = cvtpk(De[0] * (1.0f / (V_SCALE * A_SCALE)), Do[0] * (1.0f / (V_SCALE * A_SCALE))); } }
                { const int tmp = sc; sc = sn; sn = s2; s2 = tmp; }
            }
            if (c == 0) {
#pragma unroll
                for (int nb = 0; nb < 4; ++nb) *(unsigned*)(podst + (size_t)(tw + TPW - 1) * DM + s * 128 + nb * 32 + 2 * r) = pend[nb]; }
        }
#undef G2_CQ
#undef G2_V8
#undef G2_DMAQ
#undef G2_SMALLD
#undef G2_RDIX
#undef G2_RDAF
#undef EV4
#undef OD4
#undef TRR
    }
}
}

namespace pro {
__device__ __forceinline__ void tr_item(const float* W, int ldw, int K, bf16_t* WT, int nblk, int item, LAS float* scr, int lane) {
    const int kb = item / nblk, nb = item % nblk, k0 = 64 * kb, n0 = 32 * nb;
    const int kr = lane >> 3, nq = (lane & 7) * 4;
    f32x4 v[8];
#pragma unroll
    for (int i = 0; i < 8; ++i) v[i] = *(const f32x4*)(W + (size_t)(k0 + 8 * i + kr) * ldw + n0 + nq);
#pragma unroll
    for (int i = 0; i < 8; ++i) { LAS float* d = scr + (8 * i + kr) * 33 + nq; d[0] = v[i][0]; d[1] = v[i][1]; d[2] = v[i][2]; d[3] = v[i][3]; }
    asm volatile("s_waitcnt lgkmcnt(0)" ::: "memory");
    const int c = lane & 7;
#pragma unroll
    for (int j = 0; j < 4; ++j) { const int n = (lane >> 3) + 8 * j; const LAS float* s = scr + (8 * c) * 33 + n;
        u32x4 o; o.x = pk2(s[0 * 33], s[1 * 33]); o.y = pk2(s[2 * 33], s[3 * 33]); o.z = pk2(s[4 * 33], s[5 * 33]); o.w = pk2(s[6 * 33], s[7 * 33]);
        *(u32x4*)(WT + (size_t)(n0 + n) * K + k0 + 8 * c) = o; }
    asm volatile("s_waitcnt lgkmcnt(0)" ::: "memory");
}
template <bool F8OUT = false>
__device__ __forceinline__ void tr_item2(const float* W, int ldw, int K, bf16_t* WT, int nblk2, int item, LAS float* scr, int lane) {
    const int kb = item / nblk2, nb = item % nblk2, k0 = 64 * kb, n0 = 64 * nb;
    const int kr = lane >> 3, nq = (lane & 7) * 4, c = lane & 7;
    f32x4 v[2][8];
#pragma unroll
    for (int h = 0; h < 2; ++h)
#pragma unroll
        for (int i = 0; i < 8; ++i) v[h][i] = *(const f32x4*)(W + (size_t)(k0 + 8 * i + kr) * ldw + n0 + 32 * h + nq);
#pragma unroll
    for (int h = 0; h < 2; ++h) {
#pragma unroll
        for (int i = 0; i < 8; ++i) { LAS float* d = scr + (8 * i + kr) * 33 + nq; d[0] = v[h][i][0]; d[1] = v[h][i][1]; d[2] = v[h][i][2]; d[3] = v[h][i][3]; }
        asm volatile("s_waitcnt lgkmcnt(0)" ::: "memory");
#pragma unroll
        for (int j = 0; j < 4; ++j) { const int n = (lane >> 3) + 8 * j; const LAS float* sp = scr + (8 * c) * 33 + n;
            if (F8OUT) { int w0 = __builtin_amdgcn_cvt_pk_fp8_f32(clamp8(sp[0 * 33] * W8_SCALE), clamp8(sp[1 * 33] * W8_SCALE), 0, false); w0 = __builtin_amdgcn_cvt_pk_fp8_f32(clamp8(sp[2 * 33] * W8_SCALE), clamp8(sp[3 * 33] * W8_SCALE), w0, true);
                int w1 = __builtin_amdgcn_cvt_pk_fp8_f32(clamp8(sp[4 * 33] * W8_SCALE), clamp8(sp[5 * 33] * W8_SCALE), 0, false); w1 = __builtin_amdgcn_cvt_pk_fp8_f32(clamp8(sp[6 * 33] * W8_SCALE), clamp8(sp[7 * 33] * W8_SCALE), w1, true);
                *(u32x2*)((unsigned char*)WT + (size_t)(n0 + 32 * h + n) * K + k0 + 8 * c) = (u32x2){(unsigned)w0, (unsigned)w1}; }
            else { u32x4 o; o.x = pk2(sp[0 * 33], sp[1 * 33]); o.y = pk2(sp[2 * 33], sp[3 * 33]); o.z = pk2(sp[4 * 33], sp[5 * 33]); o.w = pk2(sp[6 * 33], sp[7 * 33]);
                *(u32x4*)(WT + (size_t)(n0 + 32 * h + n) * K + k0 + 8 * c) = o; } }
        asm volatile("s_waitcnt lgkmcnt(0)" ::: "memory");
    }
}
__device__ __forceinline__ void cvt_stream(const float* src, bf16_t* dst, size_t n8, size_t gtid, size_t ngt) {
    for (size_t i = gtid; i < n8; i += ngt) { const f32x4 a = ((const f32x4*)src)[2 * i], b = ((const f32x4*)src)[2 * i + 1];
        u32x4 o; o.x = pk2(a[0], a[1]); o.y = pk2(a[2], a[3]); o.z = pk2(b[0], b[1]); o.w = pk2(b[2], b[3]); ((u32x4*)dst)[i] = o; }
}
__device__ __forceinline__ void cvt_sliced(const float* src, bf16_t* dst, size_t gtid, size_t ngt) {
    for (size_t i = gtid; i < (size_t)DEPTH * PEER_N * DM / 8; i += ngt) { const f32x4 a = ((const f32x4*)src)[2 * i], b = ((const f32x4*)src)[2 * i + 1];
        const size_t k8 = i & 255, le = i >> 8, e = le & (PEER_N - 1), l = le >> 14;
        u32x4 o; o.x = pk2(a[0], a[1]); o.y = pk2(a[2], a[3]); o.z = pk2(b[0], b[1]); o.w = pk2(b[2], b[3]);
        *(u32x4*)(dst + (((l * 32 + (k8 >> 3)) * PEER_N + e) * 64 + (k8 & 7) * 8)) = o; }
}
__device__ __forceinline__ void cvt_sliced_fp8(const float* src, unsigned char* dst, float scale, size_t gtid, size_t ngt) {
    const size_t n4 = (size_t)DEPTH * PEER_N * DM / 4;
    for (size_t i0 = gtid; i0 < n4; i0 += 4 * ngt) {
        f32x4 v[4];
#pragma unroll
        for (int u = 0; u < 4; ++u) { const size_t i = i0 + u * ngt; if (i < n4) v[u] = ((const f32x4*)src)[i]; }
#pragma unroll
        for (int u = 0; u < 4; ++u) { const size_t i = i0 + u * ngt; if (i < n4) {
            const size_t k4 = i & 511, le = i >> 9, e = le & (PEER_N - 1), l = le >> 14;
            int w = __builtin_amdgcn_cvt_pk_fp8_f32(clamp8(v[u][0] * scale), clamp8(v[u][1] * scale), 0, false); w = __builtin_amdgcn_cvt_pk_fp8_f32(clamp8(v[u][2] * scale), clamp8(v[u][3] * scale), w, true);
            *(unsigned*)(dst + (((l * 16 + (k4 >> 5)) * PEER_N + e) * 128 + (k4 & 31) * 4)) = (unsigned)w; } }
    }
}
constexpr int I_MIX = 32 * 72, I_GATE = 32 * 128, I_BR = 8 * 32, I_SQ = 32 * 32, I_PW = 2 * 2;
constexpr int I_LAYER = I_MIX + I_GATE + 4 * I_BR + 2 * I_SQ + 4 * I_PW;
constexpr int CVT_CHUNKS = 4096;
constexpr int NTW = I_LAYER + 2 * CVT_CHUNKS;
constexpr int NWG_ITEMS = (NTW + 15) / 16;
template <bool VPERM>
__device__ __forceinline__ void cvt_chunk_fp8(const float* src, unsigned char* dst, float scale, size_t g0, int lane) {
    f32x4 v[2][8];
#pragma unroll
    for (int u = 0; u < 8; ++u) v[0][u] = ((const f32x4*)src)[g0 + u * 64 + lane];
#pragma unroll
    for (int b = 0; b < 4; ++b) {
        if (b + 1 < 4) {
#pragma unroll
            for (int u = 0; u < 8; ++u) v[(b + 1) & 1][u] = ((const f32x4*)src)[g0 + (b + 1) * 512 + u * 64 + lane]; }
#pragma unroll
        for (int u = 0; u < 8; ++u) { const size_t i = g0 + b * 512 + u * 64 + lane; const f32x4 x = v[b & 1][u];
            const size_t k4 = i & 511, le = i >> 9, e = le & (PEER_N - 1), l = le >> 14;
            int w = __builtin_amdgcn_cvt_pk_fp8_f32(clamp8(x[0] * scale), clamp8(x[1] * scale), 0, false); w = __builtin_amdgcn_cvt_pk_fp8_f32(clamp8(x[2] * scale), clamp8(x[3] * scale), w, true);
            if (VPERM) {
                const unsigned pw = (unsigned)__shfl_xor(w, 1); const bool oddl = (lane & 1) != 0;
                const unsigned o = oddl ? __builtin_amdgcn_perm((unsigned)w, pw, 0x07050301u) : __builtin_amdgcn_perm(pw, (unsigned)w, 0x06040200u);
                *(unsigned*)(dst + (((l * 16 + (k4 >> 5)) * PEER_N + e) * 128 + (oddl ? 64 : 0) + ((k4 & 31) >> 1) * 4)) = o; }
            else *(unsigned*)(dst + (((l * 16 + (k4 >> 5)) * PEER_N + e) * 128 + (k4 & 31) * 4)) = (unsigned)w; }
    }
}
__device__ __forceinline__ void conv_wave_item(const Params& p, int l, int w, LAS float* scr, int lane) {
    if (w >= NTW) return;
    if (w >= I_LAYER) { const int c = w - I_LAYER, tbl = c / CVT_CHUNKS, chunk = c % CVT_CHUNKS;
        const size_t g0 = (size_t)l * PEER_N * DM / 4 + (size_t)chunk * 2048;
        if (tbl == 0) cvt_chunk_fp8<false>(p.peer_u, p.uS8, U_SCALE, g0, lane); else cvt_chunk_fp8<true>(p.peer_v, p.vS8, V_SCALE, g0, lane);
        return; }
    int r = w;
    const float* win = p.w_in + (size_t)l * DM * INCOLS; bf16_t* wint = p.WinT + (size_t)l * NIN * DM;
    if (r < I_MIX) { tr_item2(win, INCOLS, DM, wint, 72, r, scr, lane); return; } r -= I_MIX;
    if (r < I_GATE) { tr_item2<true>(win + NMIX + 4, INCOLS, DM, wint + (size_t)NMIX * DM, 128, r, scr, lane); return; } r -= I_GATE;
    if (r < 4 * I_BR) { const int n = r / I_BR; tr_item2(p.w_branch + ((size_t)l * 4 + n) * BWID * DM, DM, BWID, p.WbT + ((size_t)l * 4 + n) * DM * BWID, 32, r % I_BR, scr, lane); return; } r -= 4 * I_BR;
    if (r < I_SQ) { tr_item2(p.w_out + (size_t)l * DM * DM, DM, DM, p.WoT + (size_t)l * DM * DM, 32, r, scr, lane); return; } r -= I_SQ;
    if (r < I_SQ) { tr_item2<true>(p.peer_wq + (size_t)l * DM * DM, DM, DM, p.WqT + (size_t)l * DM * DM, 32, r, scr, lane); return; } r -= I_SQ;
    { const int g = r / I_PW; tr_item2(p.pool_w + ((size_t)l * 4 + g) * 128 * 128, 128, 128, p.poolWT + ((size_t)l * 4 + g) * 128 * 128, 2, r % I_PW, scr, lane); }
}
__device__ __forceinline__ void conv_share(const Params& p, int L, int half, LAS unsigned char* lds) {
    const int tid = ltid(), wid = __builtin_amdgcn_readfirstlane(tid >> 6), lane = tid & 63;
    const int ngw = (int)gridDim.x * NWAVES, gw = lbid() * NWAVES + wid;
    LAS float* scr = (LAS float*)(lds + wid * 16384);
#pragma unroll 1
    for (int w = gw + half * ngw; w < NTW; w += 2 * ngw) conv_wave_item(p, L, w, scr, lane);
}
__device__ __forceinline__ void prologue(const Params& p, int vb, int nvb, LAS unsigned char* lds) {
    const int tid = ltid(), wid = __builtin_amdgcn_readfirstlane(tid >> 6), lane = tid & 63;
    const int gw = vb * NWAVES + wid, ngw = nvb * NWAVES;
    LAS float* scr = (LAS float*)(lds + wid * 16384);
    {
        const int kmax = (NTW + ngw - 1) / ngw;
        for (int k = 0; k < kmax; ++k) { const int w = gw + ((vb & 1) ? (kmax - 1 - k) : k) * ngw; if (w < NTW) conv_wave_item(p, 0, w, scr, lane); }
    }
    const size_t gtid = (size_t)vb * NTHREADS + tid, ngt = (size_t)nvb * NTHREADS;
    cvt_stream(p.peer_keys, p.keysB, (size_t)DEPTH * 8 * 2 * 128 * 128 / 8, gtid, ngt);
    for (size_t i = gtid; i < (size_t)DEPTH * 4 * 128 * 128; i += ngt) { const int s = (int)(i & 127), t = (int)((i >> 7) & 127); p.sguW[i] = (bf16_t)(s <= t ? f2bf(p.sgu_w[i]) : 0u); }
    for (size_t i = gtid; i < (size_t)DEPTH * 4 * DM; i += ngt) { const int k = (int)(i % DM), g = (int)((i / DM) & 3), l = (int)(i / (4 * DM)); p.wfg[i] = p.w_in[((size_t)l * DM + k) * INCOLS + NMIX + g]; }
}
}

#define XB_CW_BAR   4096
#define XB_TMO      128
#define XB_XCNT(j)  (256  + 64 * (j))
#define XB_XSUB(j)  (1280 + 64 * (j))
#define XB_XGEN(j)  (2304 + 64 * (j))
#define XB_TOP      3328
#define XB_TOPGEN   3392
#define XCD_BAR_WORDS 3456
#define XB_SPIN_CAP (1u << 18)
__device__ __forceinline__ unsigned xb_ld(unsigned* p)              { return __hip_atomic_load(p, __ATOMIC_RELAXED, __HIP_MEMORY_SCOPE_AGENT); }
__device__ __forceinline__ unsigned xb_add(unsigned* p, unsigned v) { return __hip_atomic_fetch_add(p, v, __ATOMIC_RELAXED, __HIP_MEMORY_SCOPE_AGENT); }
#define XB_SPIN(cond, bar) do { unsigned _sp = 0; while (cond) { __builtin_amdgcn_s_sleep(1); \
    if ((++_sp & 255u) == 0u) { if (xb_ld(&(bar)[XB_TMO])) break; if (_sp > XB_SPIN_CAP) { atomicAdd(&(bar)[XB_TMO], 1u); break; } } } } while (0)
struct XcdBarrier { unsigned* bar; unsigned x; volatile LAS unsigned* st; };
__device__ __forceinline__ XcdBarrier xcd_barrier_post(unsigned* bar, volatile LAS unsigned* st) {
    XcdBarrier b; b.bar = bar; b.x = xb_xcc_id(); b.st = st;
    if (threadIdx.x == 0) (void)xb_add(&bar[XB_XCNT(b.x)], 1u);
    return b;
}
__device__ __forceinline__ void xcd_barrier_complete(unsigned* bar, unsigned x, unsigned& nloc, unsigned& nx) {
    const unsigned G = gridDim.x * gridDim.y * gridDim.z;
    unsigned sum, cnt, mine, sp = 0u;
    for (;;) {
        sum = 0u; cnt = 0u; mine = 0u;
#pragma unroll
        for (unsigned j = 0; j < 16; ++j) { const unsigned c = xb_ld(&bar[XB_XCNT(j)]); sum += c; cnt += (c > 0u) ? 1u : 0u; mine = (j == x) ? c : mine; }
        if (sum == G) break;
        __builtin_amdgcn_s_sleep(1);
        if ((++sp & 255u) == 0u) { if (xb_ld(&bar[XB_TMO])) break; if (sp > XB_SPIN_CAP) { atomicAdd(&bar[XB_TMO], 1u); break; } }
    }
    nloc = mine > 0u ? mine : 1u; nx = cnt > 0u ? cnt : 1u;
}
__device__ __forceinline__ void xcd_barrier(const XcdBarrier& b) {
    asm volatile("s_waitcnt vmcnt(0)" ::: "memory");
    __syncthreads();
    if (threadIdx.x == 0) {
        const unsigned long long wsv = ((const LAS unsigned long long*)((LAS unsigned char*)b.st - LDS_BARW + LDS_PTAB))[19];
        const unsigned wlo = __builtin_amdgcn_readfirstlane((unsigned)wsv), whi = __builtin_amdgcn_readfirstlane((unsigned)(wsv >> 32));
        unsigned* bar = (unsigned*)(GAS unsigned*)((((unsigned long long)whi << 32) | wlo) + WS_CTL + (size_t)XB_CW_BAR * 4);
        __builtin_amdgcn_s_waitcnt(0);
        unsigned nloc = b.st[0], nx = b.st[1];
        if (nloc == 0u) { xcd_barrier_complete(bar, b.x, nloc, nx); b.st[0] = nloc; b.st[1] = nx; }
        const unsigned old = xb_add(&bar[XB_XSUB(b.x)], 1u);
        const unsigned gen = old / nloc;
        if (old + 1u == (gen + 1u) * nloc) {
            __builtin_amdgcn_fence(__ATOMIC_RELEASE, "agent");
            asm volatile("s_waitcnt vmcnt(0)" ::: "memory");
            const unsigned og = xb_add(&bar[XB_TOP], 1u);
            const unsigned tg = og / nx;
            if (og + 1u == (tg + 1u) * nx) xb_add(&bar[XB_TOPGEN], 1u);
            else XB_SPIN(xb_ld(&bar[XB_TOPGEN]) == tg, bar);
            __builtin_amdgcn_fence(__ATOMIC_ACQUIRE, "agent");
            xb_add(&bar[XB_XGEN(b.x)], 1u);
            asm volatile("s_waitcnt vmcnt(0)" ::: "memory");
        } else {
            XB_SPIN(xb_ld(&bar[XB_XGEN(b.x)]) == gen, bar);
            __builtin_amdgcn_fence(__ATOMIC_ACQUIRE, "agent");
            asm volatile("s_waitcnt vmcnt(0)" ::: "memory");
        }
    }
    __syncthreads();
}

constexpr int NPH_LAYER = 9, NPHASES = 2 + DEPTH * NPH_LAYER;
constexpr int CW_BAR = XB_CW_BAR;


template <class T> __device__ __forceinline__ T* ldptr(const LAS unsigned long long* ptab, int i) {
    const unsigned long long v = ptab[i];
    const unsigned lo = __builtin_amdgcn_readfirstlane((unsigned)v), hi = __builtin_amdgcn_readfirstlane((unsigned)(v >> 32));
    return (T*)(GAS T*)(((unsigned long long)hi << 32) | lo);
}
__device__ __forceinline__ Params mkparams(const LAS unsigned long long* ptab) {
    Params p;
    p.x = ldptr<const float>(ptab, 0); p.norm1_g = ldptr<const float>(ptab, 1); p.w_in = ldptr<const float>(ptab, 2); p.conv_w = ldptr<const float>(ptab, 3);
    p.sgu_norm_g = ldptr<const float>(ptab, 4); p.sgu_w = ldptr<const float>(ptab, 5); p.sgu_b = ldptr<const float>(ptab, 6); p.pool_w = ldptr<const float>(ptab, 7);
    p.pool_scale = ldptr<const float>(ptab, 8); p.forget_b = ldptr<const float>(ptab, 9); p.w_branch = ldptr<const float>(ptab, 10); p.w_out = ldptr<const float>(ptab, 11);
    p.norm2_g = ldptr<const float>(ptab, 12); p.peer_wq = ldptr<const float>(ptab, 13); p.peer_keys = ldptr<const float>(ptab, 14); p.peer_u = ldptr<const float>(ptab, 15);
    p.peer_v = ldptr<const float>(ptab, 16); p.final_g = ldptr<const float>(ptab, 17); p.out = ldptr<float>(ptab, 18);
    unsigned char* ws = ldptr<unsigned char>(ptab, 19);
    p.WinT = (bf16_t*)(ws + WS_WIN); p.WbT = (bf16_t*)(ws + WS_WB); p.WoT = (bf16_t*)(ws + WS_WO); p.WqT = (bf16_t*)(ws + WS_WQ); p.keysB = (bf16_t*)(ws + WS_KEYS);
    p.uS = (bf16_t*)(ws + WS_U); p.vS = (bf16_t*)(ws + WS_V); p.sguW = (bf16_t*)(ws + WS_SGUW); p.poolWT = (bf16_t*)(ws + WS_POOLW);
    p.wfg = (float*)(ws + WS_WFG); p.h = (float*)(ws + WS_H); p.macc = (float*)(ws + WS_MACC); p.flog = (float*)(ws + WS_FLOG); p.F = (float*)(ws + WS_F); p.pgate = (float*)(ws + WS_PGATE);
    p.xn = (bf16_t*)(ws + WS_XN); p.zmix = (bf16_t*)(ws + WS_ZMIX); p.zgate = (unsigned char*)(ws + WS_ZGATE); p.po = (bf16_t*)(ws + WS_MACC); p.br = (bf16_t*)(ws + WS_BR); p.merged = (bf16_t*)(ws + WS_MERGED); p.q = (bf16_t*)(ws + WS_Q);
    p.pidx = (int*)(ws + WS_PIDX); p.ctl = (unsigned*)(ws + WS_CTL); p.pq = (float*)(ws + WS_PQ); p.aB = (bf16_t*)(ws + WS_AB); p.uS8 = (unsigned char*)(ws + WS_U); p.vS8 = (unsigned char*)(ws + WS_V); p.hn8 = (unsigned char*)(ws + WS_HN8); p.aB8 = (unsigned char*)(ws + WS_AB); p.ssqp = (float*)(ws + WS_SSQP); p.rs2 = (float*)(ws + WS_RS2);
    return p;
}

__global__ void __launch_bounds__(NTHREADS, 2) mega(Args a) {
    extern __shared__ __attribute__((aligned(16))) unsigned char lds_raw[];
    LAS unsigned char* lds = (LAS unsigned char*)lds_raw;
    const int tid = threadIdx.x;
    LAS unsigned long long* ptab = (LAS unsigned long long*)(lds + LDS_PTAB);
    if (tid == 0) {
#pragma unroll
        for (int i = 0; i < 18; ++i) ptab[i] = (unsigned long long)a.in[i];
        ptab[18] = (unsigned long long)a.out; ptab[19] = (unsigned long long)a.ws;
    }
    const int G = gridDim.x;
    const int lo = a.ph_lo, hi = a.ph_hi;
    volatile LAS unsigned* barw = (volatile LAS unsigned*)(lds + LDS_BARW);
    if (tid == 0) { barw[0] = 0u; barw[1] = 0u; barw[2] = 0u; barw[3] = 0u; }
    __syncthreads();
    XcdBarrier bar; bar.bar = (unsigned*)(a.ws + WS_CTL) + CW_BAR; bar.x = 0; bar.st = barw;
    if (hi - lo > 1) bar = xcd_barrier_post((unsigned*)(a.ws + WS_CTL) + CW_BAR, barw);
#define PP const Params p = mkparams(ptab); const int tid_ = ltid(), vb = lbid(), wid = __builtin_amdgcn_readfirstlane(tid_ >> 6), lane = tid_ & 63, gw = vb * NWAVES + wid, ngw = G * NWAVES; (void)lane; (void)gw; (void)ngw
#ifndef KMASK
#define KMASK 0xFFFF
#endif
#define KON(b) (((KMASK) >> (b)) & 1)
#ifndef REPEAT_KIND
#define REPEAT_KIND -1
#endif
#define REPS(k) (((REPEAT_KIND) == (k) || ((k) == 3 && ((REPEAT_KIND) >= 13 && (REPEAT_KIND) <= 17))) ? 2 : 1)
#define REPLOOP(k) for (int rep = 0; rep < REPS(k); ++rep, (rep < REPS(k) ? xcd_barrier(bar) : (void)0))
#define IN(k) (lo <= (k) && (k) < hi)
#define SEAM(k) do { if (IN(k) && IN((k) + 1)) xcd_barrier(bar); } while (0)

    if (KON(0) && IN(0)) REPLOOP(0) { PP; pro::prologue(p, vb, G, lds); }
    SEAM(0);
#pragma unroll 1
    for (int l = 0; l < DEPTH; ++l) {
        const int base = 1 + NPH_LAYER * l;
        if (KON(1) && IN(base + 0)) REPLOOP(1) { PP; norm_phase<true>(p, l, l == 0 ? p.x : p.h, l == 0 ? (const bf16_t*)nullptr : p.po, p.norm1_g + (size_t)l * DM, gw, ngw, lane); }
        SEAM(base + 0);
        if (KON(2) && IN(base + 1)) REPLOOP(2) { PP;
            if (vb < 4) cumsum_head(p, vb, lds);
            {
                pg8::Gemm g{p.xn, p.WinT + (size_t)l * NIN * DM, SEQ, NMIX, DM, DM, DM}; pg8::StaticOrder S; S.init(SEQ, NMIX, G, vb);
                pg8::EpiInproj E{0, 1.f, p.zmix, p.zgate, p.ctl + CW_KN + l * 16};
                pg8::gemm_phase<pg8::EpiInproj, pg8::StaticOrder>(lds, g, S, E); }
            {
                pg8::Gemm g8{(const bf16_t*)p.hn8, p.WinT + (size_t)l * NIN * DM + (size_t)NMIX * DM, SEQ, NGATE, DM / 2, DM / 2, DM / 2}; pg8::StaticOrder S; S.init(SEQ, NGATE, G, vb);
                if (G == 256 && vb < 64) S.imax = 2;
                pg8::EpiInproj E{NMIX / 256, 1.0f / (X8_SCALE * W8_SCALE), p.zmix, p.zgate, p.ctl + CW_KN + l * 16};
                pg8::gemm_phase<pg8::EpiInproj, pg8::StaticOrder, true>(lds, g8, S, E); }
        }
        SEAM(base + 1);
        if (IN(base + 2)) REPLOOP(3) { PP;
            volatile LAS unsigned* misc = (volatile LAS unsigned*)(lds + LDS_MISC);
            unsigned* head = p.ctl + CW_MIXQ + (l * 2 + rep) * 64;
            for (;;) {
                __syncthreads();
                if (tid_ == 0) misc[0] = __hip_atomic_fetch_add(head, 1u, __ATOMIC_RELAXED, __HIP_MEMORY_SCOPE_AGENT);
                __syncthreads();
                int it = (int)misc[0];
                const int nleft = (G == 256) ? 128 : 0;
                if (it >= nleft + 128 + 192) break;
                if (it < nleft) { if (KON(2) && rep == 0) {
                    pg8::Gemm g8{(const bf16_t*)p.hn8, p.WinT + (size_t)l * NIN * DM + (size_t)NMIX * DM, SEQ, NGATE, DM / 2, DM / 2, DM / 2}; pg8::StaticOrder S; S.init(SEQ, NGATE, G, it & 63); S.i0 = 2 + (it >> 6); S.imax = S.i0 + 1;
                    pg8::EpiInproj E{NMIX / 256, 1.0f / (X8_SCALE * W8_SCALE), p.zmix, p.zgate, p.ctl + CW_KN + l * 16};
                    pg8::gemm_phase<pg8::EpiInproj, pg8::StaticOrder, true>(lds, g8, S, E); }
                    continue; }
                it -= nleft;
                if (it < 128) { if (KON(3) && (rep == 0 || (REPEAT_KIND) != 14)) { const int qb = 31 - (it >> 2), g = it & 3;
                    fa::attn_unit(p.zmix, p.F + (size_t)g * SEQ, p.br, g, qb, (__uint_as_float(__hip_atomic_load(p.ctl + CW_KN + l * 16 + g * 4 + 0, __ATOMIC_RELAXED, __HIP_MEMORY_SCOPE_AGENT)) + __uint_as_float(__hip_atomic_load(p.ctl + CW_KN + l * 16 + g * 4 + 1, __ATOMIC_RELAXED, __HIP_MEMORY_SCOPE_AGENT)) + __uint_as_float(__hip_atomic_load(p.ctl + CW_KN + l * 16 + g * 4 + 2, __ATOMIC_RELAXED, __HIP_MEMORY_SCOPE_AGENT)) + __uint_as_float(__hip_atomic_load(p.ctl + CW_KN + l * 16 + g * 4 + 3, __ATOMIC_RELAXED, __HIP_MEMORY_SCOPE_AGENT))), (LAS char*)lds); } }
                else if (KON(4) && (rep == 0 || (REPEAT_KIND) != 13)) { const int k = it - 128, t0 = (k & 63) * 128;
                    if (k < 64) { if (rep == 0 || (REPEAT_KIND) == 14 || (REPEAT_KIND) == 15) mix::sgu_item(p, l, t0, lds); }
                    else if (k < 128) { if (rep == 0 || (REPEAT_KIND) == 14 || (REPEAT_KIND) == 16) mix::pool_item(p, l, t0, lds); }
                    else { if (rep == 0 || (REPEAT_KIND) == 14 || (REPEAT_KIND) == 17) mix::conv_item(p, l, t0); } }
            }
            __syncthreads();
        }
        SEAM(base + 2);
        if (KON(5) && IN(base + 3)) REPLOOP(5) { PP;
            pg8::Gemm g{p.br, p.WbT + (size_t)l * 4 * DM * BWID, SEQ, DM, BWID, DM, BWID}; pg8::MergeOrder S; S.so.init(SEQ, DM, G, vb);
            pg8::EpiMerge E{p.zgate, p.merged};
            pg8::gemm_phase<pg8::EpiMerge, pg8::MergeOrder>(lds, g, S, E);
        }
        SEAM(base + 3);
        if (KON(6) && IN(base + 4)) { PP;
            pg8::Gemm g{p.merged, p.WoT + (size_t)l * DM * DM, SEQ, DM, DM, DM, DM}; pg8::StaticOrder S; S.init(SEQ, DM, G, vb);
            pg8::EpiResNorm E{l == 0 ? p.x : p.h, l == 0 ? (const bf16_t*)nullptr : p.po, p.h, p.norm2_g + (size_t)l * DM, p.xn, p.hn8, p.ssqp};
            pg8::gemm_phase<pg8::EpiResNorm, pg8::StaticOrder>(lds, g, S, E);
        }
        SEAM(base + 4);
        if (KON(8) && IN(base + 5)) REPLOOP(8) { PP;
            pg8::Gemm g{(const bf16_t*)p.hn8, p.WqT + (size_t)l * DM * DM, SEQ, DM, DM / 2, DM / 2, DM / 2}; pg8::StaticOrder S; S.init(SEQ, DM, G, vb);
            pg8::Unit u0; int tab_pm = -1;
            LAS float* rstab = (LAS float*)(lds + LDS_RSTAB);
            if (S.next(0, u0)) { tab_pm = u0.pm; const int rr = tid_ >> 1, hf = tid_ & 1, r = u0.pm * 256 + rr;
                const f32x4* pp = (const f32x4*)(p.ssqp + (size_t)r * 32 + hf * 16); float sm = 0.f;
#pragma unroll
                for (int k = 0; k < 4; ++k) { const f32x4 v = pp[k]; sm += v[0]; sm += v[1]; sm += v[2]; sm += v[3]; }
                const float so = __shfl_xor(sm, 1); const float tot = hf ? (so + sm) : (sm + so);
                const float rs = __builtin_amdgcn_rsqf(tot * (1.f / DM) + EPS);
                if (hf == 0) { rstab[rr] = rs; if (u0.pn == 0) p.rs2[r] = rs; } }
            __syncthreads();
            pg8::EpiScaleBf16 E{p.q, DM, p.ssqp, rstab, tab_pm, 1.0f / W8_SCALE};
            pg8::gemm_phase<pg8::EpiScaleBf16, pg8::StaticOrder, true>(lds, g, S, E);
            pg8::Unit u;
            for (int ui = 0; S.next(ui, u); ++ui) { __syncthreads(); peer::topk_item(p, l, u.pm * 256, u.pn, lds); peer::topk_item(p, l, u.pm * 256 + 128, u.pn, lds); }
            __syncthreads();
        }
        SEAM(base + 5);
        if (KON(10) && IN(base + 6)) REPLOOP(10) { PP; peer::gather1_phase(p, l, lds, rep); }
        SEAM(base + 6);
        if (KON(10) && IN(base + 7)) REPLOOP(12) { PP; peer::gather_reduce_phase(p, p.rs2, (size_t)vb * NTHREADS + tid_, (size_t)G * NTHREADS); }
        SEAM(base + 7);
        if (KON(10) && IN(base + 8)) REPLOOP(11) { PP; peer::gather2_phase(p, l, lds, rep); }
        SEAM(base + 8);
    }
    if (KON(11) && IN(NPHASES - 1)) { PP; final_norm_phase(p, gw, ngw, lane); }
#undef IN
#undef SEAM
}

extern "C" void kernel_launch(void* const* d_in, const int* in_sizes, int n_in, void* d_out, int out_size, void* d_ws, size_t ws_size, hipStream_t stream) {
    static int grid = 0;
    if (grid == 0) {
        if (n_in != 18 || out_size != SEQ * DM || ws_size < WS_END) { fprintf(stderr, "kernel_launch: unexpected shapes (n_in %d, out %d, ws %zu < %zu)\n", n_in, out_size, ws_size, (size_t)WS_END); grid = -1; return; }
        int dev = 0, cus = 0;
        if (hipGetDevice(&dev) != hipSuccess || hipDeviceGetAttribute(&cus, hipDeviceAttributeMultiprocessorCount, dev) != hipSuccess) { grid = -1; return; }
        if (hipFuncSetAttribute((const void*)mega, hipFuncAttributeMaxDynamicSharedMemorySize, LDS_BYTES) != hipSuccess) { fprintf(stderr, "kernel_launch: hipFuncSetAttribute failed\n"); grid = -1; return; }
        int per_cu = 0;
        if (hipOccupancyMaxActiveBlocksPerMultiprocessor(&per_cu, (const void*)mega, NTHREADS, LDS_BYTES) != hipSuccess || per_cu < 1) fprintf(stderr, "kernel_launch: occupancy query reports %d\n", per_cu);
        (void)hipGetLastError();
        grid = cus;
    }
    if (grid < 0) return;
    unsigned char* ws = (unsigned char*)d_ws;
    (void)hipMemsetAsync(ws + WS_CTL, 0, CTL_BYTES, stream);
    Args a{};
    for (int i = 0; i < 18; ++i) a.in[i] = (const float*)d_in[i];
    a.out = (float*)d_out; a.ws = ws;
#if N_LAUNCH_MODE == 1
    a.ph_lo = 0; a.ph_hi = NPHASES;
    hipLaunchKernelGGL(mega, dim3(grid), dim3(NTHREADS), LDS_BYTES, stream, a);
#else
    for (int ph = 0; ph < NPHASES; ++ph) { a.ph_lo = ph; a.ph_hi = ph + 1; hipLaunchKernelGGL(mega, dim3(grid), dim3(NTHREADS), LDS_BYTES, stream, a); }
#endif
}
```
